# Optimizing an MI355X kernel written in HIP

```python
import math
import jax, jax.numpy as jnp
from jax import lax
import numpy as np


D_MODEL = 1024
BATCH = 2
SEQ = 8192
DEPTH = 1

PLE_DIM = 256
ATTN_HEADS = 8
HEAD_DIM = 64
ATTN_WIDTH = ATTN_HEADS * HEAD_DIM
SSM_WIDTH = D_MODEL - ATTN_WIDTH
SSM_GROUP_CH = 16
SSM_GROUPS = SSM_WIDTH // SSM_GROUP_CH
SSM_STATE = 64
MIX_WIDTH = ATTN_WIDTH + SSM_WIDTH
IN_COLS = 3 * ATTN_WIDTH + ATTN_HEADS + SSM_WIDTH
D_FF = 2816
Q_BLOCK = 128
EPS = 1e-6

kernel_name = 'hybrid_fox_s5_macaron_ple'


def rmsnorm(x, g):
    xf = x.astype(jnp.float32)
    y = xf * lax.rsqrt(jnp.mean(xf * xf, axis=-1, keepdims=True) + EPS)
    return (y * g.astype(jnp.float32)).astype(x.dtype)


def swiglu(x, w1, w3, w2):
    return (jax.nn.silu(x @ w1) * (x @ w3)) @ w2


def forgetting_attention(q, k, v, log_f):
    B, L, H, hd = q.shape
    scale = 1.0 / math.sqrt(hd)
    q = q.transpose(0, 2, 1, 3)
    k = k.transpose(0, 2, 1, 3)
    v = v.transpose(0, 2, 1, 3)
    c = jnp.cumsum(log_f, axis=1).transpose(0, 2, 1)
    kpos = jnp.arange(L)
    n_blocks = L // Q_BLOCK

    def block(i):
        s0 = i * Q_BLOCK
        qb = lax.dynamic_slice_in_dim(q, s0, Q_BLOCK, axis=2)
        cb = lax.dynamic_slice_in_dim(c, s0, Q_BLOCK, axis=2)
        logits = (jnp.einsum('bhqd,bhkd->bhqk', qb, k).astype(jnp.float32) * scale
                  + cb[..., :, None] - c[..., None, :])
        qpos = s0 + jnp.arange(Q_BLOCK)
        mask = kpos[None, :] <= qpos[:, None]
        w = jax.nn.softmax(jnp.where(mask, logits, -jnp.inf), axis=-1)
        return jnp.einsum('bhqk,bhkd->bhqd', w.astype(v.dtype), v)

    out = lax.map(block, jnp.arange(n_blocks))
    return out.transpose(1, 0, 3, 2, 4).reshape(B, L, H * hd)


def _ssm_combine(e1, e2):
    a1r, a1i, b1r, b1i = e1
    a2r, a2i, b2r, b2i = e2
    ar = a2r * a1r - a2i * a1i
    ai = a2r * a1i + a2i * a1r
    br = a2r * b1r - a2i * b1i + b2r
    bi = a2r * b1i + a2i * b1r + b2i
    return ar, ai, br, bi


def s5_mixer(s, a_re, a_im, log_dt, b_re, b_im, c_re, c_im, d_skip, w_glu, b_glu):
    B, L, _ = s.shape
    f32 = jnp.float32
    u = s.astype(f32).reshape(B, L, SSM_GROUPS, SSM_GROUP_CH)
    ar, ai = a_re.astype(f32), a_im.astype(f32)
    dt = jnp.exp(log_dt.astype(f32))[:, None]
    decay = jnp.exp(dt * ar)
    abar_r = decay * jnp.cos(dt * ai)
    abar_i = decay * jnp.sin(dt * ai)
    nr, ni = abar_r - 1.0, abar_i
    den = ar * ar + ai * ai
    fr = (nr * ar + ni * ai) / den
    fi = (ni * ar - nr * ai) / den
    br, bi = b_re.astype(f32), b_im.astype(f32)
    bbar_r = fr[..., None] * br - fi[..., None] * bi
    bbar_i = fr[..., None] * bi + fi[..., None] * br
    bu_r = jnp.einsum('blgh,gph->blgp', u, bbar_r)
    bu_i = jnp.einsum('blgh,gph->blgp', u, bbar_i)
    a_r_full = jnp.broadcast_to(abar_r, bu_r.shape)
    a_i_full = jnp.broadcast_to(abar_i, bu_i.shape)
    _, _, xr, xi = lax.associative_scan(_ssm_combine, (a_r_full, a_i_full, bu_r, bu_i), axis=1)
    y = (jnp.einsum('blgp,ghp->blgh', xr, c_re.astype(f32))
         - jnp.einsum('blgp,ghp->blgh', xi, c_im.astype(f32))
         + d_skip.astype(f32) * u)
    y = jax.nn.gelu(y.reshape(B, L, SSM_WIDTH)).astype(s.dtype)
    return y * jax.nn.sigmoid(y @ w_glu + b_glu)


def setup_inputs(seed: int = 0) -> dict:
    key = jax.random.key(seed)
    ks = iter(jax.random.split(key, 40))
    nrm = lambda shape, scale: jax.random.normal(next(ks), shape, jnp.float32) * scale
    gain = lambda shape: 1.0 + nrm(shape, 0.05)
    Dp, D, F = DEPTH, D_MODEL, D_FF
    G, P, Hc = SSM_GROUPS, SSM_STATE, SSM_GROUP_CH
    inp = {}
    inp['x'] = nrm((BATCH, SEQ, D), 1.0)
    inp['p'] = nrm((DEPTH, BATCH, SEQ, PLE_DIM), 1.0)
    inp['g_ffn1'] = gain((Dp, D))
    inp['w1_a'] = nrm((Dp, D, F), D ** -0.5)
    inp['w3_a'] = nrm((Dp, D, F), D ** -0.5)
    inp['w2_a'] = nrm((Dp, F, D), F ** -0.5)
    inp['g_mix'] = gain((Dp, D))
    inp['w_in'] = nrm((Dp, D, IN_COLS), D ** -0.5)
    inp['b_f'] = jnp.linspace(1.0, 5.0, ATTN_HEADS)[None, :] + nrm((Dp, ATTN_HEADS), 0.1)
    inp['a_re'] = -0.5 + nrm((Dp, G, P), 0.01)
    inp['a_im'] = jnp.pi * jnp.arange(P, dtype=jnp.float32)[None, None, :] + nrm((Dp, G, P), 0.01)
    inp['log_dt'] = jax.random.uniform(next(ks), (Dp, G), jnp.float32, math.log(1e-3), math.log(1e-1))
    inp['b_re'] = nrm((Dp, G, P, Hc), (2.0 * Hc) ** -0.5)
    inp['b_im'] = nrm((Dp, G, P, Hc), (2.0 * Hc) ** -0.5)
    inp['c_re'] = nrm((Dp, G, Hc, P), (2.0 * P) ** -0.5)
    inp['c_im'] = nrm((Dp, G, Hc, P), (2.0 * P) ** -0.5)
    inp['d_skip'] = nrm((Dp, G, Hc), 1.0)
    inp['w_glu'] = nrm((Dp, SSM_WIDTH, SSM_WIDTH), SSM_WIDTH ** -0.5)
    inp['b_glu'] = nrm((Dp, SSM_WIDTH), 0.02)
    inp['g_attn_out'] = gain((Dp, ATTN_WIDTH))
    inp['g_ssm_out'] = gain((Dp, SSM_WIDTH))
    inp['w_out'] = nrm((Dp, MIX_WIDTH, D), MIX_WIDTH ** -0.5)
    inp['g_ffn2'] = gain((Dp, D))
    inp['w1_b'] = nrm((Dp, D, F), D ** -0.5)
    inp['w3_b'] = nrm((Dp, D, F), D ** -0.5)
    inp['w2_b'] = nrm((Dp, F, D), F ** -0.5)
    inp['g_ple'] = gain((Dp, D))
    inp['w_ple_gate'] = nrm((Dp, D, D), D ** -0.5)
    inp['w_ple_proj'] = nrm((Dp, PLE_DIM, D), PLE_DIM ** -0.5)
    inp['g_final'] = gain((D,))
    return inp


def reference(x, p, g_ffn1, w1_a, w3_a, w2_a, g_mix, w_in, b_f, a_re, a_im, log_dt,
              b_re, b_im, c_re, c_im, d_skip, w_glu, b_glu, g_attn_out, g_ssm_out, w_out,
              g_ffn2, w1_b, w3_b, w2_b, g_ple, w_ple_gate, w_ple_proj, g_final):
    B, L, _ = x.shape
    h = x
    s_q, s_k, s_v, s_f = ATTN_WIDTH, 2 * ATTN_WIDTH, 3 * ATTN_WIDTH, 3 * ATTN_WIDTH + ATTN_HEADS
    for i in range(DEPTH):
        h = h + 0.5 * swiglu(rmsnorm(h, g_ffn1[i]), w1_a[i], w3_a[i], w2_a[i])
        u = rmsnorm(h, g_mix[i])
        z = u @ w_in[i]
        q = z[..., :s_q].reshape(B, L, ATTN_HEADS, HEAD_DIM)
        k = z[..., s_q:s_k].reshape(B, L, ATTN_HEADS, HEAD_DIM)
        v = z[..., s_k:s_v].reshape(B, L, ATTN_HEADS, HEAD_DIM)
        log_f = jax.nn.log_sigmoid(z[..., s_v:s_f].astype(jnp.float32) + b_f[i].astype(jnp.float32))
        s_in = z[..., s_f:]
        attn = forgetting_attention(q, k, v, log_f)
        ssm = s5_mixer(s_in, a_re[i], a_im[i], log_dt[i], b_re[i], b_im[i], c_re[i], c_im[i],
                       d_skip[i], w_glu[i], b_glu[i])
        mixed = jnp.concatenate([rmsnorm(attn, g_attn_out[i]), rmsnorm(ssm, g_ssm_out[i])], axis=-1)
        h = h + mixed @ w_out[i]
        h = h + 0.5 * swiglu(rmsnorm(h, g_ffn2[i]), w1_b[i], w3_b[i], w2_b[i])
        gate = jax.nn.sigmoid(rmsnorm(h, g_ple[i]) @ w_ple_gate[i])
        h = h + gate * (p[i] @ w_ple_proj[i])
    return rmsnorm(h, g_final)
```

```cpp
#include <hip/hip_runtime.h>
#include <hip/hip_bf16.h>
#include <cmath>
#include <hip/hip_cooperative_groups.h>
#include <cstdio>
#include <cstdint>
namespace cg = cooperative_groups;
namespace pg8 {
#define PG8_LAS __attribute__((address_space(3)))
typedef unsigned short bf16_t;
typedef short bf16x8 __attribute__((ext_vector_type(8)));
typedef float f32x4 __attribute__((ext_vector_type(4)));
typedef unsigned u32x4 __attribute__((ext_vector_type(4)));
constexpr int BM = 256, BK = 64, HALF = 128, HTB = HALF * BK * 2  , STAGE_BYTES = 8 * HTB, NXCD = 8, WGM = 8;

__host__ __device__ __forceinline__ int lds_byte(int r, int c) { const int st = (r >> 4) * 2 + (c >> 5), rr = r & 15, cc = c & 31, ob = rr * 64 + cc * 2; return st * 1024 + (ob ^ (((ob >> 9) & 1) << 5)); }
__host__ __device__ __forceinline__ void stage_rc(int b, int& R, int& C) { const int st = b / 1024, sb = b % 1024, swz = sb ^ (((sb >> 9) & 1) << 5); R = (st >> 1) * 16 + swz / 64; C = (st & 1) * 32 + (swz % 64) / 2; }
__host__ __device__ __forceinline__ int perm32(int rho) { const int n = rho >> 4, i = rho & 15; return 8 * (i >> 2) + 4 * n + (i & 3); }

struct Unit { int pm, pn; };
struct Gemm { const bf16_t* A; const bf16_t* Bt; int M, N, K; };

struct StaticOrder {
    int nM, nN, nwg, G, c;
    __host__ __device__ void init(int M, int N, int G_, int c_) { nM = M / BM; nN = N / BM; nwg = nM * nN; G = G_; c = c_; }
    __host__ __device__ bool next(int i, Unit& u) const {
        const long L = (long)i * G + c; if (L >= nwg) return false;
        int wgid = (int)L; { const int q = nwg / NXCD, r = nwg % NXCD, xcd = wgid % NXCD, off = wgid / NXCD; wgid = (xcd < r ? xcd * (q + 1) : r * (q + 1) + (xcd - r) * q) + off; }
        const int nig = WGM * nN, gid = wgid / nig, fm = gid * WGM, gsz = (nM - fm) < WGM ? (nM - fm) : WGM;
        u.pm = fm + ((wgid % nig) % gsz); u.pn = (wgid % nig) / gsz; return true;
    }
    __device__ __forceinline__ void a_ready(const Unit&) const {}
    __device__ __forceinline__ void done(const Unit&) const {}
};

__device__ __forceinline__ unsigned cvt_pk_bf16(float lo, float hi) { unsigned r; asm volatile("v_cvt_pk_bf16_f32 %0, %1, %2" : "=v"(r) : "v"(lo), "v"(hi)); return r; }
typedef float f32x2 __attribute__((ext_vector_type(2)));
template <class Epi, class Sched, bool ALIGN_EPI = false, bool SP2 = false>
__device__ __forceinline__ void gemm_phase(PG8_LAS unsigned char* lds, const Gemm g, const Sched& S, const Epi& E, int tid_in) {
    int tid_ = tid_in; asm volatile("" : "+v"(tid_)); const int tid = tid_, wid = __builtin_amdgcn_readfirstlane(tid >> 6), lane = tid & 63, wr = wid >> 2, wc = wid & 3, fr = lane & 15, fq = lane >> 4;
    const int K = g.K, nt = K / BK;
    unsigned voffA[2], voffB[2];
#pragma unroll
    for (int i = 0; i < 2; ++i) { int R, C; stage_rc(tid * 16 + i * 8192, R, C); const int Rb = Epi::PERM ? ((R & ~31) + perm32(R & 31)) : R;
        voffA[i] = (unsigned)(R * K + C) * 2u; voffB[i] = (unsigned)(Rb * K + C) * 2u; }
    const size_t kstep = (size_t)(BK * 2);
    const size_t hstep = (size_t)HALF * K * 2;
    const size_t tstep = 2 * hstep;
    const unsigned ldsw = (unsigned)wid * 1024u;
    const int aoff = lds_byte(wr * 64 + fr, fq * 8), boff = lds_byte(wc * 32 + fr, fq * 8);
#define PG8_SA(b, h) (((b) * 2 + (h)) * HTB)
#define PG8_SB(b, h) ((4 + (b) * 2 + (h)) * HTB)
#define PG8_STAGE(bufoff, gbase, voff) do { _Pragma("unroll") for (int _i = 0; _i < 2; ++_i) \
        __builtin_amdgcn_global_load_lds((const unsigned*)((const char*)(gbase) + (voff)[_i]), (PG8_LAS unsigned*)(lds + (bufoff) + ldsw + _i * 8192), 16, 0, 0); } while (0)
#define PG8_LDA(dst, b, h) do { _Pragma("unroll") for (int m = 0; m < 4; ++m) _Pragma("unroll") for (int k = 0; k < 2; ++k) dst[m][k] = *(const PG8_LAS bf16x8*)(lds + PG8_SA(b, h) + aoff + m * 2048 + k * 1024); } while (0)
#define PG8_LDB(dst, b, h) do { _Pragma("unroll") for (int n = 0; n < 2; ++n) _Pragma("unroll") for (int k = 0; k < 2; ++k) dst[n][k] = *(const PG8_LAS bf16x8*)(lds + PG8_SB(b, h) + boff + n * 2048 + k * 1024); } while (0)
#define PG8_MMA(ai, bj, At, Bt) do { __builtin_amdgcn_s_setprio(1); _Pragma("unroll") for (int m = 0; m < 4; ++m) _Pragma("unroll") for (int n = 0; n < 2; ++n) _Pragma("unroll") for (int k = 0; k < 2; ++k) \
        acc[ai][bj][m][n] = __builtin_amdgcn_mfma_f32_16x16x32_bf16(Bt[n][k], At[m][k], acc[ai][bj][m][n], 0, 0, 0); __builtin_amdgcn_s_setprio(0); } while (0)
#define PG8_WAIT_V(n) asm volatile("s_waitcnt vmcnt(" #n ")" ::: "memory")
#define PG8_WAIT_L(n) asm volatile("s_waitcnt lgkmcnt(" #n ")" ::: "memory")
#define PG8_BAR __builtin_amdgcn_s_barrier()
#define PG8_SCHED __builtin_amdgcn_sched_barrier(0)
    Unit cur, nxt; int ui = 0;
    if (!S.next(0, cur)) return;
    f32x4 acc[2][2][4][2];
#pragma unroll
    for (int a = 0; a < 2; ++a)
#pragma unroll
        for (int b = 0; b < 2; ++b)
#pragma unroll
            for (int m = 0; m < 4; ++m)
#pragma unroll
                for (int n = 0; n < 2; ++n) acc[a][b][m][n] = (f32x4){0.f, 0.f, 0.f, 0.f};
    bf16x8 At[4][2], B0[2][2], B1[2][2];
    const char* cA = (const char*)g.A + (size_t)cur.pm * tstep; const char* cB = (const char*)g.Bt + (size_t)cur.pn * tstep;
    S.a_ready(cur);
    if constexpr (SP2) {
        PG8_STAGE(PG8_SB(0, 0), cB, voffB); PG8_STAGE(PG8_SB(0, 1), cB + hstep, voffB); PG8_STAGE(PG8_SA(0, 0), cA, voffA); PG8_STAGE(PG8_SA(0, 1), cA + hstep, voffA);
        if (wr == 1) PG8_BAR;
        PG8_WAIT_V(2); PG8_BAR;
        PG8_STAGE(PG8_SB(1, 0), cB + kstep, voffB); PG8_STAGE(PG8_SA(1, 0), cA + kstep, voffA); PG8_STAGE(PG8_SB(1, 1), cB + hstep + kstep, voffB);
        PG8_WAIT_V(6); PG8_BAR;
    } else {
        PG8_STAGE(PG8_SB(0, 0), cB, voffB); PG8_STAGE(PG8_SA(0, 0), cA, voffA); PG8_STAGE(PG8_SB(0, 1), cB + hstep, voffB); PG8_STAGE(PG8_SA(0, 1), cA + hstep, voffA);
        if (wr == 1) PG8_BAR;
        PG8_WAIT_V(4); PG8_BAR;
        PG8_STAGE(PG8_SB(1, 0), cB + kstep, voffB); PG8_STAGE(PG8_SA(1, 0), cA + kstep, voffA); PG8_STAGE(PG8_SB(1, 1), cB + hstep + kstep, voffB);
        PG8_WAIT_V(6); PG8_BAR;
    }
    for (;;) {
        const bool has_next = S.next(ui + 1, nxt);
        const char* nA = has_next ? (const char*)g.A + (size_t)nxt.pm * tstep : cA; const char* nB = has_next ? (const char*)g.Bt + (size_t)nxt.pn * tstep : cB;
        for (int t = 0; t < nt; t += 2) {
            const bool last = (t == nt - 2);
            const char* a1 = cA + (size_t)(t + 1) * kstep;
            const char* a2 = last ? nA : cA + (size_t)(t + 2) * kstep; const char* b2 = last ? nB : cB + (size_t)(t + 2) * kstep;
            const char* a3 = a2 + kstep; const char* b3 = b2 + kstep;
            if (last && has_next) S.a_ready(nxt);
            if constexpr (SP2) {
            PG8_LDB(B0, 0, 0); PG8_LDB(B1, 0, 1); PG8_SCHED; PG8_LDA(At, 0, 0); PG8_STAGE(PG8_SA(1, 1), a1 + hstep, voffA);
            PG8_WAIT_V(8); PG8_WAIT_L(0); PG8_BAR; PG8_MMA(0, 0, At, B0); PG8_MMA(0, 1, At, B1); PG8_BAR; PG8_SCHED;
            PG8_LDA(At, 0, 1); PG8_STAGE(PG8_SB(0, 0), b2, voffB); PG8_STAGE(PG8_SB(0, 1), b2 + hstep, voffB); PG8_STAGE(PG8_SA(0, 0), a2, voffA);
            PG8_WAIT_V(8); PG8_WAIT_L(0); PG8_BAR; PG8_MMA(1, 0, At, B0); PG8_MMA(1, 1, At, B1); PG8_BAR; PG8_SCHED;
            PG8_LDB(B0, 1, 0); PG8_LDB(B1, 1, 1); PG8_SCHED; PG8_LDA(At, 1, 0); PG8_STAGE(PG8_SA(0, 1), a2 + hstep, voffA);
            PG8_WAIT_V(8); PG8_WAIT_L(0); PG8_BAR; PG8_MMA(0, 0, At, B0); PG8_MMA(0, 1, At, B1); PG8_BAR; PG8_SCHED;
            PG8_LDA(At, 1, 1); PG8_STAGE(PG8_SB(1, 0), b3, voffB); PG8_STAGE(PG8_SB(1, 1), b3 + hstep, voffB); PG8_STAGE(PG8_SA(1, 0), a3, voffA);
            PG8_WAIT_V(8); PG8_WAIT_L(0); PG8_BAR; PG8_MMA(1, 0, At, B0); PG8_MMA(1, 1, At, B1); PG8_BAR; PG8_SCHED;
            } else {
            PG8_LDB(B0, 0, 0); PG8_SCHED; PG8_LDA(At, 0, 0); PG8_STAGE(PG8_SA(1, 1), a1 + hstep, voffA);
            PG8_WAIT_L(8); PG8_BAR; PG8_WAIT_L(0); PG8_MMA(0, 0, At, B0); PG8_BAR; PG8_SCHED;
            PG8_LDB(B1, 0, 1); PG8_STAGE(PG8_SB(0, 0), b2, voffB);
            PG8_BAR; PG8_WAIT_L(0); PG8_MMA(0, 1, At, B1); PG8_BAR;
            PG8_LDA(At, 0, 1); PG8_STAGE(PG8_SA(0, 0), a2, voffA);
            PG8_BAR; PG8_WAIT_L(0); PG8_MMA(1, 0, At, B0); PG8_BAR; PG8_SCHED;
            PG8_STAGE(PG8_SB(0, 1), b2 + hstep, voffB);
            PG8_WAIT_V(6); PG8_BAR; PG8_MMA(1, 1, At, B1); PG8_BAR;
            PG8_LDB(B0, 1, 0); PG8_SCHED; PG8_LDA(At, 1, 0); PG8_STAGE(PG8_SA(0, 1), a2 + hstep, voffA);
            PG8_WAIT_L(8); PG8_BAR; PG8_WAIT_L(0); PG8_MMA(0, 0, At, B0); PG8_BAR; PG8_SCHED;
            PG8_LDB(B1, 1, 1); PG8_STAGE(PG8_SB(1, 0), b3, voffB);
            PG8_BAR; PG8_WAIT_L(0); PG8_MMA(0, 1, At, B1); PG8_BAR;
            PG8_LDA(At, 1, 1); PG8_STAGE(PG8_SA(1, 0), a3, voffA);
            PG8_BAR; PG8_WAIT_L(0); PG8_MMA(1, 0, At, B0); PG8_BAR; PG8_SCHED;
            PG8_STAGE(PG8_SB(1, 1), b3 + hstep, voffB);
            PG8_WAIT_V(6); PG8_BAR; PG8_MMA(1, 1, At, B1); PG8_BAR;
            }
        }
        if constexpr (ALIGN_EPI) { if (wr == 0) PG8_BAR; }
        if constexpr (!Epi::AFTER_DRAIN) { E(acc, cur, wr, wc, fr, fq); S.done(cur); }
        if (!has_next) break;
#pragma unroll
        for (int a = 0; a < 2; ++a)
#pragma unroll
            for (int b = 0; b < 2; ++b)
#pragma unroll
                for (int m = 0; m < 4; ++m)
#pragma unroll
                    for (int n = 0; n < 2; ++n) acc[a][b][m][n] = (f32x4){0.f, 0.f, 0.f, 0.f};
        cur = nxt; cA = nA; cB = nB; ++ui;
        if constexpr (ALIGN_EPI) { if (wr == 1) PG8_BAR; }
    }
    PG8_WAIT_V(0);
    if constexpr (!ALIGN_EPI) { if (wr == 0) PG8_BAR; }
    PG8_BAR;
    if constexpr (Epi::AFTER_DRAIN) { E.fused(acc, cur, wr, wc, fr, fq, lds, wid, lane); S.done(cur); }
#undef PG8_SA
#undef PG8_SB
#undef PG8_STAGE
#undef PG8_LDA
#undef PG8_LDB
#undef PG8_MMA
#undef PG8_WAIT_V
#undef PG8_WAIT_L
#undef PG8_BAR
#undef PG8_SCHED
}
}

#ifndef PG8_SP2
#define PG8_SP2 true
#endif
#ifndef PG8_ALIGN
#define PG8_ALIGN true
#endif
#include <hip/hip_bf16.h>
#include <cmath>
namespace attn_body {
using bf16=__hip_bfloat16;
using bf16x8=__attribute__((ext_vector_type(8)))short;
using s16x4=__attribute__((ext_vector_type(4)))short;
using f32x16=__attribute__((ext_vector_type(16)))float;
using u32x4=__attribute__((ext_vector_type(4)))unsigned;
using f32x4v=__attribute__((ext_vector_type(4)))float;
constexpr int BATCH=2,NHEAD=8,SEQ=8192,D=64,DM=NHEAD*D;
constexpr int NW=8,QBLK=32,QB=QBLK*NW,KVBLK=64,NQB=SEQ/QB;
constexpr int ATTN_PITCH=DM, ATTN_UNIT_ROWS=QB;
__device__ __forceinline__ int crow(int r,int hi){return (r&3)+8*(r>>2)+4*hi;}
#define SBAR() __builtin_amdgcn_sched_barrier(0)
__device__ __forceinline__ void cmask(f32x16&p0,f32x16&p1,int jb,int qrel,int hi){
  const float NEG=-INFINITY; int kb=64*jb+4*hi;
  #pragma unroll
  for(int r=0;r<16;++r){int kv=kb+(r&3)+8*(r>>2); if(kv>qrel)p0[r]=NEG; if(kv+32>qrel)p1[r]=NEG;}
}

constexpr int NSLOT=3, SLOTB=8192;
constexpr int LDS_K=0, LDS_V=NSLOT*SLOTB, LDS_WS=2*NSLOT*SLOTB, LDS_OST=LDS_WS+NW*64*4, LDS_BIAS=LDS_OST+NW*4096, LDS_WT=LDS_BIAS+SEQ*4, LDS_BYTES=LDS_WT+64;
constexpr float C2=0.125f*1.4426950408889634f;
__device__ __forceinline__ void glds16(const void*gsrc,unsigned lds_dst){unsigned keep;
  asm volatile("s_mov_b32 %0, m0\n\ts_mov_b32 m0, %2\n\ts_nop 0\n\tglobal_load_lds_dwordx4 %1, off\n\ts_mov_b32 m0, %0":"=&s"(keep):"v"(gsrc),"s"(lds_dst):"memory");}
__device__ __forceinline__ float max3f(float a,float b,float c){float r;asm("v_max3_f32 %0, %1, %2, %3":"=v"(r):"v"(a),"v"(b),"v"(c));return r;}
__device__ __forceinline__ float max2f(float a,float b){float r;asm("v_max_f32_e32 %0, %1, %2":"=v"(r):"v"(a),"v"(b));return r;}
__device__ __forceinline__ float fadd_s(float a,float b){float r;asm("v_add_f32_e32 %0, %1, %2":"=v"(r):"v"(a),"v"(b));return r;}
__device__ __forceinline__ float fsub_s(float a,float b){float r;asm("v_sub_f32_e32 %0, %1, %2":"=v"(r):"v"(a),"v"(b));return r;}
typedef float f32x2_t __attribute__((ext_vector_type(2))); typedef __bf16 bf16x2_t __attribute__((ext_vector_type(2)));
__device__ __forceinline__ unsigned cvtpk_s(float lo,float hi){f32x2_t v={lo,hi};bf16x2_t b=__builtin_convertvector(v,bf16x2_t);return __builtin_bit_cast(unsigned,b);}
#define WAIT_BAR(N) asm volatile("s_waitcnt vmcnt(" #N ") lgkmcnt(0)\n\ts_barrier":::"memory")

__device__ __forceinline__ void qkt(f32x16&p0,f32x16&p1,const char*Kslot,const bf16x8*qr,int r32,int hi){
  const char*kb=Kslot+hi*1024+r32*16;
  #pragma unroll
  for(int d0=0;d0<4;++d0){
    const bf16x8 b0=*reinterpret_cast<const bf16x8*>(kb+d0*2048);
    const bf16x8 b1=*reinterpret_cast<const bf16x8*>(kb+d0*2048+512);
    p0=__builtin_amdgcn_mfma_f32_32x32x16_bf16(b0,qr[d0],p0,0,0,0);p1=__builtin_amdgcn_mfma_f32_32x32x16_bf16(b1,qr[d0],p1,0,0,0);}
}
typedef __attribute__((address_space(3))) const char* lds_cptr;
typedef short v4i16_t __attribute__((ext_vector_type(4)));
__device__ __forceinline__ void kload8(bf16x8*kf,lds_cptr kp){
  kf[0]=*(const __attribute__((address_space(3))) bf16x8*)(kp);      kf[1]=*(const __attribute__((address_space(3))) bf16x8*)(kp+512);
  kf[2]=*(const __attribute__((address_space(3))) bf16x8*)(kp+2048); kf[3]=*(const __attribute__((address_space(3))) bf16x8*)(kp+2560);
  kf[4]=*(const __attribute__((address_space(3))) bf16x8*)(kp+4096); kf[5]=*(const __attribute__((address_space(3))) bf16x8*)(kp+4608);
  kf[6]=*(const __attribute__((address_space(3))) bf16x8*)(kp+6144); kf[7]=*(const __attribute__((address_space(3))) bf16x8*)(kp+6656);
}
__device__ __forceinline__ void kload2(bf16x8*kf,lds_cptr kp,int j){ kf[2*j]=*(const __attribute__((address_space(3))) bf16x8*)(kp+j*2048); kf[2*j+1]=*(const __attribute__((address_space(3))) bf16x8*)(kp+j*2048+512); }
__device__ __forceinline__ s16x4 vtr(lds_cptr p){ return __builtin_bit_cast(s16x4,__builtin_amdgcn_ds_read_tr16_b64_v4i16((__attribute__((address_space(3))) v4i16_t*)p)); }
__device__ __forceinline__ float rowmax(const f32x16&p0,const f32x16&p1){
  float a=max3f(p0[0],p0[1],p1[0]),b=max3f(p0[2],p0[3],p1[1]);a=max3f(a,p1[2],p1[3]);
  #pragma unroll
  for(int r=4;r<16;r+=4){a=max3f(a,p0[r],p0[r+1]);b=max3f(b,p0[r+2],p0[r+3]);a=max3f(a,p1[r],p1[r+1]);b=max3f(b,p1[r+2],p1[r+3]);}
  const float m=max2f(a,b);
  auto rr=__builtin_amdgcn_permlane32_swap(__float_as_uint(m),__float_as_uint(m),false,false);
  return max2f(__uint_as_float(rr[0]),__uint_as_float(rr[1]));
}
__device__ __forceinline__ void pv(f32x16*o,int vb,bf16x8 pa0,bf16x8 pa1,bf16x8 pa2,bf16x8 pa3){
  #pragma unroll
  for(int d0=0;d0<2;++d0){s16x4 lo[4],hi[4];
    #pragma unroll
    for(int ks=0;ks<4;++ks){
      asm volatile("ds_read_b64_tr_b16 %0,%1 offset:%c2":"=&v"(lo[ks]):"v"(vb),"i"(d0*4096+ks*1024):"memory");
      asm volatile("ds_read_b64_tr_b16 %0,%1 offset:%c2":"=&v"(hi[ks]):"v"(vb),"i"(d0*4096+ks*1024+512):"memory");}
    asm volatile("s_waitcnt lgkmcnt(0)":::"memory");SBAR();
    #define PK(k) (bf16x8){lo[k][0],lo[k][1],lo[k][2],lo[k][3],hi[k][0],hi[k][1],hi[k][2],hi[k][3]}
    o[d0]=__builtin_amdgcn_mfma_f32_32x32x16_bf16(pa0,PK(0),o[d0],0,0,0);
    o[d0]=__builtin_amdgcn_mfma_f32_32x32x16_bf16(pa1,PK(1),o[d0],0,0,0);
    o[d0]=__builtin_amdgcn_mfma_f32_32x32x16_bf16(pa2,PK(2),o[d0],0,0,0);
    o[d0]=__builtin_amdgcn_mfma_f32_32x32x16_bf16(pa3,PK(3),o[d0],0,0,0);
    #undef PK
  }
}

#ifndef ATTN_STORE16
#define ATTN_STORE16(p,v) (*(u32x4*)(p)=(v))
#endif
template<int THRL> __device__ __forceinline__ void attn_unit(int b,int h,int qb,const bf16*Q,const bf16*__restrict__ K,const bf16*__restrict__ V,bf16*O,const float*__restrict__ logf,float*__restrict__ ssqA,char*shm,int tid_in){
  int tid_=tid_in; asm volatile("":"+v"(tid_)); const int tid=tid_,lane=tid&63,r32=lane&31,hi=lane>>5; const int wid=__builtin_amdgcn_readfirstlane(tid>>6);
  const long rowbase=(long)b*SEQ; const int q0=qb*QB;
  const bf16*Qw=Q+(rowbase+q0+wid*QBLK)*DM+h*D;
  const bf16*Kh=K+rowbase*DM+h*D,*Vh=V+rowbase*DM+h*D;
  const lds_cptr shm3=(lds_cptr)shm;
  const unsigned lds0=(unsigned)(uintptr_t)shm;
  float*wsf=(float*)(shm+LDS_WS)+wid*64;
  const bf16*ksrc=Kh+(long)lane*DM+wid*8;
  const bf16*vsrc=Vh+(long)(16*(wid&3)+(lane>>2))*DM+(wid>>2)*32+(lane&3)*8;
  const unsigned kdst=lds0+LDS_K+wid*1024, vdst=lds0+LDS_V+wid*1024;
  #define DMA_K(t,slot) glds16(ksrc+(long)(t)*KVBLK*DM,(unsigned)__builtin_amdgcn_readfirstlane(kdst+(slot)))
  #define DMA_V(t,slot) glds16(vsrc+(long)(t)*KVBLK*DM,(unsigned)__builtin_amdgcn_readfirstlane(vdst+(slot)))
  const int vb0=(int)(lds0+LDS_V)+((lane>>4)&1)*32+(lane&3)*8+(4*hi+((lane&15)>>2))*64;
  const char*Kbase=shm+LDS_K; bf16x8 kf[8];
  const lds_cptr kp0=shm3+LDS_K+hi*1024+r32*16; const lds_cptr vp0=shm3+LDS_V+((lane>>4)&1)*32+(lane&3)*8+(4*hi+((lane&15)>>2))*64;
  const int NT=(q0+QB)/KVBLK;
  typedef __attribute__((address_space(3))) float* lds_fptr; typedef __attribute__((address_space(3))) f32x4v* lds_f4ptr;
  const lds_fptr biasL=(lds_fptr)(shm3+LDS_BIAS); const lds_fptr wtot=(lds_fptr)(shm3+LDS_WT);
  { const int nkeys=q0+QB; const int k0=tid*16; const float*lf=logf+(long)(b*NHEAD+h)*SEQ+k0;
    f32x4v v0={0.f,0.f,0.f,0.f},v1=v0,v2=v0,v3=v0;
    if(k0<nkeys){v0=*(const f32x4v*)(lf);v1=*(const f32x4v*)(lf+4);v2=*(const f32x4v*)(lf+8);v3=*(const f32x4v*)(lf+12);}
    const float tot=((v0[0]+v0[1])+(v0[2]+v0[3]))+((v1[0]+v1[1])+(v1[2]+v1[3]))+((v2[0]+v2[1])+(v2[2]+v2[3]))+((v3[0]+v3[1])+(v3[2]+v3[3]));
    float x=tot;
    #pragma unroll
    for(int off=1;off<64;off<<=1){const float y=__shfl_down(x,off);if(lane+off<64)x+=y;}
    if(lane==0)wtot[wid]=x;
    __syncthreads();
    float wsum=0.f;
    #pragma unroll
    for(int w=1;w<NW;++w){const float t_=wtot[w];if(w>wid)wsum+=t_;}
    float run=(x-tot)+wsum;
    if(k0<nkeys){ const float L2E=1.4426950408889634f; f32x4v o0,o1,o2,o3;
      o3[3]=run*L2E;run+=v3[3];o3[2]=run*L2E;run+=v3[2];o3[1]=run*L2E;run+=v3[1];o3[0]=run*L2E;run+=v3[0];
      o2[3]=run*L2E;run+=v2[3];o2[2]=run*L2E;run+=v2[2];o2[1]=run*L2E;run+=v2[1];o2[0]=run*L2E;run+=v2[0];
      o1[3]=run*L2E;run+=v1[3];o1[2]=run*L2E;run+=v1[2];o1[1]=run*L2E;run+=v1[1];o1[0]=run*L2E;run+=v1[0];
      o0[3]=run*L2E;run+=v0[3];o0[2]=run*L2E;run+=v0[2];o0[1]=run*L2E;run+=v0[1];o0[0]=run*L2E;
      lds_f4ptr bo=(lds_f4ptr)(biasL+k0); bo[0]=o0;bo[1]=o1;bo[2]=o2;bo[3]=o3; }
    __syncthreads(); }
  const lds_fptr biasp=biasL+4*hi;
  #define BLD(X0,X1,tt) do{ const lds_fptr bp_=biasp+(tt)*KVBLK; \
    _Pragma("unroll") for(int j_=0;j_<4;++j_){ const f32x4v a_=*(const lds_f4ptr)(bp_+8*j_); const f32x4v b_=*(const lds_f4ptr)(bp_+32+8*j_); \
      X0[4*j_]=a_[0];X0[4*j_+1]=a_[1];X0[4*j_+2]=a_[2];X0[4*j_+3]=a_[3]; X1[4*j_]=b_[0];X1[4*j_+1]=b_[1];X1[4*j_+2]=b_[2];X1[4*j_+3]=b_[3]; } }while(0)
  #define BSUB(X,B) do{ _Pragma("unroll") for(int r_=(B);r_<(B)+8;++r_)X[r_]-=mhat; }while(0)
  DMA_K(0,0);DMA_V(0,0);DMA_K(1,SLOTB);
  bf16x8 qr[4];
  #pragma unroll
  for(int d0=0;d0<4;++d0)qr[d0]=*reinterpret_cast<const bf16x8*>(&Qw[(long)r32*DM+d0*16+hi*8]);
  float mhat=0.f,l_reg=0.f;f32x16 o[2];o[0]=f32x16{};o[1]=f32x16{};
  const int qrel=wid*QBLK+r32;
  #define CMASK(P0,P1,t) do{int jb_=(t)-(NT-4); if(jb_>=0)cmask(P0,P1,jb_,qrel,hi);}while(0)
  bool resc=false;
  #define START(P0,P1) do{ const float rm=rowmax(P0,P1); resc=false; \
    { const float dl=rm; mhat=fadd_s(mhat,dl); \
      _Pragma("unroll") for(int r=0;r<16;++r){P0[r]=fsub_s(P0[r],dl);P1[r]=fsub_s(P1[r],dl);} } \
    _Pragma("unroll") for(int r=0;r<16;++r)P0[r]=__builtin_amdgcn_exp2f(P0[r]); }while(0)
  #define RESC() do{ if(resc){ asm volatile("s_waitcnt lgkmcnt(0)":::"memory"); \
      _Pragma("unroll") for(int d_=0;d_<2;++d_) _Pragma("unroll") for(int r=0;r<16;++r)o[d_][r]*=wsf[crow(r,hi)]; } }while(0)
  f32x16 pA0,pA1,pB0,pB1;
  int sl_prev=0,sl_cur=0,sl_next=SLOTB;
  #define ROT() do{sl_prev=sl_cur;sl_cur=sl_next;sl_next=(sl_next==(NSLOT-1)*SLOTB)?0:sl_next+SLOTB;}while(0)
  DMA_K(2,2*SLOTB);
  WAIT_BAR(3);
  BLD(pA0,pA1,0);
  qkt(pA0,pA1,Kbase,qr,r32,hi);asm volatile("s_nop 15\n\ts_nop 7":"+v"(pA0),"+v"(pA1));CMASK(pA0,pA1,0);
  START(pA0,pA1);
  _Pragma("unroll") for(int r=0;r<16;++r)pA1[r]=__builtin_amdgcn_exp2f(pA1[r]);
  BLD(pB0,pB1,1); BSUB(pB0,0); BSUB(pB0,8); BSUB(pB1,0); BSUB(pB1,8);
  WAIT_BAR(0);
  DMA_K(3,0);DMA_V(1,SLOTB);
  ROT();
  kload8(kf,kp0+sl_cur);
  WAIT_BAR(2);
  s16x4 vlo[8],vhi[8]; u32x4 pw0,pw1,pw2,pw3;
  #define PKW(P,B) cvtpk_s(P[B],P[B+1])
  #define PAF(k) __builtin_bit_cast(bf16x8,pw##k)
  #define VFR(i) (bf16x8){vlo[i][0],vlo[i][1],vlo[i][2],vlo[i][3],vhi[i][0],vhi[i][1],vhi[i][2],vhi[i][3]}
  #define PIN(x) asm volatile("":"+v"(x))
  #define MX3(a,b,c) __builtin_fmaxf(__builtin_fmaxf((a),(b)),(c))
  #define GAPA(MF,A0,A1,A2,A3,W0,W1,PW) do{ MF; sacc+=A0; sacc+=A1; sacc+=A2; sacc+=A3; PIN(sacc); W0; W1; PIN(PW); SBAR(); }while(0)
  #define EX(v) __builtin_amdgcn_exp2f(v)
  #define GAPB(MF,X,B) do{ MF; X[B]=EX(X[B]); X[B+1]=EX(X[B+1]); X[B+2]=EX(X[B+2]); X[B+3]=EX(X[B+3]); PIN(X); SBAR(); }while(0)
  #define VRD(i) do{ vlo[i]=vtr(vp_+(((i)>>2)*4096+((i)&3)*1024)); vhi[i]=vtr(vp_+(((i)>>2)*4096+((i)&3)*1024+512)); }while(0)
  #define KRD(G,j) do{ if(G){ kload2(kf,kp0+sl_next,j); SBAR(); } }while(0)
  #define STEP(C0,C1,P0,P1,t,GK,GV,GL) do{ SBAR(); \
    const lds_cptr vp_=vp0+sl_prev; \
    VRD(0); SBAR(); float sacc=(P0[0]+P0[1]); \
    GAPA(C0=__builtin_amdgcn_mfma_f32_32x32x16_bf16(kf[0],qr[0],C0,0,0,0), P0[2],P0[3],P0[4],P0[5],     pw0[0]=PKW(P0,0), pw0[1]=PKW(P0,2), pw0); \
    VRD(4); SBAR(); GAPA(C1=__builtin_amdgcn_mfma_f32_32x32x16_bf16(kf[1],qr[0],C1,0,0,0), P0[6],P0[7],P0[8],P0[9],     pw0[2]=PKW(P0,4), pw0[3]=PKW(P0,6), pw0); \
    VRD(1); SBAR(); GAPA(C0=__builtin_amdgcn_mfma_f32_32x32x16_bf16(kf[2],qr[1],C0,0,0,0),   P0[10],P0[11],P0[12],P0[13], pw1[0]=PKW(P0,8), pw1[1]=PKW(P0,10), pw1); \
    VRD(5); SBAR(); GAPA(C1=__builtin_amdgcn_mfma_f32_32x32x16_bf16(kf[3],qr[1],C1,0,0,0),   P0[14],P0[15],P1[0],P1[1],   pw1[2]=PKW(P0,12),pw1[3]=PKW(P0,14), pw1); \
    VRD(2); SBAR(); GAPA(C0=__builtin_amdgcn_mfma_f32_32x32x16_bf16(kf[4],qr[2],C0,0,0,0),   P1[2],P1[3],P1[4],P1[5],     pw2[0]=PKW(P1,0), pw2[1]=PKW(P1,2), pw2); \
    VRD(6); SBAR(); GAPA(C1=__builtin_amdgcn_mfma_f32_32x32x16_bf16(kf[5],qr[2],C1,0,0,0),   P1[6],P1[7],P1[8],P1[9],     pw2[2]=PKW(P1,4), pw2[3]=PKW(P1,6), pw2); \
    VRD(3); SBAR(); GAPA(C0=__builtin_amdgcn_mfma_f32_32x32x16_bf16(kf[6],qr[3],C0,0,0,0),   P1[10],P1[11],P1[12],P1[13], pw3[0]=PKW(P1,8), pw3[1]=PKW(P1,10), pw3); \
    VRD(7); SBAR(); GAPA(C1=__builtin_amdgcn_mfma_f32_32x32x16_bf16(kf[7],qr[3],C1,0,0,0),   P1[14],P1[15],0.f,0.f,       pw3[2]=PKW(P1,12),pw3[3]=PKW(P1,14), pw3); \
    l_reg+=sacc; \
    if(GK){DMA_K((t)+3,sl_cur);} if(GV){DMA_V((t)+1,sl_next);} \
    CMASK(C0,C1,t); \
    { float a=MX3(C0[0],C0[1],C1[0]),b=MX3(C0[2],C0[3],C1[1]); a=MX3(a,C1[2],C1[3]); \
      _Pragma("unroll") for(int r=4;r<16;r+=4){a=MX3(a,C0[r],C0[r+1]);b=MX3(b,C0[r+2],C0[r+3]);a=MX3(a,C1[r],C1[r+1]);b=MX3(b,C1[r+2],C1[r+3]);} \
      float rm=__builtin_fmaxf(a,b); { auto rr=__builtin_amdgcn_permlane32_swap(__float_as_uint(rm),__float_as_uint(rm),false,false); rm=__builtin_fmaxf(__uint_as_float(rr[0]),__uint_as_float(rr[1])); } \
      resc=false; \
      if(__builtin_expect(__any(rm>(float)THRL),0)){ const float dl=__builtin_fmaxf(rm,0.f); mhat+=dl; \
        _Pragma("unroll") for(int r=0;r<16;++r){C0[r]-=dl;C1[r]-=dl;} \
        const float f=__builtin_amdgcn_exp2f(-dl); l_reg*=f; if(hi==0)wsf[r32]=f; resc=true; } } \
    SBAR(); \
    if(GL){ BLD(P0,P1,(t)+1); SBAR(); } \
    GAPB(o[0]=__builtin_amdgcn_mfma_f32_32x32x16_bf16(PAF(0),VFR(0),o[0],0,0,0), C0,0); \
    GAPB(o[1]=__builtin_amdgcn_mfma_f32_32x32x16_bf16(PAF(0),VFR(4),o[1],0,0,0), C0,4); \
    KRD(GL,0); GAPB(o[0]=__builtin_amdgcn_mfma_f32_32x32x16_bf16(PAF(1),VFR(1),o[0],0,0,0), C0,8); \
    KRD(GL,1); GAPB(o[1]=__builtin_amdgcn_mfma_f32_32x32x16_bf16(PAF(1),VFR(5),o[1],0,0,0), C0,12); \
    KRD(GL,2); if(GL){BSUB(P0,0);} GAPB(o[0]=__builtin_amdgcn_mfma_f32_32x32x16_bf16(PAF(2),VFR(2),o[0],0,0,0), C1,0); \
    KRD(GL,3); if(GL){BSUB(P0,8);} GAPB(o[1]=__builtin_amdgcn_mfma_f32_32x32x16_bf16(PAF(2),VFR(6),o[1],0,0,0), C1,4); \
    if(GL){BSUB(P1,0);} GAPB(o[0]=__builtin_amdgcn_mfma_f32_32x32x16_bf16(PAF(3),VFR(3),o[0],0,0,0), C1,8); \
    if(GL){BSUB(P1,8);} GAPB(o[1]=__builtin_amdgcn_mfma_f32_32x32x16_bf16(PAF(3),VFR(7),o[1],0,0,0), C1,12); \
    }while(0)
  int t=1;
  #undef CMASK
  #define CMASK(P0,P1,t) do{}while(0)
  for(;t+5<NT;t+=2){
    STEP(pB0,pB1,pA0,pA1,t,true,true,true);     WAIT_BAR(2); RESC(); ROT();
    STEP(pA0,pA1,pB0,pB1,t+1,true,true,true);   WAIT_BAR(2); RESC(); ROT();
  }
  #undef CMASK
  #define CMASK(P0,P1,t) do{int jb_=(t)-(NT-4); if(jb_>=0)cmask(P0,P1,jb_,qrel,hi);}while(0)
  #define ENDW(tt) do{ if((tt)+3<NT){WAIT_BAR(2);} else if((tt)+2<NT){WAIT_BAR(1);} else {WAIT_BAR(0);} }while(0)
  for(;t+1<NT;t+=2){
    STEP(pB0,pB1,pA0,pA1,t,(t+3<NT),(t+1<NT),(t+1<NT));       ENDW(t);   RESC(); ROT();
    STEP(pA0,pA1,pB0,pB1,t+1,(t+4<NT),(t+2<NT),(t+2<NT));     ENDW(t+1); RESC(); ROT();
  }
  STEP(pB0,pB1,pA0,pA1,NT-1,false,false,false); RESC();
  { float sacc=pB0[0]+pB0[1]; _Pragma("unroll") for(int r=2;r<16;++r)sacc+=pB0[r]; _Pragma("unroll") for(int r=0;r<16;++r)sacc+=pB1[r]; l_reg+=sacc;
    pw0=(u32x4){PKW(pB0,0),PKW(pB0,2),PKW(pB0,4),PKW(pB0,6)};pw1=(u32x4){PKW(pB0,8),PKW(pB0,10),PKW(pB0,12),PKW(pB0,14)};pw2=(u32x4){PKW(pB1,0),PKW(pB1,2),PKW(pB1,4),PKW(pB1,6)};pw3=(u32x4){PKW(pB1,8),PKW(pB1,10),PKW(pB1,12),PKW(pB1,14)};
    SBAR(); pv(o,vb0+sl_cur,PAF(0),PAF(1),PAF(2),PAF(3)); }
  #undef PKW
  #undef PAF
  #undef VFR
  #undef PIN
  #undef MX3
  #undef GAPA
  #undef GAPB
  #undef EX
  #undef VRD
  #undef KRD
  #undef STEP
  #undef ENDW
  {auto rr=__builtin_amdgcn_permlane32_swap(__float_as_uint(l_reg),__float_as_uint(l_reg),false,false);l_reg=__uint_as_float(rr[0])+__uint_as_float(rr[1]);}
  if(hi==0)wsf[32+r32]=l_reg;asm volatile("s_waitcnt lgkmcnt(0)":::"memory");
  float rli[16];
  #pragma unroll
  for(int r=0;r<16;++r)rli[r]=__builtin_amdgcn_rcpf(wsf[32+crow(r,hi)]);
  bf16*Ow=O+(rowbase+q0+wid*QBLK)*DM+h*D;
  { bf16*stg=(bf16*)(shm+LDS_OST)+wid*2048;
    #pragma unroll
    for(int r=0;r<16;++r){const int orow=crow(r,hi);
      #pragma unroll
      for(int d0=0;d0<2;++d0)stg[orow*64+d0*32+r32]=__float2bfloat16(o[d0][r]*rli[r]);}
    asm volatile("s_waitcnt lgkmcnt(0)":::"memory");
    #pragma unroll
    for(int i=0;i<4;++i){const int row=i*8+(lane>>3),ch=lane&7; const u32x4 v=*(const u32x4*)(stg+row*64+ch*8); ATTN_STORE16(Ow+(long)row*DM+ch*8,v);
      float ss=0.f;
      #pragma unroll
      for(int e=0;e<4;++e){const float lo_=__uint_as_float(v[e]<<16),hi_=__uint_as_float(v[e]&0xffff0000u);ss+=lo_*lo_+hi_*hi_;}
      ss+=__shfl_xor(ss,1);ss+=__shfl_xor(ss,2);ss+=__shfl_xor(ss,4);
      if(ch==0)ssqA[(rowbase+q0+wid*QBLK+row)*NHEAD+h]=ss;} }
  asm volatile("s_waitcnt lgkmcnt(0)\n\ts_barrier":::"memory");
  #undef DMA_K
  #undef DMA_V
  #undef BLD
  #undef BSUB
  #undef CMASK
  #undef START
  #undef RESC
  #undef ROT
}
constexpr int ATTN_LDS_BYTES=LDS_BYTES;
#undef SBAR
#undef WAIT_BAR
}
#define LAS __attribute__((address_space(3)))
#define GAS __attribute__((address_space(1)))
using pg8::f32x4; using pg8::u32x4; using pg8::bf16_t; using pg8::bf16x8; using pg8::Unit; using pg8::BM; using pg8::HALF;
typedef unsigned u32x2 __attribute__((ext_vector_type(2)));
constexpr int TOK = 16384, DMODEL = 1024, DFF = 2816, HW = 512, SEQL = 8192, PLE = 256, NGRP = 32;
constexpr float L2E = 1.4426950408889634f;
constexpr float QSCALE = 0.125f * L2E;
constexpr size_t MiB = 1u << 20;
constexpr size_t WS_CTL = 0, WS_AP = 1 * MiB, WS_BB = WS_AP + 512 * 1024, WS_KTAB = 2 * MiB, WS_PEND = 3 * MiB, WS_CC = 5 * MiB, WS_WF = 7 * MiB, WS_LOGF = 8 * MiB;
constexpr size_t WS_SSQ0 = 9 * MiB, WS_SSQ1 = 10 * MiB, WS_SSQ2 = 11 * MiB, WS_SSQ3 = 12 * MiB, WS_SSQ4 = 13 * MiB, WS_SSQA = 14 * MiB, WS_SSQS = 14 * MiB + 512 * 1024;
constexpr size_t WS_W13A = 16 * MiB, WS_W2A = 27 * MiB, WS_WIN = 33 * MiB, WS_WGLU = 37 * MiB, WS_WOA = 38 * MiB, WS_WOS = 39 * MiB, WS_W13B = 40 * MiB, WS_W2B = 51 * MiB, WS_WG = 57 * MiB, WS_WP = 59 * MiB;
constexpr size_t WS_PB = 60 * MiB, WS_XB = 68 * MiB, WS_H1 = 100 * MiB;
constexpr size_t WS_Q = 100 * MiB, WS_K = 116 * MiB, WS_V = 132 * MiB, WS_U = 148 * MiB, WS_Y = 164 * MiB, WS_SSMO = 188 * MiB, WS_PP = 100 * MiB, WS_END = 204 * MiB;
static_assert(WS_K == WS_Q + 16 * MiB && WS_V == WS_Q + 32 * MiB, "EpiQKVU pointer arithmetic");
constexpr int RING_BYTES = 131072, MISC_OFF = RING_BYTES, LDS_BYTES = 147456;

__device__ __forceinline__ float sigm(float w) { return __builtin_amdgcn_rcpf(1.f + __builtin_amdgcn_exp2f(-L2E * w)); }
__device__ __forceinline__ unsigned pkbf(float lo, float hi) { return pg8::cvt_pk_bf16(lo, hi); }
__device__ __forceinline__ float bflo(unsigned w) { return __uint_as_float(w << 16); }
__device__ __forceinline__ float bfhi(unsigned w) { return __uint_as_float(w & 0xffff0000u); }
template <int NP> __device__ __forceinline__ float rstd_row(const float* ssq, int row, float invn) {
    const f32x4* p = (const f32x4*)(ssq + (size_t)row * NP); float s = 0.f;
#pragma unroll
    for (int i = 0; i < NP / 4; ++i) { const f32x4 v = p[i]; s += (v[0] + v[1]) + (v[2] + v[3]); }
    return __builtin_amdgcn_rsqf(s * invn + 1e-6f);
}
__device__ __forceinline__ float wave_sum(float v) {
#pragma unroll
    for (int o = 1; o < 64; o <<= 1) v += __shfl_xor(v, o);
    return v;
}

struct EpiSwiglu {
    static constexpr bool PERM = true, AFTER_DRAIN = false;
    bf16_t* O; const float* ssq;
    __device__ __forceinline__ void operator()(const f32x4 (&acc)[2][2][4][2], const Unit& u, int wr, int wc, int fr, int fq) const {
        const int row0 = u.pm * BM + wr * 64 + fr, col0 = u.pn * 128 + wc * 32 + 8 * fq;
#pragma unroll
        for (int ai = 0; ai < 2; ++ai)
#pragma unroll
            for (int m = 0; m < 4; ++m) { asm volatile("" ::: "memory"); const int row = row0 + ai * HALF + m * 16; const float rs = rstd_row<16>(ssq, row, 1.f / 1024.f);
                const f32x4 a0 = acc[ai][0][m][0] * rs, a1 = acc[ai][0][m][1] * rs, b0 = acc[ai][1][m][0] * rs, b1 = acc[ai][1][m][1] * rs; f32x4 h0, h1;
#pragma unroll
                for (int e = 0; e < 4; ++e) { h0[e] = a0[e] * sigm(a0[e]) * b0[e]; h1[e] = a1[e] * sigm(a1[e]) * b1[e]; }
                u32x4 w; w.x = pkbf(h0[0], h0[1]); w.y = pkbf(h0[2], h0[3]); w.z = pkbf(h1[0], h1[1]); w.w = pkbf(h1[2], h1[3]);
                *(u32x4*)(O + (size_t)row * DFF + col0) = w; }
    }
};
template <bool NORM, bool OUTB> struct EpiRes {
    static constexpr bool PERM = true, AFTER_DRAIN = false;
    const float* base; float* out; bf16_t* xb; float* ssqo; const float* ssqi; float coef;
    __device__ __forceinline__ void operator()(const f32x4 (&acc)[2][2][4][2], const Unit& u, int wr, int wc, int fr, int fq) const {
        const int row0 = u.pm * BM + wr * 64 + fr, col0 = u.pn * BM + wc * 32 + 8 * fq;
#pragma unroll
        for (int ai = 0; ai < 2; ++ai)
#pragma unroll
            for (int m = 0; m < 4; ++m) { asm volatile("" ::: "memory"); const int row = row0 + ai * HALF + m * 16; float alpha = coef; if (NORM) alpha *= rstd_row<8>(ssqi, row, 1.f / 512.f); float ss = 0.f;
#pragma unroll
                for (int bj = 0; bj < 2; ++bj) { const size_t off = (size_t)row * DMODEL + col0 + bj * HALF;
                    const f32x4 v0 = *(const f32x4*)(base + off) + acc[ai][bj][m][0] * alpha, v1 = *(const f32x4*)(base + off + 4) + acc[ai][bj][m][1] * alpha;
                    *(f32x4*)(out + off) = v0; *(f32x4*)(out + off + 4) = v1;
                    if (OUTB) { u32x4 w; w.x = pkbf(v0[0], v0[1]); w.y = pkbf(v0[2], v0[3]); w.z = pkbf(v1[0], v1[1]); w.w = pkbf(v1[2], v1[3]); *(u32x4*)(xb + off) = w;
                        ss += (v0[0] * v0[0] + v0[1] * v0[1]) + (v0[2] * v0[2] + v0[3] * v0[3]) + (v1[0] * v1[0] + v1[1] * v1[1]) + (v1[2] * v1[2] + v1[3] * v1[3]); } }
                if (OUTB) { ss += __shfl_xor(ss, 16); ss += __shfl_xor(ss, 32); if (fq == 0) ssqo[(size_t)row * 16 + u.pn * 4 + wc] = ss; } }
    }
};
struct EpiQKVU {
    static constexpr bool PERM = true, AFTER_DRAIN = false;
    bf16_t *Q, *U; const float* ssq;
    __device__ __forceinline__ void operator()(const f32x4 (&acc)[2][2][4][2], const Unit& u, int wr, int wc, int fr, int fq) const {
        const int row0 = u.pm * BM + wr * 64 + fr, part = u.pn >> 1, c0 = (u.pn & 1) * 256 + wc * 32 + 8 * fq;
        bf16_t* dstb = Q + (size_t)part * (size_t)(8 * MiB); const float sc = part == 0 ? QSCALE : 1.f;
#pragma unroll
        for (int ai = 0; ai < 2; ++ai)
#pragma unroll
            for (int m = 0; m < 4; ++m) { asm volatile("" ::: "memory"); const int row = row0 + ai * HALF + m * 16; const float rs = rstd_row<16>(ssq, row, 1.f / 1024.f) * sc;
#pragma unroll
                for (int bj = 0; bj < 2; ++bj) { const int c = c0 + bj * HALF; const f32x4 v0 = acc[ai][bj][m][0] * rs, v1 = acc[ai][bj][m][1] * rs;
                    u32x4 w; w.x = pkbf(v0[0], v0[1]); w.y = pkbf(v0[2], v0[3]); w.z = pkbf(v1[0], v1[1]); w.w = pkbf(v1[2], v1[3]);
                    if (part < 3) *(u32x4*)(dstb + (size_t)row * HW + c) = w;
                    else { const int g = c >> 4, half = (c >> 3) & 1, b = row >> 13, t = row & 8191; *(u32x4*)(U + ((size_t)((b * NGRP + g) * SEQL + t)) * 16 + half * 8) = w; } } }
    }
};
struct EpiGlu {
    static constexpr bool PERM = true, AFTER_DRAIN = false;
    const bf16_t* Y; const float* bglu; bf16_t* O; float* ssqo;
    __device__ __forceinline__ void operator()(const f32x4 (&acc)[2][2][4][2], const Unit& u, int wr, int wc, int fr, int fq) const {
        const int row0 = u.pm * BM + wr * 64 + fr, c0 = u.pn * BM + wc * 32 + 8 * fq;
#pragma unroll
        for (int ai = 0; ai < 2; ++ai)
#pragma unroll
            for (int m = 0; m < 4; ++m) { asm volatile("" ::: "memory"); const int row = row0 + ai * HALF + m * 16; float ss = 0.f;
#pragma unroll
                for (int bj = 0; bj < 2; ++bj) { const int c = c0 + bj * HALF; const u32x4 yv = *(const u32x4*)(Y + (size_t)row * HW + c);
                    const f32x4 b0 = *(const f32x4*)(bglu + c), b1 = *(const f32x4*)(bglu + c + 4); const f32x4 a0 = acc[ai][bj][m][0] + b0, a1 = acc[ai][bj][m][1] + b1;
                    float o[8]; o[0] = bflo(yv.x) * sigm(a0[0]); o[1] = bfhi(yv.x) * sigm(a0[1]); o[2] = bflo(yv.y) * sigm(a0[2]); o[3] = bfhi(yv.y) * sigm(a0[3]);
                    o[4] = bflo(yv.z) * sigm(a1[0]); o[5] = bfhi(yv.z) * sigm(a1[1]); o[6] = bflo(yv.w) * sigm(a1[2]); o[7] = bfhi(yv.w) * sigm(a1[3]);
                    u32x4 w; w.x = pkbf(o[0], o[1]); w.y = pkbf(o[2], o[3]); w.z = pkbf(o[4], o[5]); w.w = pkbf(o[6], o[7]); *(u32x4*)(O + (size_t)row * HW + c) = w;
#pragma unroll
                    for (int e = 0; e < 8; ++e) ss += o[e] * o[e]; }
                ss += __shfl_xor(ss, 16); ss += __shfl_xor(ss, 32); if (fq == 0) ssqo[(size_t)row * 8 + u.pn * 4 + wc] = ss; }
    }
};
struct EpiBf16P {
    static constexpr bool PERM = true, AFTER_DRAIN = false;
    bf16_t* O;
    __device__ __forceinline__ void operator()(const f32x4 (&acc)[2][2][4][2], const Unit& u, int wr, int wc, int fr, int fq) const {
        const int row0 = u.pm * BM + wr * 64 + fr, c0 = u.pn * BM + wc * 32 + 8 * fq;
#pragma unroll
        for (int ai = 0; ai < 2; ++ai)
#pragma unroll
            for (int m = 0; m < 4; ++m) { asm volatile("" ::: "memory"); const int row = row0 + ai * HALF + m * 16;
#pragma unroll
                for (int bj = 0; bj < 2; ++bj) { const f32x4 v0 = acc[ai][bj][m][0], v1 = acc[ai][bj][m][1];
                    u32x4 w; w.x = pkbf(v0[0], v0[1]); w.y = pkbf(v0[2], v0[3]); w.z = pkbf(v1[0], v1[1]); w.w = pkbf(v1[2], v1[3]); *(u32x4*)(O + (size_t)row * DMODEL + c0 + bj * HALF) = w; } }
    }
};
struct EpiGate {
    static constexpr bool PERM = true, AFTER_DRAIN = false;
    const float* base; float* out; const bf16_t* pp; const float* ssqi; float* ssqo;
    __device__ __forceinline__ void operator()(const f32x4 (&acc)[2][2][4][2], const Unit& u, int wr, int wc, int fr, int fq) const {
        const int row0 = u.pm * BM + wr * 64 + fr, c0 = u.pn * BM + wc * 32 + 8 * fq;
#pragma unroll
        for (int ai = 0; ai < 2; ++ai)
#pragma unroll
            for (int m = 0; m < 4; ++m) { asm volatile("" ::: "memory"); const int row = row0 + ai * HALF + m * 16; const float rs = rstd_row<16>(ssqi, row, 1.f / 1024.f); float ss = 0.f;
#pragma unroll
                for (int bj = 0; bj < 2; ++bj) { const size_t off = (size_t)row * DMODEL + c0 + bj * HALF; const u32x4 pv = *(const u32x4*)(pp + off);
                    const f32x4 x0 = *(const f32x4*)(base + off), x1 = *(const f32x4*)(base + off + 4); const f32x4 a0 = acc[ai][bj][m][0] * rs, a1 = acc[ai][bj][m][1] * rs; f32x4 v0, v1;
                    v0[0] = x0[0] + sigm(a0[0]) * bflo(pv.x); v0[1] = x0[1] + sigm(a0[1]) * bfhi(pv.x); v0[2] = x0[2] + sigm(a0[2]) * bflo(pv.y); v0[3] = x0[3] + sigm(a0[3]) * bfhi(pv.y);
                    v1[0] = x1[0] + sigm(a1[0]) * bflo(pv.z); v1[1] = x1[1] + sigm(a1[1]) * bfhi(pv.z); v1[2] = x1[2] + sigm(a1[2]) * bflo(pv.w); v1[3] = x1[3] + sigm(a1[3]) * bfhi(pv.w);
                    *(f32x4*)(out + off) = v0; *(f32x4*)(out + off + 4) = v1;
                    ss += (v0[0] * v0[0] + v0[1] * v0[1]) + (v0[2] * v0[2] + v0[3] * v0[3]) + (v1[0] * v1[0] + v1[1] * v1[1]) + (v1[2] * v1[2] + v1[3] * v1[3]); }
                ss += __shfl_xor(ss, 16); ss += __shfl_xor(ss, 32); if (fq == 0) ssqo[(size_t)row * 16 + u.pn * 4 + wc] = ss; }
    }
};

__device__ __forceinline__ void tr_item(const float* src, int srcN, int k0, int c0, const float* gain, bf16_t* dst, int dstPitch, int dstRow0, LAS float* scr, int lane) {
#pragma unroll 8
    for (int i = 0; i < 32; ++i) { const int kk = 2 * i + (lane >> 5); float v = src[(size_t)(k0 + kk) * srcN + c0 + (lane & 31)]; if (gain) v *= gain[k0 + kk]; scr[kk * 33 + (lane & 31)] = v; }
    asm volatile("s_waitcnt lgkmcnt(0)" ::: "memory");
    const int c = lane & 7;
#pragma unroll
    for (int j = 0; j < 4; ++j) { const int n = (lane >> 3) + 8 * j; const LAS float* s = scr + (8 * c) * 33 + n;
        u32x4 o; o.x = pkbf(s[0 * 33], s[1 * 33]); o.y = pkbf(s[2 * 33], s[3 * 33]); o.z = pkbf(s[4 * 33], s[5 * 33]); o.w = pkbf(s[6 * 33], s[7 * 33]);
        *(u32x4*)(dst + (size_t)(dstRow0 + n) * dstPitch + k0 + 8 * c) = o; }
    asm volatile("s_waitcnt lgkmcnt(0)" ::: "memory");
}
__device__ __forceinline__ void tr_w13(const float* w1, const float* w3, const float* gain, bf16_t* dst, int item, LAS float* scr, int lane) {
    const int nblk = 5632 / 32, kb = item / nblk, nb = item % nblk, R0 = 32 * nb, tile = R0 >> 8, r = R0 & 255;
    tr_item(r < 128 ? w1 : w3, DFF, 64 * kb, 128 * tile + (r & 127), gain, dst, DMODEL, R0, scr, lane);
}
__device__ __forceinline__ void cis_d(double a, double& c, double& s) {
    const double k = rint(a * 0.63661977236758134);
    const double r = fma(-k, 6.123233995736766e-17, fma(-k, 1.5707963267948966, a)), r2 = r * r;
    const double sp = r * (1.0 + r2 * (-1.0 / 6 + r2 * (1.0 / 120 + r2 * (-1.0 / 5040 + r2 * (1.0 / 362880 + r2 * (-1.0 / 39916800 + r2 * (1.0 / 6227020800.0)))))));
    const double cp = 1.0 + r2 * (-0.5 + r2 * (1.0 / 24 + r2 * (-1.0 / 720 + r2 * (1.0 / 40320 + r2 * (-1.0 / 3628800 + r2 * (1.0 / 479001600.0 + r2 * (-1.0 / 87178291200.0)))))));
    const int q = ((int)k) & 3;
    c = (q == 0) ? cp : (q == 1) ? -sp : (q == 2) ? -cp : sp;
    s = (q == 0) ? sp : (q == 1) ? cp : (q == 2) ? -sp : -cp;
}
__device__ __forceinline__ float gelu_tanh(float y) { return y * sigm(1.5957691216057308f * (y + 0.044715f * y * y * y)); }

__device__ __forceinline__ void ssm_item(int bg, const bf16_t* U, const bf16_t* Ktab, const bf16_t* Pend, const bf16_t* Cc, const float* AP, bf16_t* Yout, LAS unsigned char* lds, int tid) {
    asm volatile("" : "+v"(tid));
    const int lane = tid & 63, wid = __builtin_amdgcn_readfirstlane(tid >> 6), fr = lane & 15, fq = lane >> 4;
    const int b = bg >> 5, g = bg & 31;
    const bf16_t* Ub = U + (size_t)bg * SEQL * 16; const bf16_t* Kt = Ktab + g * 4096; const bf16_t* Pe = Pend + g * 32768; const bf16_t* Cg = Cc + g * 32768; const float* APg = AP + g * 64 * 36;
    float a16r[4], a16i[4];
#pragma unroll
    for (int pt = 0; pt < 4; ++pt) { a16r[pt] = APg[(16 * pt + fr) * 36 + 32]; a16i[pt] = APg[(16 * pt + fr) * 36 + 33]; }
    const float a64r = APg[lane * 36 + 34], a64i = APg[lane * 36 + 35];
    float cr = 0.f, ci = 0.f;
    LAS float* Ebuf = (LAS float*)lds; LAS float* Cbuf = (LAS float*)(lds + 16384); LAS unsigned short* XP = (LAS unsigned short*)(lds + 32768) + wid * (16 * 136);
    const int slot = wid * 4 + fq;
    for (int seg = 0; seg < 4; ++seg) {
        const int c0 = seg * 128 + wid * 16;
        bf16x8 uf[8];
        { const bf16_t* ub = Ub + ((size_t)(c0 + fr) * 16 + (fq >> 1)) * 16 + 8 * (fq & 1); asm volatile("" : "+v"(ub));
#pragma unroll
        for (int ks = 0; ks < 8; ++ks) uf[ks] = *(const GAS bf16x8*)(ub + 32 * ks); }
        f32x4 S[8];
#pragma unroll
        for (int nt = 0; nt < 8; ++nt) { const bf16_t* pn = Pe + (16 * nt + fr) * 256 + 8 * fq; asm volatile("" : "+v"(pn) :: "memory"); S[nt] = (f32x4){0.f, 0.f, 0.f, 0.f};
#pragma unroll
            for (int ks = 0; ks < 8; ++ks) { const bf16x8 pf = *(const GAS bf16x8*)(pn + 32 * ks); S[nt] = __builtin_amdgcn_mfma_f32_16x16x32_bf16(uf[ks], pf, S[nt], 0, 0, 0); } }
        f32x4 Y[16];
#pragma unroll
        for (int tl = 0; tl < 16; ++tl) Y[tl] = (f32x4){0.f, 0.f, 0.f, 0.f};
#pragma unroll
        for (int d = 0; d < 16; ++d) { const int j = d - (fq >> 1); const bf16_t* kp = Kt + (j * 16 + fr) * 16 + 8 * (fq & 1); asm volatile("" : "+v"(kp) :: "memory"); bf16x8 kfv = (bf16x8){0, 0, 0, 0, 0, 0, 0, 0}; if (j >= 0) kfv = *(const GAS bf16x8*)kp;
#pragma unroll
            for (int ks = 0; ks < 8; ++ks) if (d + 2 * ks < 16) Y[d + 2 * ks] = __builtin_amdgcn_mfma_f32_16x16x32_bf16(kfv, uf[ks], Y[d + 2 * ks], 0, 0, 0); }
#pragma unroll
        for (int pt = 0; pt < 4; ++pt) { float xr = 0.f, xi = 0.f;
#pragma unroll
            for (int i = 0; i < 4; ++i) { const float nr = a16r[pt] * xr - a16i[pt] * xi + S[pt][i], ni = a16r[pt] * xi + a16i[pt] * xr + S[pt + 4][i]; xr = nr; xi = ni; }
            Ebuf[slot * 128 + 16 * pt + fr] = xr; Ebuf[slot * 128 + 64 + 16 * pt + fr] = xi; }
        __syncthreads();
        if (wid == 0) {
            for (int sl = 0; sl < 32; ++sl) { Cbuf[sl * 128 + lane] = cr; Cbuf[sl * 128 + 64 + lane] = ci; const float er = Ebuf[sl * 128 + lane], ei = Ebuf[sl * 128 + 64 + lane];
                const float nr = a64r * cr - a64i * ci + er, ni = a64r * ci + a64i * cr + ei; cr = nr; ci = ni; }
        }
        __syncthreads();
#pragma unroll
        for (int pt = 0; pt < 4; ++pt) { float xr = Cbuf[slot * 128 + 16 * pt + fr], xi = Cbuf[slot * 128 + 64 + 16 * pt + fr];
#pragma unroll
            for (int i = 0; i < 4; ++i) { const unsigned w = pkbf(xr, xi); XP[(4 * fq + i) * 136 + 16 * pt + fr] = (unsigned short)(w & 0xffffu); XP[(4 * fq + i) * 136 + 64 + 16 * pt + fr] = (unsigned short)(w >> 16);
                const float nr = a16r[pt] * xr - a16i[pt] * xi + S[pt][i], ni = a16r[pt] * xi + a16i[pt] * xr + S[pt + 4][i]; xr = nr; xi = ni; } }
        asm volatile("s_waitcnt lgkmcnt(0)" ::: "memory");
        bf16x8 xf[4];
#pragma unroll
        for (int ks = 0; ks < 4; ++ks) xf[ks] = *(const LAS bf16x8*)(XP + fr * 136 + 32 * ks + 8 * fq);
#pragma unroll
        for (int tl = 0; tl < 16; ++tl) { const bf16_t* cp = Cg + (tl * 16 + fr) * 128 + 8 * fq; asm volatile("" : "+v"(cp) :: "memory");
#pragma unroll
            for (int ks = 0; ks < 4; ++ks) { const bf16x8 cf = *(const GAS bf16x8*)(cp + 32 * ks); Y[tl] = __builtin_amdgcn_mfma_f32_16x16x32_bf16(cf, xf[ks], Y[tl], 0, 0, 0); } }
        bf16_t* yo = Yout + ((size_t)b * SEQL + (size_t)(c0 + fr) * 16) * HW + g * 16 + 4 * fq; asm volatile("" : "+v"(yo));
#pragma unroll
        for (int tl = 0; tl < 16; ++tl) { u32x2 w; w.x = pkbf(gelu_tanh(Y[tl][0]), gelu_tanh(Y[tl][1])); w.y = pkbf(gelu_tanh(Y[tl][2]), gelu_tanh(Y[tl][3])); *(GAS u32x2*)(yo + (size_t)tl * HW) = w; }
        asm volatile("s_waitcnt lgkmcnt(0)" ::: "memory");
    }
    __syncthreads();
}

struct Args { const float* in[30]; float* out; unsigned char* ws; };
#define CAS __attribute__((address_space(4)))

__global__ void __launch_bounds__(512, 2) mk_fwd(Args a) {
    extern __shared__ __attribute__((aligned(16))) unsigned char lds_raw[];
    cg::grid_group grid = cg::this_grid();
    LAS unsigned char* lds = (LAS unsigned char*)lds_raw;
    const int wave_s = __builtin_amdgcn_readfirstlane((int)(threadIdx.x >> 6));
#define IDS() const CAS Args* ap_ = (const CAS Args*)__builtin_amdgcn_kernarg_segment_ptr(); asm volatile("" : "+s"(ap_)); \
    int tid; asm volatile("v_mbcnt_lo_u32_b32 %0, -1, 0\n\tv_mbcnt_hi_u32_b32 %0, -1, %0" : "=v"(tid)); tid += wave_s * 64; const int lane = tid & 63, wave = __builtin_amdgcn_readfirstlane(tid >> 6); \
    const int G = gridDim.x, bx = blockIdx.x, vcu = (G % 8 == 0) ? (bx % 8) * (G / 8) + bx / 8 : bx; \
    const int gw = vcu * 8 + wave, NGW = G * 8, gt = bx * 512 + tid, NGT = G * 512; (void)lane; (void)gw; (void)NGW; (void)gt; (void)NGT; (void)vcu
#define INP(i) (ap_->in[i])
#define WSP(T, off) ((T*)(ap_->ws + (off)))
#define OUTP (ap_->out)
    {
        IDS();
        const float *x = INP(0), *pin = INP(1), *g_ffn1 = INP(2), *w1_a = INP(3), *w3_a = INP(4), *w2_a = INP(5), *g_mix = INP(6), *w_in = INP(7);
        const float *a_re = INP(9), *a_im = INP(10), *log_dt = INP(11), *b_re = INP(12), *b_im = INP(13);
        const float *w_glu = INP(17), *g_attn_out = INP(19), *g_ssm_out = INP(20), *w_out = INP(21), *g_ffn2 = INP(22), *w1_b = INP(23), *w3_b = INP(24), *w2_b = INP(25);
        const float *g_ple = INP(26), *w_ple_gate = INP(27), *w_ple_proj = INP(28);
        float* AP = WSP(float, WS_AP); float* BB = WSP(float, WS_BB); bf16_t* Wf = WSP(bf16_t, WS_WF); float* ssq0 = WSP(float, WS_SSQ0);
        bf16_t *W13a = WSP(bf16_t, WS_W13A), *W2a = WSP(bf16_t, WS_W2A), *Win = WSP(bf16_t, WS_WIN), *Wglu = WSP(bf16_t, WS_WGLU), *WoA = WSP(bf16_t, WS_WOA), *WoS = WSP(bf16_t, WS_WOS);
        bf16_t *W13b = WSP(bf16_t, WS_W13B), *W2b = WSP(bf16_t, WS_W2B), *Wg = WSP(bf16_t, WS_WG), *Wp = WSP(bf16_t, WS_WP), *PB = WSP(bf16_t, WS_PB), *XB = WSP(bf16_t, WS_XB);
        LAS float* scr = (LAS float*)(lds + wave * 16384);
        constexpr int I_13 = 16 * 176, I_2 = 44 * 32, I_IN = 16 * 64, I_GLU = 8 * 16, I_O = 8 * 32, I_G = 16 * 32, I_P = 4 * 32;
        constexpr int NITEMS = 2 * I_13 + 2 * I_2 + I_IN + I_GLU + 2 * I_O + I_G + I_P;
        for (int it = gw; it < NITEMS; it += NGW) {
            int r = it;
            if (r < I_13) { tr_w13(w1_a, w3_a, g_ffn1, W13a, r, scr, lane); continue; } r -= I_13;
            if (r < I_13) { tr_w13(w1_b, w3_b, g_ffn2, W13b, r, scr, lane); continue; } r -= I_13;
            if (r < I_2) { tr_item(w2_a, DMODEL, 64 * (r / 32), 32 * (r % 32), nullptr, W2a, DFF, 32 * (r % 32), scr, lane); continue; } r -= I_2;
            if (r < I_2) { tr_item(w2_b, DMODEL, 64 * (r / 32), 32 * (r % 32), nullptr, W2b, DFF, 32 * (r % 32), scr, lane); continue; } r -= I_2;
            if (r < I_IN) { const int R0 = 32 * (r % 64); tr_item(w_in, 2056, 64 * (r / 64), R0 < 1536 ? R0 : R0 + 8, g_mix, Win, DMODEL, R0, scr, lane); continue; } r -= I_IN;
            if (r < I_GLU) { tr_item(w_glu, HW, 64 * (r / 16), 32 * (r % 16), nullptr, Wglu, HW, 32 * (r % 16), scr, lane); continue; } r -= I_GLU;
            if (r < I_O) { tr_item(w_out, DMODEL, 64 * (r / 32), 32 * (r % 32), g_attn_out, WoA, HW, 32 * (r % 32), scr, lane); continue; } r -= I_O;
            if (r < I_O) { tr_item(w_out + (size_t)HW * DMODEL, DMODEL, 64 * (r / 32), 32 * (r % 32), g_ssm_out, WoS, HW, 32 * (r % 32), scr, lane); continue; } r -= I_O;
            if (r < I_G) { tr_item(w_ple_gate, DMODEL, 64 * (r / 32), 32 * (r % 32), g_ple, Wg, DMODEL, 32 * (r % 32), scr, lane); continue; } r -= I_G;
            tr_item(w_ple_proj, DMODEL, 64 * (r / 32), 32 * (r % 32), nullptr, Wp, PLE, 32 * (r % 32), scr, lane);
        }
        for (int m = gw; m < TOK; m += NGW) {
            const f32x4* xr = (const f32x4*)(x + (size_t)m * DMODEL) + lane; u32x2* o8 = (u32x2*)(XB + (size_t)m * DMODEL) + lane; float ss = 0.f;
#pragma unroll
            for (int j = 0; j < 4; ++j) { const f32x4 v = xr[64 * j]; ss += (v[0] * v[0] + v[1] * v[1]) + (v[2] * v[2] + v[3] * v[3]); u32x2 w; w.x = pkbf(v[0], v[1]); w.y = pkbf(v[2], v[3]); o8[64 * j] = w; }
            ss = wave_sum(ss); if (lane < 16) ssq0[(size_t)m * 16 + lane] = lane == 0 ? ss : 0.f;
            const f32x4 pv = *((const f32x4*)(pin + (size_t)m * PLE) + lane); u32x2 w; w.x = pkbf(pv[0], pv[1]); w.y = pkbf(pv[2], pv[3]); *((u32x2*)(PB + (size_t)m * PLE) + lane) = w;
        }
        if (gt < 16384) { const int n = gt >> 10, k = gt & 1023; const float v = n < 8 ? g_mix[k] * w_in[(size_t)k * 2056 + 1536 + n] : 0.f; Wf[gt] = (bf16_t)(pkbf(v, 0.f) & 0xffffu); }
        if (gt < 2048) {
            const int g = gt >> 6; const double dt = exp((double)log_dt[g]), ar = a_re[gt], ai = a_im[gt];
            double cs, sn; cis_d(dt * ai, cs, sn); const double dec = exp(dt * ar), Ar = dec * cs, Ai = dec * sn;
            const double nr = Ar - 1.0, ni = Ai, den = ar * ar + ai * ai, f_r = (nr * ar + ni * ai) / den, f_i = (ni * ar - nr * ai) / den;
            float* ap = AP + gt * 36; double pr = 1.0, pi = 0.0;
            for (int n = 0; n <= 16; ++n) { ap[2 * n] = (float)pr; ap[2 * n + 1] = (float)pi; if (n < 16) { const double t_ = pr * Ar - pi * Ai; pi = pr * Ai + pi * Ar; pr = t_; } }
            double qr = pr * pr - pi * pi, qi = 2.0 * pr * pi; const double q2r = qr * qr - qi * qi, q2i = 2.0 * qr * qi; ap[34] = (float)q2r; ap[35] = (float)q2i;
            for (int h = 0; h < 16; ++h) { const double br = b_re[gt * 16 + h], bi = b_im[gt * 16 + h]; BB[gt * 32 + 2 * h] = (float)(f_r * br - f_i * bi); BB[gt * 32 + 2 * h + 1] = (float)(f_r * bi + f_i * br); }
        }
    }
    grid.sync();

    {
        IDS();
        const float *c_re = INP(14), *c_im = INP(15), *d_skip = INP(16);
        const float* AP = WSP(float, WS_AP); const float* BB = WSP(float, WS_BB); bf16_t* Ktab = WSP(bf16_t, WS_KTAB); bf16_t* Pend = WSP(bf16_t, WS_PEND); bf16_t* Cc = WSP(bf16_t, WS_CC);
        for (int idx = gt; idx < 131072; idx += NGT) {
            const int g = idx >> 12, j = (idx >> 8) & 15, h = (idx >> 4) & 15, hp = idx & 15; float s = 0.f;
            for (int p = 0; p < 64; ++p) { const float Cr = c_re[(g * 16 + h) * 64 + p], Ci = c_im[(g * 16 + h) * 64 + p], Ar = AP[(g * 64 + p) * 36 + 2 * j], Ai = AP[(g * 64 + p) * 36 + 2 * j + 1];
                const float Wr = Cr * Ar - Ci * Ai, Wi = Cr * Ai + Ci * Ar, Br = BB[(g * 64 + p) * 32 + 2 * hp], Bi = BB[(g * 64 + p) * 32 + 2 * hp + 1]; s += Wr * Br - Wi * Bi; }
            if (j == 0 && h == hp) s += d_skip[g * 16 + h];
            Ktab[idx] = (bf16_t)(pkbf(s, 0.f) & 0xffffu);
        }
        for (int idx = gt; idx < 1048576; idx += NGT) {
            { const int g = idx >> 15, comp = (idx >> 8) & 127, k = idx & 255, p = comp & 63, im = comp >> 6, sl = k >> 4, hp = k & 15;
              const float Ar = AP[(g * 64 + p) * 36 + 2 * (15 - sl)], Ai = AP[(g * 64 + p) * 36 + 2 * (15 - sl) + 1], Br = BB[(g * 64 + p) * 32 + 2 * hp], Bi = BB[(g * 64 + p) * 32 + 2 * hp + 1];
              const float v = im ? (Ar * Bi + Ai * Br) : (Ar * Br - Ai * Bi); Pend[idx] = (bf16_t)(pkbf(v, 0.f) & 0xffffu); }
            { const int g = idx >> 15, n = (idx >> 7) & 255, tl = n >> 4, h = n & 15, comp = idx & 127, p = comp & 63, im = comp >> 6;
              const float Cr = c_re[(g * 16 + h) * 64 + p], Ci = c_im[(g * 16 + h) * 64 + p], Ar = AP[(g * 64 + p) * 36 + 2 * (tl + 1)], Ai = AP[(g * 64 + p) * 36 + 2 * (tl + 1) + 1];
              const float v = im ? -(Cr * Ai + Ci * Ar) : (Cr * Ar - Ci * Ai); Cc[idx] = (bf16_t)(pkbf(v, 0.f) & 0xffffu); }
        }
        pg8::Gemm gm{WSP(bf16_t, WS_XB), WSP(bf16_t, WS_W13A), TOK, 2 * DFF, DMODEL}; pg8::StaticOrder S; S.init(TOK, 2 * DFF, G, bx);
        EpiSwiglu E{WSP(bf16_t, WS_H1), WSP(float, WS_SSQ0)};
        pg8::gemm_phase<EpiSwiglu, pg8::StaticOrder, true, true>(lds, gm, S, E, tid);
    }
    grid.sync();
    {
        IDS();
        pg8::Gemm gm{WSP(bf16_t, WS_H1), WSP(bf16_t, WS_W2A), TOK, DMODEL, DFF}; pg8::StaticOrder S; S.init(TOK, DMODEL, G, bx);
        EpiRes<false, true> E{INP(0), OUTP, WSP(bf16_t, WS_XB), WSP(float, WS_SSQ1), nullptr, 0.5f};
        pg8::gemm_phase<EpiRes<false, true>, pg8::StaticOrder, true, true>(lds, gm, S, E, tid);
    }
    grid.sync();
    {
        IDS();
        const float* b_f = INP(8); const bf16_t* XB = WSP(bf16_t, WS_XB); const bf16_t* Wf = WSP(bf16_t, WS_WF); const float* ssq1 = WSP(float, WS_SSQ1); float* LOGF = WSP(float, WS_LOGF);
        const int fr = lane & 15, fq = lane >> 4;
        for (int it = gw; it < TOK / 16; it += NGW) {
            const int t0 = it * 16; f32x4 acc = (f32x4){0.f, 0.f, 0.f, 0.f};
            const bf16_t* ap = XB + (size_t)(t0 + fr) * DMODEL + 8 * fq; const bf16_t* bp = Wf + fr * DMODEL + 8 * fq;
#pragma unroll 8
            for (int ks = 0; ks < 32; ++ks) acc = __builtin_amdgcn_mfma_f32_16x16x32_bf16(*(const bf16x8*)(ap + 32 * ks), *(const bf16x8*)(bp + 32 * ks), acc, 0, 0, 0);
            if (fr < 8) { const int r0 = t0 + 4 * fq; const float bf = b_f[fr]; f32x4 o;
#pragma unroll
                for (int i = 0; i < 4; ++i) { const float z = rstd_row<16>(ssq1, r0 + i, 1.f / 1024.f) * acc[i] + bf; o[i] = fminf(z, 0.f) - log1pf(expf(-fabsf(z))); }
                *(f32x4*)(LOGF + (size_t)((r0 >> 13) * 8 + fr) * SEQL + (r0 & 8191)) = o; }
        }
        pg8::Gemm gm{XB, WSP(bf16_t, WS_WIN), TOK, 2048, DMODEL}; pg8::StaticOrder S; S.init(TOK, 2048, G, bx);
        EpiQKVU E{WSP(bf16_t, WS_Q), WSP(bf16_t, WS_U), ssq1};
        pg8::gemm_phase<EpiQKVU, pg8::StaticOrder, true, true>(lds, gm, S, E, tid);
    }
    grid.sync();
    {
        volatile LAS int* qs = (volatile LAS int*)(lds + MISC_OFF);
        for (;;) {
            IDS();
            if (tid == 0) qs[0] = (int)__hip_atomic_fetch_add(WSP(unsigned, WS_CTL) + 64, 1u, __ATOMIC_RELAXED, __HIP_MEMORY_SCOPE_AGENT);
            __syncthreads();
            const int item = __builtin_amdgcn_readfirstlane(qs[0]);
            __syncthreads();
            if (item >= 64 + 512) break;
            if (item < 64) ssm_item(item, WSP(bf16_t, WS_U), WSP(bf16_t, WS_KTAB), WSP(bf16_t, WS_PEND), WSP(bf16_t, WS_CC), WSP(float, WS_AP), WSP(bf16_t, WS_Y), lds, tid);
            else { const int ai_ = item - 64, qb = 31 - (ai_ >> 4), bh = ai_ & 15;
                attn_body::attn_unit<8>(bh >> 3, bh & 7, qb, WSP(attn_body::bf16, WS_Q), WSP(attn_body::bf16, WS_K), WSP(attn_body::bf16, WS_V), WSP(attn_body::bf16, WS_Q), WSP(float, WS_LOGF), WSP(float, WS_SSQA), (char*)lds_raw, tid); }
        }
    }
    grid.sync();
    {
        IDS();
        pg8::Gemm gm{WSP(bf16_t, WS_Y), WSP(bf16_t, WS_WGLU), TOK, HW, HW}; pg8::StaticOrder S; S.init(TOK, HW, G, bx);
        EpiGlu E{WSP(bf16_t, WS_Y), INP(18), WSP(bf16_t, WS_SSMO), WSP(float, WS_SSQS)};
        pg8::gemm_phase<EpiGlu, pg8::StaticOrder, true, true>(lds, gm, S, E, tid);
    }
    grid.sync();
    {
        { IDS(); pg8::Gemm gm{WSP(bf16_t, WS_Q), WSP(bf16_t, WS_WOA), TOK, DMODEL, HW}; pg8::StaticOrder S; S.init(TOK, DMODEL, G, bx);
          EpiRes<true, false> E{OUTP, OUTP, nullptr, nullptr, WSP(float, WS_SSQA), 1.f};
          pg8::gemm_phase<EpiRes<true, false>, pg8::StaticOrder, true, true>(lds, gm, S, E, tid); }
        { IDS(); pg8::Gemm gm{WSP(bf16_t, WS_SSMO), WSP(bf16_t, WS_WOS), TOK, DMODEL, HW}; pg8::StaticOrder S; S.init(TOK, DMODEL, G, bx);
          EpiRes<true, true> E{OUTP, OUTP, WSP(bf16_t, WS_XB), WSP(float, WS_SSQ2), WSP(float, WS_SSQS), 1.f};
          pg8::gemm_phase<EpiRes<true, true>, pg8::StaticOrder, true, true>(lds, gm, S, E, tid); }
    }
    grid.sync();
    {
        IDS();
        pg8::Gemm gm{WSP(bf16_t, WS_XB), WSP(bf16_t, WS_W13B), TOK, 2 * DFF, DMODEL}; pg8::StaticOrder S; S.init(TOK, 2 * DFF, G, bx);
        EpiSwiglu E{WSP(bf16_t, WS_H1), WSP(float, WS_SSQ2)};
        pg8::gemm_phase<EpiSwiglu, pg8::StaticOrder, true, true>(lds, gm, S, E, tid);
    }
    grid.sync();
    {
        IDS();
        pg8::Gemm gm{WSP(bf16_t, WS_H1), WSP(bf16_t, WS_W2B), TOK, DMODEL, DFF}; pg8::StaticOrder S; S.init(TOK, DMODEL, G, bx);
        EpiRes<false, true> E{OUTP, OUTP, WSP(bf16_t, WS_XB), WSP(float, WS_SSQ3), nullptr, 0.5f};
        pg8::gemm_phase<EpiRes<false, true>, pg8::StaticOrder, true, true>(lds, gm, S, E, tid);
    }
    grid.sync();
    {
        { IDS(); pg8::Gemm gm{WSP(bf16_t, WS_PB), WSP(bf16_t, WS_WP), TOK, DMODEL, PLE}; pg8::StaticOrder S; S.init(TOK, DMODEL, G, bx);
          EpiBf16P E{WSP(bf16_t, WS_PP)};
          pg8::gemm_phase<EpiBf16P, pg8::StaticOrder, true, true>(lds, gm, S, E, tid); }
        { IDS(); pg8::Gemm gm{WSP(bf16_t, WS_XB), WSP(bf16_t, WS_WG), TOK, DMODEL, DMODEL}; pg8::StaticOrder S; S.init(TOK, DMODEL, G, bx);
          EpiGate E{OUTP, OUTP, WSP(bf16_t, WS_PP), WSP(float, WS_SSQ3), WSP(float, WS_SSQ4)};
          pg8::gemm_phase<EpiGate, pg8::StaticOrder, true, true>(lds, gm, S, E, tid); }
    }
    grid.sync();
    { IDS(); const float* ssq4 = WSP(float, WS_SSQ4); float* out = OUTP; const float* g_final = INP(29);
    for (int m = gw; m < TOK; m += NGW) {
        const float rs = rstd_row<16>(ssq4, m, 1.f / 1024.f); f32x4* o = (f32x4*)(out + (size_t)m * DMODEL) + lane; const f32x4* gf = (const f32x4*)g_final + lane;
#pragma unroll
        for (int j = 0; j < 4; ++j) { const f32x4 v = o[64 * j], gg = gf[64 * j]; o[64 * j] = v * rs * gg; }
    } }
}

extern "C" void kernel_launch(void* const* d_in, const int* in_sizes, int n_in, void* d_out, int out_size, void* d_ws, size_t ws_size, hipStream_t stream) {
    static int grid = 0;
    if (grid == 0) {
        if (n_in != 30 || out_size != TOK * DMODEL || ws_size < WS_END) { fprintf(stderr, "kernel_launch: unexpected problem (n_in %d out %d ws %zu)\n", n_in, out_size, ws_size); grid = -1; return; }
        int dev = 0, cus = 0, per_cu = 0;
        (void)hipGetDevice(&dev); (void)hipDeviceGetAttribute(&cus, hipDeviceAttributeMultiprocessorCount, dev);
        if (hipFuncSetAttribute((const void*)mk_fwd, hipFuncAttributeMaxDynamicSharedMemorySize, LDS_BYTES) != hipSuccess) { fprintf(stderr, "kernel_launch: hipFuncSetAttribute failed\n"); grid = -1; return; }
        if (hipOccupancyMaxActiveBlocksPerMultiprocessor(&per_cu, (const void*)mk_fwd, 512, LDS_BYTES) != hipSuccess || per_cu < 1) { fprintf(stderr, "kernel_launch: occupancy query gave %d\n", per_cu); per_cu = 1; }
        (void)hipGetLastError();
        grid = cus * per_cu;
    }
    if (grid < 0) return;
    (void)hipMemsetAsync((char*)d_ws + WS_CTL, 0, 4096, stream);
    Args a{};
    for (int i = 0; i < 30; ++i) a.in[i] = (const float*)d_in[i];
    a.out = (float*)d_out; a.ws = (unsigned char*)d_ws;
    void* args[] = {&a};
    hipError_t e = hipLaunchCooperativeKernel((const void*)mk_fwd, dim3(grid), dim3(512), args, LDS_BYTES, stream);
    if (e != hipSuccess) fprintf(stderr, "kernel_launch: cooperative launch failed: %s (grid %d)\n", hipGetErrorString(e), grid);
}
```

```cpp
#include <hip/hip_runtime.h>
#include <hip/hip_bf16.h>
#include <cmath>
#include <hip/hip_cooperative_groups.h>
#include <cstdio>
#include <cstdint>
namespace cg = cooperative_groups;
template <int MASK> __device__ __forceinline__ float sx(float v) { return __builtin_bit_cast(float, __builtin_amdgcn_ds_swizzle(__builtin_bit_cast(int, v), (MASK << 10) | 0x1f)); }
__device__ __forceinline__ float sum32(float v) { unsigned a = __builtin_bit_cast(unsigned, v), b = a; asm volatile("v_nop\n\tv_nop\n\tv_permlane32_swap_b32 %0, %1" : "+v"(a), "+v"(b)); return __builtin_bit_cast(float, a) + __builtin_bit_cast(float, b); }
__device__ __forceinline__ float max32(float v) { unsigned a = __builtin_bit_cast(unsigned, v), b = a; asm volatile("v_nop\n\tv_nop\n\tv_permlane32_swap_b32 %0, %1" : "+v"(a), "+v"(b)); return __builtin_fmaxf(__builtin_bit_cast(float, a), __builtin_bit_cast(float, b)); }
namespace pg8 {
#define PG8_LAS __attribute__((address_space(3)))
typedef unsigned short bf16_t;
typedef short bf16x8 __attribute__((ext_vector_type(8)));
typedef float f32x4 __attribute__((ext_vector_type(4)));
typedef unsigned u32x4 __attribute__((ext_vector_type(4)));
constexpr int BM = 256, BK = 64, HALF = 128, HTB = HALF * BK * 2  , STAGE_BYTES = 8 * HTB, NXCD = 8, WGM = 8;

__host__ __device__ __forceinline__ int lds_byte(int r, int c) { const int st = (r >> 4) * 2 + (c >> 5), rr = r & 15, cc = c & 31, ob = rr * 64 + cc * 2; return st * 1024 + (ob ^ (((ob >> 9) & 1) << 5)); }
__host__ __device__ __forceinline__ void stage_rc(int b, int& R, int& C) { const int st = b / 1024, sb = b % 1024, swz = sb ^ (((sb >> 9) & 1) << 5); R = (st >> 1) * 16 + swz / 64; C = (st & 1) * 32 + (swz % 64) / 2; }
__host__ __device__ __forceinline__ int perm32(int rho) { const int n = rho >> 4, i = rho & 15; return 8 * (i >> 2) + 4 * n + (i & 3); }

struct Unit { int pm, pn; };
struct Gemm { const bf16_t* A; const bf16_t* Bt; int M, N, K; const bf16_t* A2 = nullptr; int lda = 0; };

struct StaticOrder {
    int nM, nN, nwg, G, c;
    __host__ __device__ void init(int M, int N, int G_, int c_) { nM = M / BM; nN = N / BM; nwg = nM * nN; G = G_; c = c_; }
    __host__ __device__ bool next(int i, Unit& u) const {
        const long L = (long)i * G + c; if (L >= nwg) return false;
        int wgid = (int)L; { const int q = nwg / NXCD, r = nwg % NXCD, xcd = wgid % NXCD, off = wgid / NXCD; wgid = (xcd < r ? xcd * (q + 1) : r * (q + 1) + (xcd - r) * q) + off; }
        const int nig = WGM * nN, gid = wgid / nig, fm = gid * WGM, gsz = (nM - fm) < WGM ? (nM - fm) : WGM;
        u.pm = fm + ((wgid % nig) % gsz); u.pn = (wgid % nig) / gsz; return true;
    }
    __device__ __forceinline__ void a_ready(const Unit&) const {}
    __device__ __forceinline__ void done(const Unit&) const {}
};

__device__ __forceinline__ unsigned cvt_pk_bf16(float lo, float hi) { unsigned r; asm volatile("v_cvt_pk_bf16_f32 %0, %1, %2" : "=v"(r) : "v"(lo), "v"(hi)); return r; }
typedef float f32x2 __attribute__((ext_vector_type(2)));
template <class Epi, class Sched, bool ALIGN_EPI = false, bool SP2 = false>
__device__ __forceinline__ void gemm_phase(PG8_LAS unsigned char* lds, const Gemm g, const Sched& S, const Epi& E, int tid_in) {
    int tid_ = tid_in; asm volatile("" : "+v"(tid_)); const int tid = tid_, wid = __builtin_amdgcn_readfirstlane(tid >> 6), lane = tid & 63, wr = wid >> 2, wc = wid & 3, fr = lane & 15, fq = lane >> 4;
    const int K = g.K, nt = K / BK, lda = g.lda ? g.lda : K, ksplit = g.A2 ? nt / 2 : nt;
    unsigned voffA[2], voffB[2];
#pragma unroll
    for (int i = 0; i < 2; ++i) { int R, C; stage_rc(tid * 16 + i * 8192, R, C); const int Rb = Epi::PERM ? ((R & ~31) + perm32(R & 31)) : R;
        voffA[i] = (unsigned)(R * lda + C) * 2u; voffB[i] = (unsigned)(Rb * K + C) * 2u; }
    const size_t kstep = (size_t)(BK * 2);
    const size_t hstep = (size_t)HALF * K * 2;
    const size_t tstep = 2 * hstep; const size_t hstepA = (size_t)HALF * lda * 2, tstepA = 2 * hstepA;
    const unsigned ldsw = (unsigned)wid * 1024u;
    const int aoff = lds_byte(wr * 64 + fr, fq * 8), boff = lds_byte(wc * 32 + fr, fq * 8);
#define PG8_SA(b, h) (((b) * 2 + (h)) * HTB)
#define PG8_SB(b, h) ((4 + (b) * 2 + (h)) * HTB)
#define PG8_STAGE(bufoff, gbase, voff) do { _Pragma("unroll") for (int _i = 0; _i < 2; ++_i) \
        __builtin_amdgcn_global_load_lds((const unsigned*)((const char*)(gbase) + (voff)[_i]), (PG8_LAS unsigned*)(lds + (bufoff) + ldsw + _i * 8192), 16, 0, 0); } while (0)
#define PG8_LDA(dst, b, h) do { _Pragma("unroll") for (int m = 0; m < 4; ++m) _Pragma("unroll") for (int k = 0; k < 2; ++k) dst[m][k] = *(const PG8_LAS bf16x8*)(lds + PG8_SA(b, h) + aoff + m * 2048 + k * 1024); } while (0)
#define PG8_LDB(dst, b, h) do { _Pragma("unroll") for (int n = 0; n < 2; ++n) _Pragma("unroll") for (int k = 0; k < 2; ++k) dst[n][k] = *(const PG8_LAS bf16x8*)(lds + PG8_SB(b, h) + boff + n * 2048 + k * 1024); } while (0)
#define PG8_MMA(ai, bj, At, Bt) do { __builtin_amdgcn_s_setprio(1); _Pragma("unroll") for (int m = 0; m < 4; ++m) _Pragma("unroll") for (int n = 0; n < 2; ++n) _Pragma("unroll") for (int k = 0; k < 2; ++k) \
        acc[ai][bj][m][n] = __builtin_amdgcn_mfma_f32_16x16x32_bf16(Bt[n][k], At[m][k], acc[ai][bj][m][n], 0, 0, 0); __builtin_amdgcn_s_setprio(0); } while (0)
#define PG8_WAIT_V(n) asm volatile("s_waitcnt vmcnt(" #n ")" ::: "memory")
#define PG8_WAIT_L(n) asm volatile("s_waitcnt lgkmcnt(" #n ")" ::: "memory")
#define PG8_BAR __builtin_amdgcn_s_barrier()
#define PG8_SCHED __builtin_amdgcn_sched_barrier(0)
    Unit cur, nxt; int ui = 0;
    if (!S.next(0, cur)) return;
    f32x4 acc[2][2][4][2];
#pragma unroll
    for (int a = 0; a < 2; ++a)
#pragma unroll
        for (int b = 0; b < 2; ++b)
#pragma unroll
            for (int m = 0; m < 4; ++m)
#pragma unroll
                for (int n = 0; n < 2; ++n) acc[a][b][m][n] = (f32x4){0.f, 0.f, 0.f, 0.f};
    bf16x8 At[4][2], B0[2][2], B1[2][2];
    const char* cA = (const char*)g.A + (size_t)cur.pm * tstepA; const char* cA2 = (const char*)g.A2 + (size_t)cur.pm * tstepA; const char* cB = (const char*)g.Bt + (size_t)cur.pn * tstep;
    S.a_ready(cur);
    if constexpr (SP2) {
        PG8_STAGE(PG8_SB(0, 0), cB, voffB); PG8_STAGE(PG8_SB(0, 1), cB + hstep, voffB); PG8_STAGE(PG8_SA(0, 0), cA, voffA); PG8_STAGE(PG8_SA(0, 1), cA + hstepA, voffA);
        if (wr == 1) PG8_BAR;
        PG8_WAIT_V(2); PG8_BAR;
        PG8_STAGE(PG8_SB(1, 0), cB + kstep, voffB); PG8_STAGE(PG8_SA(1, 0), cA + kstep, voffA); PG8_STAGE(PG8_SB(1, 1), cB + hstep + kstep, voffB);
        PG8_WAIT_V(6); PG8_BAR;
    } else {
        PG8_STAGE(PG8_SB(0, 0), cB, voffB); PG8_STAGE(PG8_SA(0, 0), cA, voffA); PG8_STAGE(PG8_SB(0, 1), cB + hstep, voffB); PG8_STAGE(PG8_SA(0, 1), cA + hstepA, voffA);
        if (wr == 1) PG8_BAR;
        PG8_WAIT_V(4); PG8_BAR;
        PG8_STAGE(PG8_SB(1, 0), cB + kstep, voffB); PG8_STAGE(PG8_SA(1, 0), cA + kstep, voffA); PG8_STAGE(PG8_SB(1, 1), cB + hstep + kstep, voffB);
        PG8_WAIT_V(6); PG8_BAR;
    }
    for (;;) {
        const bool has_next = S.next(ui + 1, nxt);
        const char* nA = has_next ? (const char*)g.A + (size_t)nxt.pm * tstepA : cA; const char* nA2 = has_next ? (const char*)g.A2 + (size_t)nxt.pm * tstepA : cA2; const char* nB = has_next ? (const char*)g.Bt + (size_t)nxt.pn * tstep : cB;
        for (int t = 0; t < nt; t += 2) {
            const bool last = (t == nt - 2);
            const char* a1 = (t + 1 < ksplit) ? cA + (size_t)(t + 1) * kstep : cA2 + (size_t)(t + 1 - ksplit) * kstep;
            const char* a2 = last ? nA : ((t + 2 < ksplit) ? cA + (size_t)(t + 2) * kstep : cA2 + (size_t)(t + 2 - ksplit) * kstep); const char* b2 = last ? nB : cB + (size_t)(t + 2) * kstep;
            const char* a3 = a2 + kstep; const char* b3 = b2 + kstep;
            if (last && has_next) S.a_ready(nxt);
            if constexpr (Epi::MIDK) { if (t == nt / 2) { int l_; asm volatile("v_mbcnt_lo_u32_b32 %0, -1, 0\n\tv_mbcnt_hi_u32_b32 %0, -1, %0" : "=v"(l_)); E.mid(acc, cur, wr, wc, l_ & 15, l_ >> 4); } }
            if constexpr (SP2) {
            PG8_LDB(B0, 0, 0); PG8_LDB(B1, 0, 1); PG8_SCHED; PG8_LDA(At, 0, 0); PG8_STAGE(PG8_SA(1, 1), a1 + hstepA, voffA);
            PG8_WAIT_V(8); PG8_WAIT_L(0); PG8_BAR; PG8_MMA(0, 0, At, B0); PG8_MMA(0, 1, At, B1); PG8_BAR; PG8_SCHED;
            PG8_LDA(At, 0, 1); PG8_STAGE(PG8_SB(0, 0), b2, voffB); PG8_STAGE(PG8_SB(0, 1), b2 + hstep, voffB); PG8_STAGE(PG8_SA(0, 0), a2, voffA);
            PG8_WAIT_V(8); PG8_WAIT_L(0); PG8_BAR; PG8_MMA(1, 0, At, B0); PG8_MMA(1, 1, At, B1); PG8_BAR; PG8_SCHED;
            PG8_LDB(B0, 1, 0); PG8_LDB(B1, 1, 1); PG8_SCHED; PG8_LDA(At, 1, 0); PG8_STAGE(PG8_SA(0, 1), a2 + hstepA, voffA);
            PG8_WAIT_V(8); PG8_WAIT_L(0); PG8_BAR; PG8_MMA(0, 0, At, B0); PG8_MMA(0, 1, At, B1); PG8_BAR; PG8_SCHED;
            PG8_LDA(At, 1, 1); PG8_STAGE(PG8_SB(1, 0), b3, voffB); PG8_STAGE(PG8_SB(1, 1), b3 + hstep, voffB); PG8_STAGE(PG8_SA(1, 0), a3, voffA);
            PG8_WAIT_V(8); PG8_WAIT_L(0); PG8_BAR; PG8_MMA(1, 0, At, B0); PG8_MMA(1, 1, At, B1); PG8_BAR; PG8_SCHED;
            } else {
            PG8_LDB(B0, 0, 0); PG8_SCHED; PG8_LDA(At, 0, 0); PG8_STAGE(PG8_SA(1, 1), a1 + hstepA, voffA);
            PG8_WAIT_L(8); PG8_BAR; PG8_WAIT_L(0); PG8_MMA(0, 0, At, B0); PG8_BAR; PG8_SCHED;
            PG8_LDB(B1, 0, 1); PG8_STAGE(PG8_SB(0, 0), b2, voffB);
            PG8_BAR; PG8_WAIT_L(0); PG8_MMA(0, 1, At, B1); PG8_BAR;
            PG8_LDA(At, 0, 1); PG8_STAGE(PG8_SA(0, 0), a2, voffA);
            PG8_BAR; PG8_WAIT_L(0); PG8_MMA(1, 0, At, B0); PG8_BAR; PG8_SCHED;
            PG8_STAGE(PG8_SB(0, 1), b2 + hstep, voffB);
            PG8_WAIT_V(6); PG8_BAR; PG8_MMA(1, 1, At, B1); PG8_BAR;
            PG8_LDB(B0, 1, 0); PG8_SCHED; PG8_LDA(At, 1, 0); PG8_STAGE(PG8_SA(0, 1), a2 + hstepA, voffA);
            PG8_WAIT_L(8); PG8_BAR; PG8_WAIT_L(0); PG8_MMA(0, 0, At, B0); PG8_BAR; PG8_SCHED;
            PG8_LDB(B1, 1, 1); PG8_STAGE(PG8_SB(1, 0), b3, voffB);
            PG8_BAR; PG8_WAIT_L(0); PG8_MMA(0, 1, At, B1); PG8_BAR;
            PG8_LDA(At, 1, 1); PG8_STAGE(PG8_SA(1, 0), a3, voffA);
            PG8_BAR; PG8_WAIT_L(0); PG8_MMA(1, 0, At, B0); PG8_BAR; PG8_SCHED;
            PG8_STAGE(PG8_SB(1, 1), b3 + hstep, voffB);
            PG8_WAIT_V(6); PG8_BAR; PG8_MMA(1, 1, At, B1); PG8_BAR;
            }
        }
        if constexpr (ALIGN_EPI) { if (wr == 0) PG8_BAR; }
        if constexpr (!Epi::AFTER_DRAIN) { int l_; asm volatile("v_mbcnt_lo_u32_b32 %0, -1, 0\n\tv_mbcnt_hi_u32_b32 %0, -1, %0" : "=v"(l_)); E(acc, cur, wr, wc, l_ & 15, l_ >> 4); S.done(cur); }
        if (!has_next) break;
#pragma unroll
        for (int a = 0; a < 2; ++a)
#pragma unroll
            for (int b = 0; b < 2; ++b)
#pragma unroll
                for (int m = 0; m < 4; ++m)
#pragma unroll
                    for (int n = 0; n < 2; ++n) acc[a][b][m][n] = (f32x4){0.f, 0.f, 0.f, 0.f};
        cur = nxt; cA = nA; cA2 = nA2; cB = nB; ++ui;
        if constexpr (ALIGN_EPI) { if (wr == 1) PG8_BAR; }
    }
    PG8_WAIT_V(0);
    if constexpr (!ALIGN_EPI) { if (wr == 0) PG8_BAR; }
    PG8_BAR;
    if constexpr (Epi::AFTER_DRAIN) { E.fused(acc, cur, wr, wc, fr, fq, lds, wid, lane); S.done(cur); }
#undef PG8_SA
#undef PG8_SB
#undef PG8_STAGE
#undef PG8_LDA
#undef PG8_LDB
#undef PG8_MMA
#undef PG8_WAIT_V
#undef PG8_WAIT_L
#undef PG8_BAR
#undef PG8_SCHED
}
}

#ifndef PG8_SP2
#define PG8_SP2 true
#endif
#ifndef PG8_ALIGN
#define PG8_ALIGN true
#endif
#include <hip/hip_bf16.h>
#include <cmath>
namespace attn_body {
using bf16=__hip_bfloat16;
using bf16x8=__attribute__((ext_vector_type(8)))short;
using s16x4=__attribute__((ext_vector_type(4)))short;
using f32x16=__attribute__((ext_vector_type(16)))float;
using u32x4=__attribute__((ext_vector_type(4)))unsigned;
using f32x4v=__attribute__((ext_vector_type(4)))float;
constexpr int BATCH=2,NHEAD=8,SEQ=8192,D=64,DM=NHEAD*D;
constexpr int NW=8,QBLK=32,QB=QBLK*NW,KVBLK=64,NQB=SEQ/QB;
constexpr int ATTN_PITCH=DM, ATTN_UNIT_ROWS=QB;
__device__ __forceinline__ int crow(int r,int hi){return (r&3)+8*(r>>2)+4*hi;}
#define SBAR() __builtin_amdgcn_sched_barrier(0)
__device__ __forceinline__ void cmask(f32x16&p0,f32x16&p1,int jb,int qrel,int hi){
  const float NEG=-INFINITY; int kb=64*jb+4*hi;
  #pragma unroll
  for(int r=0;r<16;++r){int kv=kb+(r&3)+8*(r>>2); if(kv>qrel)p0[r]=NEG; if(kv+32>qrel)p1[r]=NEG;}
}

constexpr int NSLOT=3, SLOTB=8192;
constexpr int LDS_K=0, LDS_V=NSLOT*SLOTB, LDS_WS=2*NSLOT*SLOTB, LDS_OST=LDS_WS+NW*64*4, LDS_BIAS=LDS_OST+NW*4096, LDS_WT=LDS_BIAS+SEQ*4, LDS_BYTES=LDS_WT+64;
constexpr float C2=0.125f*1.4426950408889634f;
__device__ __forceinline__ void glds16(const void*gsrc,unsigned lds_dst){unsigned keep;
  asm volatile("s_mov_b32 %0, m0\n\ts_mov_b32 m0, %2\n\ts_nop 0\n\tglobal_load_lds_dwordx4 %1, off\n\ts_mov_b32 m0, %0":"=&s"(keep):"v"(gsrc),"s"(lds_dst):"memory");}
__device__ __forceinline__ float max3f(float a,float b,float c){float r;asm("v_max3_f32 %0, %1, %2, %3":"=v"(r):"v"(a),"v"(b),"v"(c));return r;}
__device__ __forceinline__ float max2f(float a,float b){float r;asm("v_max_f32_e32 %0, %1, %2":"=v"(r):"v"(a),"v"(b));return r;}
__device__ __forceinline__ float fadd_s(float a,float b){float r;asm("v_add_f32_e32 %0, %1, %2":"=v"(r):"v"(a),"v"(b));return r;}
__device__ __forceinline__ float fsub_s(float a,float b){float r;asm("v_sub_f32_e32 %0, %1, %2":"=v"(r):"v"(a),"v"(b));return r;}
typedef float f32x2_t __attribute__((ext_vector_type(2))); typedef __bf16 bf16x2_t __attribute__((ext_vector_type(2)));
__device__ __forceinline__ unsigned cvtpk_s(float lo,float hi){f32x2_t v={lo,hi};bf16x2_t b=__builtin_convertvector(v,bf16x2_t);return __builtin_bit_cast(unsigned,b);}
#define WAIT_BAR(N) asm volatile("s_waitcnt vmcnt(" #N ") lgkmcnt(0)\n\ts_barrier":::"memory")

__device__ __forceinline__ void qkt(f32x16&p0,f32x16&p1,const char*Kslot,const bf16x8*qr,int r32,int hi){
  const char*kb=Kslot+hi*1024+r32*16;
  #pragma unroll
  for(int d0=0;d0<4;++d0){
    const bf16x8 b0=*reinterpret_cast<const bf16x8*>(kb+d0*2048);
    const bf16x8 b1=*reinterpret_cast<const bf16x8*>(kb+d0*2048+512);
    p0=__builtin_amdgcn_mfma_f32_32x32x16_bf16(b0,qr[d0],p0,0,0,0);p1=__builtin_amdgcn_mfma_f32_32x32x16_bf16(b1,qr[d0],p1,0,0,0);}
}
typedef __attribute__((address_space(3))) const char* lds_cptr;
typedef short v4i16_t __attribute__((ext_vector_type(4)));
__device__ __forceinline__ void kload8(bf16x8*kf,lds_cptr kp){
  kf[0]=*(const __attribute__((address_space(3))) bf16x8*)(kp);      kf[1]=*(const __attribute__((address_space(3))) bf16x8*)(kp+512);
  kf[2]=*(const __attribute__((address_space(3))) bf16x8*)(kp+2048); kf[3]=*(const __attribute__((address_space(3))) bf16x8*)(kp+2560);
  kf[4]=*(const __attribute__((address_space(3))) bf16x8*)(kp+4096); kf[5]=*(const __attribute__((address_space(3))) bf16x8*)(kp+4608);
  kf[6]=*(const __attribute__((address_space(3))) bf16x8*)(kp+6144); kf[7]=*(const __attribute__((address_space(3))) bf16x8*)(kp+6656);
}
__device__ __forceinline__ void kload2(bf16x8*kf,lds_cptr kp,int j){ kf[2*j]=*(const __attribute__((address_space(3))) bf16x8*)(kp+j*2048); kf[2*j+1]=*(const __attribute__((address_space(3))) bf16x8*)(kp+j*2048+512); }
__device__ __forceinline__ s16x4 vtr(lds_cptr p){ return __builtin_bit_cast(s16x4,__builtin_amdgcn_ds_read_tr16_b64_v4i16((__attribute__((address_space(3))) v4i16_t*)p)); }
__device__ __forceinline__ float rowmax(const f32x16&p0,const f32x16&p1){
  float a=max3f(p0[0],p0[1],p1[0]),b=max3f(p0[2],p0[3],p1[1]);a=max3f(a,p1[2],p1[3]);
  #pragma unroll
  for(int r=4;r<16;r+=4){a=max3f(a,p0[r],p0[r+1]);b=max3f(b,p0[r+2],p0[r+3]);a=max3f(a,p1[r],p1[r+1]);b=max3f(b,p1[r+2],p1[r+3]);}
  const float m=max2f(a,b);
  auto rr=__builtin_amdgcn_permlane32_swap(__float_as_uint(m),__float_as_uint(m),false,false);
  return max2f(__uint_as_float(rr[0]),__uint_as_float(rr[1]));
}
__device__ __forceinline__ void pv(f32x16*o,int vb,bf16x8 pa0,bf16x8 pa1,bf16x8 pa2,bf16x8 pa3){
  #pragma unroll
  for(int d0=0;d0<2;++d0){s16x4 lo[4],hi[4];
    #pragma unroll
    for(int ks=0;ks<4;++ks){
      asm volatile("ds_read_b64_tr_b16 %0,%1 offset:%c2":"=&v"(lo[ks]):"v"(vb),"i"(d0*4096+ks*1024):"memory");
      asm volatile("ds_read_b64_tr_b16 %0,%1 offset:%c2":"=&v"(hi[ks]):"v"(vb),"i"(d0*4096+ks*1024+512):"memory");}
    asm volatile("s_waitcnt lgkmcnt(0)":::"memory");SBAR();
    #define PK(k) (bf16x8){lo[k][0],lo[k][1],lo[k][2],lo[k][3],hi[k][0],hi[k][1],hi[k][2],hi[k][3]}
    o[d0]=__builtin_amdgcn_mfma_f32_32x32x16_bf16(pa0,PK(0),o[d0],0,0,0);
    o[d0]=__builtin_amdgcn_mfma_f32_32x32x16_bf16(pa1,PK(1),o[d0],0,0,0);
    o[d0]=__builtin_amdgcn_mfma_f32_32x32x16_bf16(pa2,PK(2),o[d0],0,0,0);
    o[d0]=__builtin_amdgcn_mfma_f32_32x32x16_bf16(pa3,PK(3),o[d0],0,0,0);
    #undef PK
  }
}

#ifndef ATTN_STORE16
#define ATTN_STORE16(p,v) (*(u32x4*)(p)=(v))
#endif
template<int THRL> __device__ __forceinline__ void attn_unit(int b,int h,int qb,int tb_in,int te,int mode,float*__restrict__ part,unsigned*pcnt,const unsigned*kmaxp,const bf16*Q,const bf16*__restrict__ K,const bf16*__restrict__ V,bf16*O,const float*__restrict__ logf,float*__restrict__ ssqA,char*shm,int tid_in){
  int tid_=tid_in; asm volatile("":"+v"(tid_)); const int tid=tid_,lane=tid&63,r32=lane&31,hi=lane>>5; const int wid=__builtin_amdgcn_readfirstlane(tid>>6);
  const long rowbase=(long)b*SEQ; const int q0=qb*QB;
  const bf16*Qw=Q+(rowbase+q0+wid*QBLK)*DM+h*D;
  const lds_cptr shm3=(lds_cptr)shm;
  typedef __attribute__((address_space(3))) float* lds_fptr; typedef __attribute__((address_space(3))) f32x4v* lds_f4ptr;
  const lds_fptr biasL=(lds_fptr)(shm3+LDS_BIAS); const lds_fptr wtot=(lds_fptr)(shm3+LDS_WT);
  bf16x8 qr[4];
  #pragma unroll
  for(int d0=0;d0<4;++d0)qr[d0]=*reinterpret_cast<const bf16x8*>(&Qw[(long)r32*DM+d0*16+hi*8]);
  float qn=0.f;
  #pragma unroll
  for(int d0=0;d0<4;++d0){
    #pragma unroll
    for(int e=0;e<8;++e){const float qv=__uint_as_float(((unsigned)(unsigned short)qr[d0][e])<<16);qn+=qv*qv;}}
  qn=sum32(qn);
  qn=__builtin_fmaxf(qn,sx<1>(qn));qn=__builtin_fmaxf(qn,sx<2>(qn));qn=__builtin_fmaxf(qn,sx<4>(qn));qn=__builtin_fmaxf(qn,sx<8>(qn));qn=__builtin_fmaxf(qn,sx<16>(qn));
  { const int nkeys=q0+QB; const int k0=tid*16; const float*lf=logf+(long)(b*NHEAD+h)*SEQ+k0;
    f32x4v v0={0.f,0.f,0.f,0.f},v1=v0,v2=v0,v3=v0;
    if(k0<nkeys){v0=*(const f32x4v*)(lf);v1=*(const f32x4v*)(lf+4);v2=*(const f32x4v*)(lf+8);v3=*(const f32x4v*)(lf+12);}
    const float tot=((v0[0]+v0[1])+(v0[2]+v0[3]))+((v1[0]+v1[1])+(v1[2]+v1[3]))+((v2[0]+v2[1])+(v2[2]+v2[3]))+((v3[0]+v3[1])+(v3[2]+v3[3]));
    float x=tot;
    #pragma unroll
    for(int off=1;off<64;off<<=1){const float y=__builtin_bit_cast(float,__builtin_amdgcn_ds_bpermute(((lane+off)&63)<<2,__builtin_bit_cast(int,x)));if(lane+off<64)x+=y;}
    if(lane==0){wtot[wid]=x;wtot[8+wid]=qn;}
    __syncthreads();
    float wsum=0.f;
    #pragma unroll
    for(int w=1;w<NW;++w){const float t_=wtot[w];if(w>wid)wsum+=t_;}
    float run=(x-tot)+wsum;
    if(k0<nkeys){ const float L2E=1.4426950408889634f; f32x4v o0,o1,o2,o3;
      o3[3]=run*L2E;run+=v3[3];o3[2]=run*L2E;run+=v3[2];o3[1]=run*L2E;run+=v3[1];o3[0]=run*L2E;run+=v3[0];
      o2[3]=run*L2E;run+=v2[3];o2[2]=run*L2E;run+=v2[2];o2[1]=run*L2E;run+=v2[1];o2[0]=run*L2E;run+=v2[0];
      o1[3]=run*L2E;run+=v1[3];o1[2]=run*L2E;run+=v1[2];o1[1]=run*L2E;run+=v1[1];o1[0]=run*L2E;run+=v1[0];
      o0[3]=run*L2E;run+=v0[3];o0[2]=run*L2E;run+=v0[2];o0[1]=run*L2E;run+=v0[1];o0[0]=run*L2E;
      lds_f4ptr bo=(lds_f4ptr)(biasL+k0); bo[0]=o0;bo[1]=o1;bo[2]=o2;bo[3]=o3; }
    __syncthreads(); }
  int tb=tb_in; bool emptyA=false;
  { float qmx=wtot[8];
    #pragma unroll
    for(int w=1;w<NW;++w)qmx=__builtin_fmaxf(qmx,wtot[8+w]);
    const float kmx=__uint_as_float(__hip_atomic_load(kmaxp,__ATOMIC_RELAXED,__HIP_MEMORY_SCOPE_AGENT))+__uint_as_float(__hip_atomic_load(kmaxp+1,__ATOMIC_RELAXED,__HIP_MEMORY_SCOPE_AGENT));
    const float Bq=__builtin_sqrtf(qmx*kmx)*1.02f;   const float thr=biasL[q0]-150.f-2.f*Bq;
    const int ntf=(q0+QB)/KVBLK; const int skipf=(tid<ntf)?(biasL[KVBLK*tid+KVBLK-1]<thr?1:0):0;
    const unsigned long long bal=__ballot(skipf);
    __syncthreads();
    if(lane==0&&wid<2)wtot[wid]=(float)__popcll(bal);
    __syncthreads();
    int t0=((int)wtot[0]+(int)wtot[1])&~1; emptyA=(mode==1&&t0>=te); if(t0>te-4)t0=te-4; if(t0>tb)tb=t0;
    __syncthreads(); }
  if(!emptyA){
  const bf16*Kh=K+(rowbase+(long)tb*KVBLK)*DM+h*D,*Vh=V+(rowbase+(long)tb*KVBLK)*DM+h*D;
  const unsigned lds0=(unsigned)(uintptr_t)shm;
  float*wsf=(float*)(shm+LDS_WS)+wid*64;
  const bf16*ksrc=Kh+(long)lane*DM+wid*8;
  const bf16*vsrc=Vh+(long)(16*(wid&3)+(lane>>2))*DM+(wid>>2)*32+(lane&3)*8;
  const unsigned kdst=lds0+LDS_K+wid*1024, vdst=lds0+LDS_V+wid*1024;
  #define DMA_K(t,slot) glds16(ksrc+(long)(t)*KVBLK*DM,(unsigned)__builtin_amdgcn_readfirstlane(kdst+(slot)))
  #define DMA_V(t,slot) glds16(vsrc+(long)(t)*KVBLK*DM,(unsigned)__builtin_amdgcn_readfirstlane(vdst+(slot)))
  const int vb0=(int)(lds0+LDS_V)+((lane>>4)&1)*32+(lane&3)*8+(4*hi+((lane&15)>>2))*64;
  const char*Kbase=shm+LDS_K; bf16x8 kf[8];
  const lds_cptr kp0=shm3+LDS_K+hi*1024+r32*16; const lds_cptr vp0=shm3+LDS_V+((lane>>4)&1)*32+(lane&3)*8+(4*hi+((lane&15)>>2))*64;
  const int NT=te-tb;
  const lds_fptr biasp=biasL+4*hi+tb*KVBLK;
  #define BLD(X0,X1,tt) do{ const lds_fptr bp_=biasp+(tt)*KVBLK; \
    _Pragma("unroll") for(int j_=0;j_<4;++j_){ const f32x4v a_=*(const lds_f4ptr)(bp_+8*j_); const f32x4v b_=*(const lds_f4ptr)(bp_+32+8*j_); \
      X0[4*j_]=a_[0];X0[4*j_+1]=a_[1];X0[4*j_+2]=a_[2];X0[4*j_+3]=a_[3]; X1[4*j_]=b_[0];X1[4*j_+1]=b_[1];X1[4*j_+2]=b_[2];X1[4*j_+3]=b_[3]; } }while(0)
  #define BSUB(X,B) do{ const f32x2_t mh2_={mhat,mhat}; _Pragma("unroll") for(int r_=(B);r_<(B)+8;r_+=2){ f32x2_t t_={X[r_],X[r_+1]}; t_=t_-mh2_; X[r_]=t_.x; X[r_+1]=t_.y; } }while(0)
  DMA_K(0,0);DMA_V(0,0);DMA_K(1,SLOTB);
  float mhat=0.f,l_reg=0.f;f32x16 o[2];o[0]=f32x16{};o[1]=f32x16{};
  const int qrel=wid*QBLK+r32;
  #define CMASK(P0,P1,t) do{int jb_=(t)-(NT-4); if(jb_>=0&&mode!=1)cmask(P0,P1,jb_,qrel,hi);}while(0)
  bool resc=false;
  #define START(P0,P1) do{ const float rm=rowmax(P0,P1); resc=false; \
    { const float dl=rm; mhat=fadd_s(mhat,dl); \
      _Pragma("unroll") for(int r=0;r<16;++r){P0[r]=fsub_s(P0[r],dl);P1[r]=fsub_s(P1[r],dl);} } \
    _Pragma("unroll") for(int r=0;r<16;++r)P0[r]=__builtin_amdgcn_exp2f(P0[r]); }while(0)
  #define RESC() do{ if(resc){ asm volatile("s_waitcnt lgkmcnt(0)":::"memory"); \
      _Pragma("unroll") for(int d_=0;d_<2;++d_) _Pragma("unroll") for(int r=0;r<16;++r)o[d_][r]*=wsf[crow(r,hi)]; } }while(0)
  f32x16 pA0,pA1,pB0,pB1;
  int sl_prev=0,sl_cur=0,sl_next=SLOTB;
  #define ROT() do{sl_prev=sl_cur;sl_cur=sl_next;sl_next=(sl_next==(NSLOT-1)*SLOTB)?0:sl_next+SLOTB;}while(0)
  DMA_K(2,2*SLOTB);
  WAIT_BAR(3);
  BLD(pA0,pA1,0);
  qkt(pA0,pA1,Kbase,qr,r32,hi);asm volatile("s_nop 15\n\ts_nop 7":"+v"(pA0),"+v"(pA1));CMASK(pA0,pA1,0);
  START(pA0,pA1);
  _Pragma("unroll") for(int r=0;r<16;++r)pA1[r]=__builtin_amdgcn_exp2f(pA1[r]);
  BLD(pB0,pB1,1); BSUB(pB0,0); BSUB(pB0,8); BSUB(pB1,0); BSUB(pB1,8);
  WAIT_BAR(0);
  DMA_K(3,0);DMA_V(1,SLOTB);
  ROT();
  kload8(kf,kp0+sl_cur);
  WAIT_BAR(2);
  s16x4 vlo[8],vhi[8]; u32x4 pw0,pw1,pw2,pw3;
  #define PKW(P,B) cvtpk_s(P[B],P[B+1])
  #define PAF(k) __builtin_bit_cast(bf16x8,pw##k)
  #define VFR(i) (bf16x8){vlo[i][0],vlo[i][1],vlo[i][2],vlo[i][3],vhi[i][0],vhi[i][1],vhi[i][2],vhi[i][3]}
  #define PIN(x) asm volatile("":"+v"(x))
  #define MX3(a,b,c) __builtin_fmaxf(__builtin_fmaxf((a),(b)),(c))
  #define GAPA(MF,A0,A1,A2,A3,W0,W1,PW) do{ MF; sacc+=A0; sacc+=A1; sacc+=A2; sacc+=A3; PIN(sacc); W0; W1; PIN(PW); SBAR(); }while(0)
  #define EX(v) __builtin_amdgcn_exp2f(v)
  #define GAPB(MF,X,B) do{ MF; X[B]=EX(X[B]); X[B+1]=EX(X[B+1]); X[B+2]=EX(X[B+2]); X[B+3]=EX(X[B+3]); PIN(X); SBAR(); }while(0)
  #define VRD(i) do{ vlo[i]=vtr(vp_+(((i)>>2)*4096+((i)&3)*1024)); vhi[i]=vtr(vp_+(((i)>>2)*4096+((i)&3)*1024+512)); }while(0)
  #define KRD(G,j) do{ if(G){ kload2(kf,kp0+sl_next,j); SBAR(); } }while(0)
  #define STEP(C0,C1,P0,P1,t,GK,GV,GL) do{ SBAR(); \
    const lds_cptr vp_=vp0+sl_prev; \
    VRD(0); SBAR(); float sacc=(P0[0]+P0[1]); \
    GAPA(C0=__builtin_amdgcn_mfma_f32_32x32x16_bf16(kf[0],qr[0],C0,0,0,0), P0[2],P0[3],P0[4],P0[5],     pw0[0]=PKW(P0,0), pw0[1]=PKW(P0,2), pw0); \
    VRD(4); SBAR(); GAPA(C1=__builtin_amdgcn_mfma_f32_32x32x16_bf16(kf[1],qr[0],C1,0,0,0), P0[6],P0[7],P0[8],P0[9],     pw0[2]=PKW(P0,4), pw0[3]=PKW(P0,6), pw0); \
    VRD(1); SBAR(); GAPA(C0=__builtin_amdgcn_mfma_f32_32x32x16_bf16(kf[2],qr[1],C0,0,0,0),   P0[10],P0[11],P0[12],P0[13], pw1[0]=PKW(P0,8), pw1[1]=PKW(P0,10), pw1); \
    VRD(5); SBAR(); GAPA(C1=__builtin_amdgcn_mfma_f32_32x32x16_bf16(kf[3],qr[1],C1,0,0,0),   P0[14],P0[15],P1[0],P1[1],   pw1[2]=PKW(P0,12),pw1[3]=PKW(P0,14), pw1); \
    VRD(2); SBAR(); GAPA(C0=__builtin_amdgcn_mfma_f32_32x32x16_bf16(kf[4],qr[2],C0,0,0,0),   P1[2],P1[3],P1[4],P1[5],     pw2[0]=PKW(P1,0), pw2[1]=PKW(P1,2), pw2); \
    VRD(6); SBAR(); GAPA(C1=__builtin_amdgcn_mfma_f32_32x32x16_bf16(kf[5],qr[2],C1,0,0,0),   P1[6],P1[7],P1[8],P1[9],     pw2[2]=PKW(P1,4), pw2[3]=PKW(P1,6), pw2); \
    VRD(3); SBAR(); GAPA(C0=__builtin_amdgcn_mfma_f32_32x32x16_bf16(kf[6],qr[3],C0,0,0,0),   P1[10],P1[11],P1[12],P1[13], pw3[0]=PKW(P1,8), pw3[1]=PKW(P1,10), pw3); \
    VRD(7); SBAR(); GAPA(C1=__builtin_amdgcn_mfma_f32_32x32x16_bf16(kf[7],qr[3],C1,0,0,0),   P1[14],P1[15],0.f,0.f,       pw3[2]=PKW(P1,12),pw3[3]=PKW(P1,14), pw3); \
    l_reg+=sacc; \
    if(GK){DMA_K((t)+3,sl_cur);} if(GV){DMA_V((t)+1,sl_next);} \
    CMASK(C0,C1,t); \
    { float a=MX3(C0[0],C0[1],C1[0]),b=MX3(C0[2],C0[3],C1[1]); a=MX3(a,C1[2],C1[3]); \
      _Pragma("unroll") for(int r=4;r<16;r+=4){a=MX3(a,C0[r],C0[r+1]);b=MX3(b,C0[r+2],C0[r+3]);a=MX3(a,C1[r],C1[r+1]);b=MX3(b,C1[r+2],C1[r+3]);} \
      float rm=__builtin_fmaxf(a,b); { auto rr=__builtin_amdgcn_permlane32_swap(__float_as_uint(rm),__float_as_uint(rm),false,false); rm=__builtin_fmaxf(__uint_as_float(rr[0]),__uint_as_float(rr[1])); } \
      resc=false; \
      if(__builtin_expect(__any(rm>(float)THRL),0)){ const float dl=__builtin_fmaxf(rm,0.f); mhat+=dl; \
        _Pragma("unroll") for(int r=0;r<16;++r){C0[r]-=dl;C1[r]-=dl;} \
        const float f=__builtin_amdgcn_exp2f(-dl); l_reg*=f; if(hi==0)wsf[r32]=f; resc=true; } } \
    SBAR(); \
    if(GL){ BLD(P0,P1,(t)+1); SBAR(); } \
    GAPB(o[0]=__builtin_amdgcn_mfma_f32_32x32x16_bf16(PAF(0),VFR(0),o[0],0,0,0), C0,0); \
    GAPB(o[1]=__builtin_amdgcn_mfma_f32_32x32x16_bf16(PAF(0),VFR(4),o[1],0,0,0), C0,4); \
    KRD(GL,0); GAPB(o[0]=__builtin_amdgcn_mfma_f32_32x32x16_bf16(PAF(1),VFR(1),o[0],0,0,0), C0,8); \
    KRD(GL,1); GAPB(o[1]=__builtin_amdgcn_mfma_f32_32x32x16_bf16(PAF(1),VFR(5),o[1],0,0,0), C0,12); \
    KRD(GL,2); if(GL){BSUB(P0,0);} GAPB(o[0]=__builtin_amdgcn_mfma_f32_32x32x16_bf16(PAF(2),VFR(2),o[0],0,0,0), C1,0); \
    KRD(GL,3); if(GL){BSUB(P0,8);} GAPB(o[1]=__builtin_amdgcn_mfma_f32_32x32x16_bf16(PAF(2),VFR(6),o[1],0,0,0), C1,4); \
    if(GL){BSUB(P1,0);} GAPB(o[0]=__builtin_amdgcn_mfma_f32_32x32x16_bf16(PAF(3),VFR(3),o[0],0,0,0), C1,8); \
    if(GL){BSUB(P1,8);} GAPB(o[1]=__builtin_amdgcn_mfma_f32_32x32x16_bf16(PAF(3),VFR(7),o[1],0,0,0), C1,12); \
    }while(0)
  int t=1;
  #undef CMASK
  #define CMASK(P0,P1,t) do{}while(0)
  for(;t+5<NT;t+=2){
    STEP(pB0,pB1,pA0,pA1,t,true,true,true);     WAIT_BAR(2); RESC(); ROT();
    STEP(pA0,pA1,pB0,pB1,t+1,true,true,true);   WAIT_BAR(2); RESC(); ROT();
  }
  #undef CMASK
  #define CMASK(P0,P1,t) do{int jb_=(t)-(NT-4); if(jb_>=0&&mode!=1)cmask(P0,P1,jb_,qrel,hi);}while(0)
  #define ENDW(tt) do{ if((tt)+3<NT){WAIT_BAR(2);} else if((tt)+2<NT){WAIT_BAR(1);} else {WAIT_BAR(0);} }while(0)
  for(;t+1<NT;t+=2){
    STEP(pB0,pB1,pA0,pA1,t,(t+3<NT),(t+1<NT),(t+1<NT));       ENDW(t);   RESC(); ROT();
    STEP(pA0,pA1,pB0,pB1,t+1,(t+4<NT),(t+2<NT),(t+2<NT));     ENDW(t+1); RESC(); ROT();
  }
  STEP(pB0,pB1,pA0,pA1,NT-1,false,false,false); RESC();
  { float sacc=pB0[0]+pB0[1]; _Pragma("unroll") for(int r=2;r<16;++r)sacc+=pB0[r]; _Pragma("unroll") for(int r=0;r<16;++r)sacc+=pB1[r]; l_reg+=sacc;
    pw0=(u32x4){PKW(pB0,0),PKW(pB0,2),PKW(pB0,4),PKW(pB0,6)};pw1=(u32x4){PKW(pB0,8),PKW(pB0,10),PKW(pB0,12),PKW(pB0,14)};pw2=(u32x4){PKW(pB1,0),PKW(pB1,2),PKW(pB1,4),PKW(pB1,6)};pw3=(u32x4){PKW(pB1,8),PKW(pB1,10),PKW(pB1,12),PKW(pB1,14)};
    SBAR(); pv(o,vb0+sl_cur,PAF(0),PAF(1),PAF(2),PAF(3)); }
  #undef PKW
  #undef PAF
  #undef VFR
  #undef PIN
  #undef MX3
  #undef GAPA
  #undef GAPB
  #undef EX
  #undef VRD
  #undef KRD
  #undef STEP
  #undef ENDW
  {auto rr=__builtin_amdgcn_permlane32_swap(__float_as_uint(l_reg),__float_as_uint(l_reg),false,false);l_reg=__uint_as_float(rr[0])+__uint_as_float(rr[1]);}
  if(mode==0){
  if(hi==0)wsf[32+r32]=l_reg;asm volatile("s_waitcnt lgkmcnt(0)":::"memory");
  float rli[16];
  #pragma unroll
  for(int r=0;r<16;++r)rli[r]=__builtin_amdgcn_rcpf(wsf[32+crow(r,hi)]);
  bf16*Ow=O+(rowbase+q0+wid*QBLK)*DM+h*D;
  { bf16*stg=(bf16*)(shm+LDS_OST)+wid*2048;
    #pragma unroll
    for(int r=0;r<16;++r){const int orow=crow(r,hi);
      #pragma unroll
      for(int d0=0;d0<2;++d0)stg[orow*64+d0*32+r32]=__float2bfloat16(o[d0][r]*rli[r]);}
    asm volatile("s_waitcnt lgkmcnt(0)":::"memory");
    #pragma unroll
    for(int i=0;i<4;++i){const int row=i*8+(lane>>3),ch=lane&7; const u32x4 v=*(const u32x4*)(stg+row*64+ch*8); ATTN_STORE16(Ow+(long)row*DM+ch*8,v);
      float ss=0.f;
      #pragma unroll
      for(int e=0;e<4;++e){const float lo_=__uint_as_float(v[e]<<16),hi_=__uint_as_float(v[e]&0xffff0000u);ss+=lo_*lo_+hi_*hi_;}
      ss+=sx<1>(ss);ss+=sx<2>(ss);ss+=sx<4>(ss);
      if(ch==0)ssqA[(rowbase+q0+wid*QBLK+row)*NHEAD+h]=ss;} }
  } else {
    float*PO=part+(long)(mode-1)*QB*D+(long)(wid*QBLK)*D;
    #pragma unroll
    for(int r=0;r<16;++r){const int orow=crow(r,hi);
      #pragma unroll
      for(int d0=0;d0<2;++d0)__hip_atomic_store(PO+orow*D+d0*32+r32,o[d0][r],__ATOMIC_RELAXED,__HIP_MEMORY_SCOPE_AGENT);}
    if(hi==0){ float*PM=part+2*QB*D+(mode-1)*QB+wid*QBLK; __hip_atomic_store(PM+r32,mhat,__ATOMIC_RELAXED,__HIP_MEMORY_SCOPE_AGENT); __hip_atomic_store(PM+2*QB+r32,l_reg,__ATOMIC_RELAXED,__HIP_MEMORY_SCOPE_AGENT); }
  }
  asm volatile("s_waitcnt lgkmcnt(0)\n\ts_barrier":::"memory");
  } else if(tid<QB){ float*PM=part+2*QB*D; __hip_atomic_store(PM+tid,-1e30f,__ATOMIC_RELAXED,__HIP_MEMORY_SCOPE_AGENT); __hip_atomic_store(PM+2*QB+tid,0.f,__ATOMIC_RELAXED,__HIP_MEMORY_SCOPE_AGENT); }
  if(mode!=0){
    asm volatile("s_waitcnt vmcnt(0)":::"memory"); __syncthreads();
    if(tid==0){
      const unsigned old=__hip_atomic_fetch_add(pcnt,1u,__ATOMIC_RELAXED,__HIP_MEMORY_SCOPE_AGENT);
      if(old==1u){ __builtin_amdgcn_fence(__ATOMIC_ACQUIRE,"agent"); asm volatile("s_waitcnt vmcnt(0)":::"memory"); }
      wtot[0]=(old==1u)?1.f:0.f; }
    __syncthreads();
    const bool merger=wtot[0]!=0.f;
    __syncthreads();
    if(merger){ const int row=tid>>1,ch=tid&1; const float*PA=part+(long)row*D+ch*32,*PB=PA+(long)QB*D; const float*PM=part+2*QB*D;
      const float MA=PM[row],MB=PM[QB+row],LA=PM[2*QB+row],LB=PM[3*QB+row]; const float m=__builtin_fmaxf(MA,MB);
      const bool ua=LA>0.f,ub=LB>0.f; const float wA=ua?__builtin_amdgcn_exp2f(MA-m):0.f,wB=ub?__builtin_amdgcn_exp2f(MB-m):0.f; const float inv=__builtin_amdgcn_rcpf(LA*wA+LB*wB); const float cA=wA*inv,cB=wB*inv;
      bf16*Om=O+(rowbase+q0+row)*DM+h*D+ch*32; float ss=0.f;
      #pragma unroll
      for(int i=0;i<4;++i){ const f32x4v z4={0.f,0.f,0.f,0.f}; const f32x4v a0=ua?*(const f32x4v*)(PA+8*i):z4,a1=ua?*(const f32x4v*)(PA+8*i+4):z4,b0=ub?*(const f32x4v*)(PB+8*i):z4,b1=ub?*(const f32x4v*)(PB+8*i+4):z4;
        u32x4 w; w[0]=cvtpk_s(a0[0]*cA+b0[0]*cB,a0[1]*cA+b0[1]*cB); w[1]=cvtpk_s(a0[2]*cA+b0[2]*cB,a0[3]*cA+b0[3]*cB); w[2]=cvtpk_s(a1[0]*cA+b1[0]*cB,a1[1]*cA+b1[1]*cB); w[3]=cvtpk_s(a1[2]*cA+b1[2]*cB,a1[3]*cA+b1[3]*cB);
        ATTN_STORE16(Om+8*i,w);
        #pragma unroll
        for(int e=0;e<4;++e){const float lo_=__uint_as_float(w[e]<<16),hi_=__uint_as_float(w[e]&0xffff0000u);ss+=lo_*lo_+hi_*hi_;} }
      ss+=sx<1>(ss);
      if(ch==0)ssqA[(rowbase+q0+row)*NHEAD+h]=ss; }
  }
  #undef DMA_K
  #undef DMA_V
  #undef BLD
  #undef BSUB
  #undef CMASK
  #undef START
  #undef RESC
  #undef ROT
}
constexpr int ATTN_LDS_BYTES=LDS_BYTES;
#undef SBAR
#undef WAIT_BAR
}
#define LAS __attribute__((address_space(3)))
#define GAS __attribute__((address_space(1)))
using pg8::f32x4; using pg8::u32x4; using pg8::bf16_t; using pg8::bf16x8; using pg8::Unit; using pg8::BM; using pg8::HALF;
typedef unsigned u32x2 __attribute__((ext_vector_type(2)));
constexpr int TOK = 16384, DMODEL = 1024, DFF = 2816, HW = 512, SEQL = 8192, PLE = 256, NGRP = 32;
constexpr float L2E = 1.4426950408889634f;
constexpr float QSCALE = 0.125f * L2E;
constexpr size_t MiB = 1u << 20;
constexpr size_t WS_CTL = 0, WS_AP = 1 * MiB, WS_BB = WS_AP + 512 * 1024, WS_KTAB = 2 * MiB, WS_PEND = 3 * MiB, WS_CC = 5 * MiB, WS_WF = 7 * MiB, WS_LOGF = 8 * MiB;
constexpr size_t WS_SSQ0 = 9 * MiB, WS_SSQ1 = 10 * MiB, WS_SSQ2 = 11 * MiB, WS_SSQ3 = 12 * MiB, WS_SSQ4 = 13 * MiB, WS_SSQA = 14 * MiB, WS_SSQS = 14 * MiB + 512 * 1024;
constexpr size_t WS_W13A = 16 * MiB, WS_W2A = 27 * MiB, WS_WIN = 33 * MiB, WS_WGLU = 37 * MiB, WS_WOA = 38 * MiB, WS_WOS = 39 * MiB, WS_W13B = 40 * MiB, WS_W2B = 51 * MiB, WS_WG = 57 * MiB, WS_WP = 59 * MiB;
constexpr size_t PARTF = 2 * 256 * 64 + 4 * 256;
static_assert(60 * PARTF * 4 <= 8 * MiB && 45 * PARTF * 4 <= 6 * MiB && 151 * PARTF * 4 <= 20 * MiB, "partial record chunks");
constexpr size_t WS_PART_UNUSED = 188 * MiB;
constexpr size_t WS_PB = 60 * MiB, WS_XB = 68 * MiB, WS_H1 = 100 * MiB;
constexpr size_t WS_Q = 100 * MiB, WS_K = 116 * MiB, WS_V = 132 * MiB, WS_U = 148 * MiB, WS_Y = 164 * MiB, WS_SSMO = 188 * MiB, WS_PP = 204 * MiB, WS_END = 256 * MiB;
static_assert(WS_K == WS_Q + 16 * MiB && WS_V == WS_Q + 32 * MiB, "EpiQKVU pointer arithmetic");
constexpr int RING_BYTES = 131072, LDS_BYTES = 147456, MISC_OFF = LDS_BYTES - 256;

__device__ __forceinline__ float sigm(float w) { return __builtin_amdgcn_rcpf(1.f + __builtin_amdgcn_exp2f(-L2E * w)); }
__device__ __forceinline__ unsigned pkbf(float lo, float hi) { return pg8::cvt_pk_bf16(lo, hi); }
__device__ __forceinline__ float bflo(unsigned w) { return __uint_as_float(w << 16); }
__device__ __forceinline__ float bfhi(unsigned w) { return __uint_as_float(w & 0xffff0000u); }
template <int NP> __device__ __forceinline__ float rstd_row(const float* ssq, int row, float invn) {
    const f32x4* p = (const f32x4*)(ssq + (size_t)row * NP); float s = 0.f;
#pragma unroll
    for (int i = 0; i < NP / 4; ++i) { const f32x4 v = p[i]; s += (v[0] + v[1]) + (v[2] + v[3]); }
    return __builtin_amdgcn_rsqf(s * invn + 1e-6f);
}
template <int NP> __device__ __forceinline__ void rstd8(const float* ssq, int pm, int wr, int fr, int fq, float invn, float (&rs)[2][4]) {
    int lrow = pm * BM + wr * 64 + fq * 16 + fr; asm volatile("" : "+v"(lrow));
    const float r0 = rstd_row<NP>(ssq, lrow, invn), r1 = rstd_row<NP>(ssq, lrow + HALF, invn);
#pragma unroll
    for (int m = 0; m < 4; ++m) { rs[0][m] = __builtin_bit_cast(float, __builtin_amdgcn_ds_bpermute((16 * m + fr) << 2, __builtin_bit_cast(int, r0))); rs[1][m] = __builtin_bit_cast(float, __builtin_amdgcn_ds_bpermute((16 * m + fr) << 2, __builtin_bit_cast(int, r1))); }
}
__device__ __forceinline__ float wave_sum(float v) {
    v += sx<1>(v); v += sx<2>(v); v += sx<4>(v); v += sx<8>(v); v += sx<16>(v); v = sum32(v);
    return v;
}

struct EpiSwiglu {
    static constexpr bool PERM = true, AFTER_DRAIN = false, MIDK = false;
    bf16_t* O; const float* ssq;
    __device__ __forceinline__ void operator()(const f32x4 (&acc)[2][2][4][2], const Unit& u, int wr, int wc, int fr, int fq) const {
        int row0 = u.pm * BM + wr * 64 + fr, col0 = u.pn * 128 + wc * 32 + 8 * fq; asm volatile("" : "+v"(row0));
        float rs8[2][4]; rstd8<16>(ssq, u.pm, wr, fr, fq, 1.f / 1024.f, rs8);
#pragma unroll
        for (int ai = 0; ai < 2; ++ai)
#pragma unroll
            for (int m = 0; m < 4; ++m) { asm volatile("" ::: "memory"); const int row = row0 + ai * HALF + m * 16; const float rs = rs8[ai][m];
                const f32x4 a0 = acc[ai][0][m][0] * rs, a1 = acc[ai][0][m][1] * rs, b0 = acc[ai][1][m][0] * rs, b1 = acc[ai][1][m][1] * rs; f32x4 h0, h1;
#pragma unroll
                for (int e = 0; e < 4; ++e) { h0[e] = a0[e] * sigm(a0[e]) * b0[e]; h1[e] = a1[e] * sigm(a1[e]) * b1[e]; }
                u32x4 w; w.x = pkbf(h0[0], h0[1]); w.y = pkbf(h0[2], h0[3]); w.z = pkbf(h1[0], h1[1]); w.w = pkbf(h1[2], h1[3]);
                *(u32x4*)(O + (size_t)row * DFF + col0) = w; }
    }
};
template <bool NORM, bool BASEB> struct EpiRes {
    static constexpr bool PERM = true, AFTER_DRAIN = false, MIDK = false;
    const float* basef; bf16_t* xb; float* ssqo; const float* ssqi; float coef;
    __device__ __forceinline__ void operator()(const f32x4 (&acc)[2][2][4][2], const Unit& u, int wr, int wc, int fr, int fq) const {
        int row0 = u.pm * BM + wr * 64 + fr, col0 = u.pn * BM + wc * 32 + 8 * fq; asm volatile("" : "+v"(row0));
        float rs8[2][4]; if (NORM) rstd8<8>(ssqi, u.pm, wr, fr, fq, 1.f / 512.f, rs8);
#pragma unroll
        for (int ai = 0; ai < 2; ++ai) { asm volatile("" ::: "memory");
            f32x4 xv[4][2][2];
#pragma unroll
            for (int m = 0; m < 4; ++m)
#pragma unroll
                for (int bj = 0; bj < 2; ++bj) { const size_t off = (size_t)(row0 + ai * HALF + m * 16) * DMODEL + col0 + bj * HALF;
                    if (BASEB) { const u32x4 bv = *(const u32x4*)(xb + off); xv[m][bj][0] = (f32x4){bflo(bv.x), bfhi(bv.x), bflo(bv.y), bfhi(bv.y)}; xv[m][bj][1] = (f32x4){bflo(bv.z), bfhi(bv.z), bflo(bv.w), bfhi(bv.w)}; }
                    else { xv[m][bj][0] = __builtin_nontemporal_load((const f32x4*)(basef + off)); xv[m][bj][1] = __builtin_nontemporal_load((const f32x4*)(basef + off + 4)); } }
#pragma unroll
            for (int m = 0; m < 4; ++m) { const int row = row0 + ai * HALF + m * 16; float alpha = coef; if (NORM) alpha *= rs8[ai][m]; float ss = 0.f;
#pragma unroll
                for (int bj = 0; bj < 2; ++bj) { const size_t off = (size_t)row * DMODEL + col0 + bj * HALF;
                    const f32x4 v0 = xv[m][bj][0] + acc[ai][bj][m][0] * alpha, v1 = xv[m][bj][1] + acc[ai][bj][m][1] * alpha;
                    u32x4 w; w.x = pkbf(v0[0], v0[1]); w.y = pkbf(v0[2], v0[3]); w.z = pkbf(v1[0], v1[1]); w.w = pkbf(v1[2], v1[3]); *(u32x4*)(xb + off) = w;
                    ss += (v0[0] * v0[0] + v0[1] * v0[1]) + (v0[2] * v0[2] + v0[3] * v0[3]) + (v1[0] * v1[0] + v1[1] * v1[1]) + (v1[2] * v1[2] + v1[3] * v1[3]); }
                ss += sx<16>(ss); ss = sum32(ss); if (fq == 0) ssqo[(size_t)row * 16 + u.pn * 4 + wc] = ss; } }
    }
};
struct EpiOut {
    static constexpr bool PERM = true, AFTER_DRAIN = false, MIDK = true;
    bf16_t* xb; float* ssqo; const float* ssqA; const float* ssqS;
    __device__ __forceinline__ void mid(f32x4 (&acc)[2][2][4][2], const Unit& u, int wr, int wc, int fr, int fq) const {
        float ra8[2][4], rb8[2][4]; rstd8<8>(ssqA, u.pm, wr, fr, fq, 1.f / 512.f, ra8); rstd8<8>(ssqS, u.pm, wr, fr, fq, 1.f / 512.f, rb8);
#pragma unroll
        for (int ai = 0; ai < 2; ++ai)
#pragma unroll
            for (int m = 0; m < 4; ++m) { const float ratio = ra8[ai][m] * __builtin_amdgcn_rcpf(rb8[ai][m]);
#pragma unroll
                for (int bj = 0; bj < 2; ++bj) { acc[ai][bj][m][0] *= ratio; acc[ai][bj][m][1] *= ratio; } }
    }
    __device__ __forceinline__ void operator()(const f32x4 (&acc)[2][2][4][2], const Unit& u, int wr, int wc, int fr, int fq) const {
        EpiRes<true, true> E{nullptr, xb, ssqo, ssqS, 1.f}; E(acc, u, wr, wc, fr, fq);
    }
};
struct StrideOrder {
    int first, stride, total, nN;
    __device__ __forceinline__ bool next(int i, Unit& u) const { const int id = first + i * stride; if (id >= total) return false; u.pm = id / nN; u.pn = id % nN; return true; }
    __device__ __forceinline__ void a_ready(const Unit&) const {}
    __device__ __forceinline__ void done(const Unit&) const {}
};
struct EpiQKVU {
    static constexpr bool PERM = true, AFTER_DRAIN = false, MIDK = false;
    bf16_t *Q, *U; const float* ssq; unsigned* kmax;
    __device__ __forceinline__ void operator()(const f32x4 (&acc)[2][2][4][2], const Unit& u, int wr, int wc, int fr, int fq) const {
        int row0 = u.pm * BM + wr * 64 + fr, part = u.pn >> 1, c0 = (u.pn & 1) * 256 + wc * 32 + 8 * fq; asm volatile("" : "+v"(row0));
        bf16_t* dstb = Q + (size_t)part * (size_t)(8 * MiB); const float sc = part == 0 ? QSCALE : 1.f;
        float rs8[2][4]; rstd8<16>(ssq, u.pm, wr, fr, fq, 1.f / 1024.f, rs8); float mxb[2] = {0.f, 0.f};
#pragma unroll
        for (int ai = 0; ai < 2; ++ai)
#pragma unroll
            for (int m = 0; m < 4; ++m) { asm volatile("" ::: "memory"); const int row = row0 + ai * HALF + m * 16; const float rs = rs8[ai][m] * sc;
#pragma unroll
                for (int bj = 0; bj < 2; ++bj) { const int c = c0 + bj * HALF; const f32x4 v0 = acc[ai][bj][m][0] * rs, v1 = acc[ai][bj][m][1] * rs;
                    if (part == 1) { float p2 = ((v0[0] * v0[0] + v0[1] * v0[1]) + (v0[2] * v0[2] + v0[3] * v0[3])) + ((v1[0] * v1[0] + v1[1] * v1[1]) + (v1[2] * v1[2] + v1[3] * v1[3])); p2 += sx<16>(p2); p2 = sum32(p2); mxb[bj] = __builtin_fmaxf(mxb[bj], p2); }
                    u32x4 w; w.x = pkbf(v0[0], v0[1]); w.y = pkbf(v0[2], v0[3]); w.z = pkbf(v1[0], v1[1]); w.w = pkbf(v1[2], v1[3]);
                    if (part < 3) *(u32x4*)(dstb + (size_t)row * HW + c) = w;
                    else { const int g = c >> 4, half = (c >> 3) & 1, b = row >> 13, t = row & 8191; *(u32x4*)(U + ((size_t)((b * NGRP + g) * SEQL + t)) * 16 + half * 8) = w; } } }
        if (part == 1) {
#pragma unroll
            for (int bj = 0; bj < 2; ++bj) { float mx = mxb[bj];
                mx = __builtin_fmaxf(mx, sx<1>(mx)); mx = __builtin_fmaxf(mx, sx<2>(mx)); mx = __builtin_fmaxf(mx, sx<4>(mx)); mx = __builtin_fmaxf(mx, sx<8>(mx));
                if (fr == 0 && fq == 0) __hip_atomic_fetch_max(kmax + (((u.pm >> 5) * 8 + (u.pn & 1) * 4 + bj * 2 + (wc >> 1)) << 1) + (wc & 1), __float_as_uint(mx), __ATOMIC_RELAXED, __HIP_MEMORY_SCOPE_AGENT); } }
    }
};
struct EpiGlu {
    static constexpr bool PERM = true, AFTER_DRAIN = false, MIDK = false;
    const bf16_t* Y; const float* bglu; bf16_t* O; float* ssqo;
    __device__ __forceinline__ void operator()(const f32x4 (&acc)[2][2][4][2], const Unit& u, int wr, int wc, int fr, int fq) const {
        int row0 = u.pm * BM + wr * 64 + fr, c0 = u.pn * BM + wc * 32 + 8 * fq; asm volatile("" : "+v"(row0));
#pragma unroll
        for (int ai = 0; ai < 2; ++ai)
#pragma unroll
            for (int m = 0; m < 4; ++m) { asm volatile("" ::: "memory"); const int row = row0 + ai * HALF + m * 16; float ss = 0.f;
#pragma unroll
                for (int bj = 0; bj < 2; ++bj) { const int c = c0 + bj * HALF; const u32x4 yv = *(const u32x4*)(Y + (size_t)row * HW + c);
                    const f32x4 b0 = *(const f32x4*)(bglu + c), b1 = *(const f32x4*)(bglu + c + 4); const f32x4 a0 = acc[ai][bj][m][0] + b0, a1 = acc[ai][bj][m][1] + b1;
                    float o[8]; o[0] = bflo(yv.x) * sigm(a0[0]); o[1] = bfhi(yv.x) * sigm(a0[1]); o[2] = bflo(yv.y) * sigm(a0[2]); o[3] = bfhi(yv.y) * sigm(a0[3]);
                    o[4] = bflo(yv.z) * sigm(a1[0]); o[5] = bfhi(yv.z) * sigm(a1[1]); o[6] = bflo(yv.w) * sigm(a1[2]); o[7] = bfhi(yv.w) * sigm(a1[3]);
                    u32x4 w; w.x = pkbf(o[0], o[1]); w.y = pkbf(o[2], o[3]); w.z = pkbf(o[4], o[5]); w.w = pkbf(o[6], o[7]); *(u32x4*)(O + (size_t)row * HW + c) = w;
#pragma unroll
                    for (int e = 0; e < 8; ++e) ss += o[e] * o[e]; }
                ss += sx<16>(ss); ss = sum32(ss); if (fq == 0) ssqo[(size_t)row * 8 + u.pn * 4 + wc] = ss; }
    }
};
struct EpiBf16P {
    static constexpr bool PERM = true, AFTER_DRAIN = false, MIDK = false;
    bf16_t* O;
    __device__ __forceinline__ void operator()(const f32x4 (&acc)[2][2][4][2], const Unit& u, int wr, int wc, int fr, int fq) const {
        int row0 = u.pm * BM + wr * 64 + fr, c0 = u.pn * BM + wc * 32 + 8 * fq; asm volatile("" : "+v"(row0));
#pragma unroll
        for (int ai = 0; ai < 2; ++ai)
#pragma unroll
            for (int m = 0; m < 4; ++m) { asm volatile("" ::: "memory"); const int row = row0 + ai * HALF + m * 16;
#pragma unroll
                for (int bj = 0; bj < 2; ++bj) { const f32x4 v0 = acc[ai][bj][m][0], v1 = acc[ai][bj][m][1];
                    u32x4 w; w.x = pkbf(v0[0], v0[1]); w.y = pkbf(v0[2], v0[3]); w.z = pkbf(v1[0], v1[1]); w.w = pkbf(v1[2], v1[3]); *(u32x4*)(O + (size_t)row * DMODEL + c0 + bj * HALF) = w; } }
    }
};
struct EpiGate {
    static constexpr bool PERM = true, AFTER_DRAIN = false, MIDK = false;
    const bf16_t* base; float* out; const bf16_t* pp; const float* ssqi; float* ssqo;
    __device__ __forceinline__ void operator()(const f32x4 (&acc)[2][2][4][2], const Unit& u, int wr, int wc, int fr, int fq) const {
        int row0 = u.pm * BM + wr * 64 + fr, c0 = u.pn * BM + wc * 32 + 8 * fq; asm volatile("" : "+v"(row0));
        float rs8[2][4]; rstd8<16>(ssqi, u.pm, wr, fr, fq, 1.f / 1024.f, rs8);
#pragma unroll
        for (int ai = 0; ai < 2; ++ai)
#pragma unroll
            for (int m = 0; m < 4; ++m) { asm volatile("" ::: "memory"); const int row = row0 + ai * HALF + m * 16; const float rs = rs8[ai][m]; float ss = 0.f;
#pragma unroll
                for (int bj = 0; bj < 2; ++bj) { const size_t off = (size_t)row * DMODEL + c0 + bj * HALF; const u32x4 pv = *(const u32x4*)(pp + off);
                    const u32x4 bv = *(const u32x4*)(base + off); const f32x4 x0 = (f32x4){bflo(bv.x), bfhi(bv.x), bflo(bv.y), bfhi(bv.y)}, x1 = (f32x4){bflo(bv.z), bfhi(bv.z), bflo(bv.w), bfhi(bv.w)}; const f32x4 a0 = acc[ai][bj][m][0] * rs, a1 = acc[ai][bj][m][1] * rs; f32x4 v0, v1;
                    v0[0] = x0[0] + sigm(a0[0]) * bflo(pv.x); v0[1] = x0[1] + sigm(a0[1]) * bfhi(pv.x); v0[2] = x0[2] + sigm(a0[2]) * bflo(pv.y); v0[3] = x0[3] + sigm(a0[3]) * bfhi(pv.y);
                    v1[0] = x1[0] + sigm(a1[0]) * bflo(pv.z); v1[1] = x1[1] + sigm(a1[1]) * bfhi(pv.z); v1[2] = x1[2] + sigm(a1[2]) * bflo(pv.w); v1[3] = x1[3] + sigm(a1[3]) * bfhi(pv.w);
                    *(f32x4*)(out + off) = v0; *(f32x4*)(out + off + 4) = v1;
                    ss += (v0[0] * v0[0] + v0[1] * v0[1]) + (v0[2] * v0[2] + v0[3] * v0[3]) + (v1[0] * v1[0] + v1[1] * v1[1]) + (v1[2] * v1[2] + v1[3] * v1[3]); }
                ss += sx<16>(ss); ss = sum32(ss); if (fq == 0) ssqo[(size_t)row * 16 + u.pn * 4 + wc] = ss; }
    }
};

struct EpiGateFinal {
    static constexpr bool PERM = true, AFTER_DRAIN = false, MIDK = false;
    const bf16_t* base; float* out; const bf16_t* pp; const float* ssqi; float* ssqo; unsigned* cnt; const float* gfin; LAS float* pl;
    __device__ __forceinline__ void operator()(const f32x4 (&acc)[2][2][4][2], const Unit& u, int wr, int wc, int fr, int fq) const {
        int row0 = u.pm * BM + wr * 64 + fr, c0 = u.pn * BM + wc * 32 + 8 * fq; asm volatile("" : "+v"(row0));
        float rs8[2][4]; rstd8<16>(ssqi, u.pm, wr, fr, fq, 1.f / 1024.f, rs8);
        f32x4 v[2][4][2][2];
#pragma unroll
        for (int am = 0; am < 4; ++am) { asm volatile("" ::: "memory"); const int ai = am >> 1;
            u32x4 pvv[2][2], bvv[2][2];
#pragma unroll
            for (int mm = 0; mm < 2; ++mm)
#pragma unroll
                for (int bj = 0; bj < 2; ++bj) { const size_t off = (size_t)(row0 + ai * HALF + ((am & 1) * 2 + mm) * 16) * DMODEL + c0 + bj * HALF; pvv[mm][bj] = *(const u32x4*)(pp + off); bvv[mm][bj] = *(const u32x4*)(base + off); }
#pragma unroll
            for (int mm = 0; mm < 2; ++mm) { const int m = (am & 1) * 2 + mm; const int row = row0 + ai * HALF + m * 16; const float rs = rs8[ai][m]; float ss = 0.f;
#pragma unroll
                for (int bj = 0; bj < 2; ++bj) { const u32x4 pv = pvv[mm][bj];
                    const u32x4 bv = bvv[mm][bj]; const f32x4 x0 = (f32x4){bflo(bv.x), bfhi(bv.x), bflo(bv.y), bfhi(bv.y)}, x1 = (f32x4){bflo(bv.z), bfhi(bv.z), bflo(bv.w), bfhi(bv.w)}; const f32x4 a0 = acc[ai][bj][m][0] * rs, a1 = acc[ai][bj][m][1] * rs; f32x4 v0, v1;
                    v0[0] = x0[0] + sigm(a0[0]) * bflo(pv.x); v0[1] = x0[1] + sigm(a0[1]) * bfhi(pv.x); v0[2] = x0[2] + sigm(a0[2]) * bflo(pv.y); v0[3] = x0[3] + sigm(a0[3]) * bfhi(pv.y);
                    v1[0] = x1[0] + sigm(a1[0]) * bflo(pv.z); v1[1] = x1[1] + sigm(a1[1]) * bfhi(pv.z); v1[2] = x1[2] + sigm(a1[2]) * bflo(pv.w); v1[3] = x1[3] + sigm(a1[3]) * bfhi(pv.w);
                    v[ai][m][bj][0] = v0; v[ai][m][bj][1] = v1;
                    ss += (v0[0] * v0[0] + v0[1] * v0[1]) + (v0[2] * v0[2] + v0[3] * v0[3]) + (v1[0] * v1[0] + v1[1] * v1[1]) + (v1[2] * v1[2] + v1[3] * v1[3]); }
                ss += sx<16>(ss); ss = sum32(ss);
                if (fq == 0) pl[(row - u.pm * BM) * 4 + wc] = ss; } }
        asm volatile("s_waitcnt lgkmcnt(0)" ::: "memory"); __builtin_amdgcn_s_barrier(); asm volatile("" ::: "memory");
        const int tloc = (wr * 4 + wc) * 64 + fq * 16 + fr;
        if (tloc < BM) { const f32x4 t4 = *(const LAS f32x4*)(pl + tloc * 4); __hip_atomic_store(ssqo + (size_t)(u.pm * BM + tloc) * 4 + u.pn, (t4[0] + t4[1]) + (t4[2] + t4[3]), __ATOMIC_RELAXED, __HIP_MEMORY_SCOPE_AGENT); }
        asm volatile("s_waitcnt vmcnt(0) lgkmcnt(0)" ::: "memory"); __builtin_amdgcn_s_barrier(); asm volatile("" ::: "memory");
        unsigned* c = cnt + 64 * u.pm;
        if (tloc == 0) __hip_atomic_fetch_add(c, 1u, __ATOMIC_RELAXED, __HIP_MEMORY_SCOPE_AGENT);
        for (unsigned sp = 0; sp < (1u << 22); ++sp) {
            if ((unsigned)__builtin_amdgcn_readfirstlane(__hip_atomic_load(c, __ATOMIC_RELAXED, __HIP_MEMORY_SCOPE_AGENT)) >= 4u) break;
            __builtin_amdgcn_s_sleep(2); }
        __builtin_amdgcn_fence(__ATOMIC_ACQUIRE, "agent");
        float rf8[2][4];
        { int lrow = u.pm * BM + wr * 64 + fq * 16 + fr; asm volatile("" : "+v"(lrow)); const f32x4 q0 = *(const f32x4*)(ssqo + (size_t)lrow * 4), q1 = *(const f32x4*)(ssqo + (size_t)(lrow + HALF) * 4);
          const float r0 = __builtin_amdgcn_rsqf(((q0[0] + q0[1]) + (q0[2] + q0[3])) * (1.f / 1024.f) + 1e-6f), r1 = __builtin_amdgcn_rsqf(((q1[0] + q1[1]) + (q1[2] + q1[3])) * (1.f / 1024.f) + 1e-6f);
#pragma unroll
          for (int m = 0; m < 4; ++m) { rf8[0][m] = __builtin_bit_cast(float, __builtin_amdgcn_ds_bpermute((16 * m + fr) << 2, __builtin_bit_cast(int, r0))); rf8[1][m] = __builtin_bit_cast(float, __builtin_amdgcn_ds_bpermute((16 * m + fr) << 2, __builtin_bit_cast(int, r1))); } }
#pragma unroll
        for (int ai = 0; ai < 2; ++ai)
#pragma unroll
            for (int m = 0; m < 4; ++m) { asm volatile("" ::: "memory"); const int row = row0 + ai * HALF + m * 16; const float rstd = rf8[ai][m];
#pragma unroll
                for (int bj = 0; bj < 2; ++bj) { const size_t off = (size_t)row * DMODEL + c0 + bj * HALF; const f32x4 g0 = *(const f32x4*)(gfin + c0 + bj * HALF), g1 = *(const f32x4*)(gfin + c0 + bj * HALF + 4);
                    __builtin_nontemporal_store(v[ai][m][bj][0] * rstd * g0, (f32x4*)(out + off)); __builtin_nontemporal_store(v[ai][m][bj][1] * rstd * g1, (f32x4*)(out + off + 4)); } }
    }
};

__device__ __forceinline__ void tr_item(const float* src, int srcN, int k0, int c0, const float* gain, bf16_t* dst, int dstPitch, int dstRow0, LAS float* scr, int lane) {
    float tv[32];
#pragma unroll
    for (int i = 0; i < 32; ++i) { const int kk = 2 * i + (lane >> 5); tv[i] = __builtin_nontemporal_load(src + (size_t)(k0 + kk) * srcN + c0 + (lane & 31)); }
    if (gain) {
#pragma unroll
        for (int i = 0; i < 32; ++i) tv[i] *= gain[k0 + 2 * i + (lane >> 5)]; }
#pragma unroll
    for (int i = 0; i < 32; ++i) scr[(2 * i + (lane >> 5)) * 33 + (lane & 31)] = tv[i];
    asm volatile("s_waitcnt lgkmcnt(0)" ::: "memory");
    const int c = lane & 7;
#pragma unroll
    for (int j = 0; j < 4; ++j) { const int n = (lane >> 3) + 8 * j; const LAS float* s = scr + (8 * c) * 33 + n;
        u32x4 o; o.x = pkbf(s[0 * 33], s[1 * 33]); o.y = pkbf(s[2 * 33], s[3 * 33]); o.z = pkbf(s[4 * 33], s[5 * 33]); o.w = pkbf(s[6 * 33], s[7 * 33]);
        *(u32x4*)(dst + (size_t)(dstRow0 + n) * dstPitch + k0 + 8 * c) = o; }
    asm volatile("s_waitcnt lgkmcnt(0)" ::: "memory");
}
__device__ __forceinline__ void tr_w13(const float* w1, const float* w3, const float* gain, bf16_t* dst, int item, LAS float* scr, int lane) {
    const int nblk = 5632 / 32, kb = item / nblk, nb = item % nblk, R0 = 32 * nb, tile = R0 >> 8, r = R0 & 255;
    tr_item(r < 128 ? w1 : w3, DFF, 64 * kb, 128 * tile + (r & 127), gain, dst, DMODEL, R0, scr, lane);
}
__device__ __forceinline__ void cis_d(double a, double& c, double& s) {
    const double k = rint(a * 0.63661977236758134);
    const double r = fma(-k, 6.123233995736766e-17, fma(-k, 1.5707963267948966, a)), r2 = r * r;
    const double sp = r * (1.0 + r2 * (-1.0 / 6 + r2 * (1.0 / 120 + r2 * (-1.0 / 5040 + r2 * (1.0 / 362880 + r2 * (-1.0 / 39916800 + r2 * (1.0 / 6227020800.0)))))));
    const double cp = 1.0 + r2 * (-0.5 + r2 * (1.0 / 24 + r2 * (-1.0 / 720 + r2 * (1.0 / 40320 + r2 * (-1.0 / 3628800 + r2 * (1.0 / 479001600.0 + r2 * (-1.0 / 87178291200.0)))))));
    const int q = ((int)k) & 3;
    c = (q == 0) ? cp : (q == 1) ? -sp : (q == 2) ? -cp : sp;
    s = (q == 0) ? sp : (q == 1) ? cp : (q == 2) ? -sp : -cp;
}
__device__ __forceinline__ float gelu_tanh(float y) { return y * sigm(1.5957691216057308f * (y + 0.044715f * y * y * y)); }

__device__ __forceinline__ void ssm_item(int bg, const bf16_t* U, const bf16_t* Ktab, const bf16_t* Pend, const bf16_t* Cc, const float* AP, bf16_t* Yout, LAS unsigned char* lds, int tid, unsigned* done) {
    asm volatile("" : "+v"(tid));
    const int lane = tid & 63, wid = __builtin_amdgcn_readfirstlane(tid >> 6), fr = lane & 15, fq = lane >> 4;
    const int b = bg >> 5, g = bg & 31;
    const bf16_t* Ub = U + (size_t)bg * SEQL * 16; const bf16_t* Kt = Ktab + g * 4096; const bf16_t* Pe = Pend + g * 32768; const bf16_t* Cg = Cc + g * 32768; const float* APg = AP + g * 64 * 36;
    float a16r[4], a16i[4];
#pragma unroll
    for (int pt = 0; pt < 4; ++pt) { a16r[pt] = APg[(16 * pt + fr) * 36 + 32]; a16i[pt] = APg[(16 * pt + fr) * 36 + 33]; }
    const float a64r = APg[lane * 36 + 34], a64i = APg[lane * 36 + 35];
    float cr = 0.f, ci = 0.f;
    LAS float* Ebuf = (LAS float*)lds; LAS float* Cbuf = (LAS float*)(lds + 16384); LAS unsigned short* XP = (LAS unsigned short*)(lds + 32768) + wid * (16 * 136);
    const int slot = wid * 4 + fq;
    LAS unsigned short* PendL = (LAS unsigned short*)(lds + 67584); LAS unsigned short* KtL = (LAS unsigned short*)(lds + 135168);
    { const GAS u32x4* ps = (const GAS u32x4*)Pe; u32x4 tv[8];
#pragma unroll
      for (int i = 0; i < 8; ++i) tv[i] = ps[tid + 512 * i];
      const u32x4 kv = ((const GAS u32x4*)Kt)[tid];
#pragma unroll
      for (int i = 0; i < 8; ++i) { const int c = tid + 512 * i; *(LAS u32x4*)(PendL + (c >> 5) * 264 + (c & 31) * 8) = tv[i]; }
      *(LAS u32x4*)(KtL + tid * 8) = kv; }
    __syncthreads();
    for (int seg = 0; seg < 4; ++seg) {
        const int c0 = seg * 128 + wid * 16;
        bf16x8 uf[8];
        { const bf16_t* ub = Ub + ((size_t)(c0 + fr) * 16 + (fq >> 1)) * 16 + 8 * (fq & 1); asm volatile("" : "+v"(ub));
#pragma unroll
        for (int ks = 0; ks < 8; ++ks) uf[ks] = *(const GAS bf16x8*)(ub + 32 * ks); }
        f32x4 S[8];
#pragma unroll
        for (int nt = 0; nt < 8; ++nt) { const LAS unsigned short* pn = PendL + (16 * nt + fr) * 264 + 8 * fq; S[nt] = (f32x4){0.f, 0.f, 0.f, 0.f};
#pragma unroll
            for (int ks = 0; ks < 8; ++ks) { const bf16x8 pf = *(const LAS bf16x8*)(pn + 32 * ks); S[nt] = __builtin_amdgcn_mfma_f32_16x16x32_bf16(uf[ks], pf, S[nt], 0, 0, 0); } }
        f32x4 Y[16];
#pragma unroll
        for (int tl = 0; tl < 16; ++tl) Y[tl] = (f32x4){0.f, 0.f, 0.f, 0.f};
#pragma unroll
        for (int d = 0; d < 16; ++d) { const int j = d - (fq >> 1); bf16x8 kfv = *(const LAS bf16x8*)(KtL + ((j < 0 ? 0 : j) * 16 + fr) * 16 + 8 * (fq & 1)); if (j < 0) kfv = (bf16x8){0, 0, 0, 0, 0, 0, 0, 0};
#pragma unroll
            for (int ks = 0; ks < 8; ++ks) if (d + 2 * ks < 16) Y[d + 2 * ks] = __builtin_amdgcn_mfma_f32_16x16x32_bf16(kfv, uf[ks], Y[d + 2 * ks], 0, 0, 0); }
#pragma unroll
        for (int pt = 0; pt < 4; ++pt) { float xr = 0.f, xi = 0.f;
#pragma unroll
            for (int i = 0; i < 4; ++i) { const float nr = a16r[pt] * xr - a16i[pt] * xi + S[pt][i], ni = a16r[pt] * xi + a16i[pt] * xr + S[pt + 4][i]; xr = nr; xi = ni; }
            Ebuf[slot * 128 + 16 * pt + fr] = xr; Ebuf[slot * 128 + 64 + 16 * pt + fr] = xi; }
        __syncthreads();
        if (wid == 0) {
            float er[32], ei[32];
#pragma unroll
            for (int sl = 0; sl < 32; ++sl) { er[sl] = Ebuf[sl * 128 + lane]; ei[sl] = Ebuf[sl * 128 + 64 + lane]; }
#pragma unroll
            for (int sl = 0; sl < 32; ++sl) { Cbuf[sl * 128 + lane] = cr; Cbuf[sl * 128 + 64 + lane] = ci;
                const float nr = a64r * cr - a64i * ci + er[sl], ni = a64r * ci + a64i * cr + ei[sl]; cr = nr; ci = ni; }
        }
        __syncthreads();
#pragma unroll
        for (int pt = 0; pt < 4; ++pt) { float xr = Cbuf[slot * 128 + 16 * pt + fr], xi = Cbuf[slot * 128 + 64 + 16 * pt + fr];
#pragma unroll
            for (int i = 0; i < 4; ++i) { const unsigned w = pkbf(xr, xi); XP[(4 * fq + i) * 136 + 16 * pt + fr] = (unsigned short)(w & 0xffffu); XP[(4 * fq + i) * 136 + 64 + 16 * pt + fr] = (unsigned short)(w >> 16);
                const float nr = a16r[pt] * xr - a16i[pt] * xi + S[pt][i], ni = a16r[pt] * xi + a16i[pt] * xr + S[pt + 4][i]; xr = nr; xi = ni; } }
        asm volatile("s_waitcnt lgkmcnt(0)" ::: "memory");
        bf16x8 xf[4];
#pragma unroll
        for (int ks = 0; ks < 4; ++ks) xf[ks] = *(const LAS bf16x8*)(XP + fr * 136 + 32 * ks + 8 * fq);
#pragma unroll
        for (int tl = 0; tl < 16; ++tl) { const bf16_t* cp = Cg + (tl * 16 + fr) * 128 + 8 * fq; if ((tl & 3) == 0) asm volatile("" : "+v"(cp) :: "memory"); else asm volatile("" : "+v"(cp));
#pragma unroll
            for (int ks = 0; ks < 4; ++ks) { const bf16x8 cf = *(const GAS bf16x8*)(cp + 32 * ks); Y[tl] = __builtin_amdgcn_mfma_f32_16x16x32_bf16(cf, xf[ks], Y[tl], 0, 0, 0); } }
        bf16_t* yo = Yout + ((size_t)b * SEQL + (size_t)(c0 + fr) * 16) * HW + g * 16 + 4 * fq; asm volatile("" : "+v"(yo));
#pragma unroll
        for (int tl = 0; tl < 16; ++tl) { u32x2 w; w.x = pkbf(gelu_tanh(Y[tl][0]), gelu_tanh(Y[tl][1])); w.y = pkbf(gelu_tanh(Y[tl][2]), gelu_tanh(Y[tl][3])); *(GAS u32x2*)(yo + (size_t)tl * HW) = w; }
        asm volatile("s_waitcnt lgkmcnt(0)" ::: "memory");
    }
    asm volatile("s_waitcnt vmcnt(0)" ::: "memory");
    __syncthreads();
    if (tid == 0) { __builtin_amdgcn_fence(__ATOMIC_RELEASE, "agent"); asm volatile("s_waitcnt vmcnt(0)" ::: "memory"); __hip_atomic_fetch_add(done, 1u, __ATOMIC_RELAXED, __HIP_MEMORY_SCOPE_AGENT); }
}

#define XB_TMO      128
#define XB_XCNT(j)  (256  + 64 * (j))
#define XB_XSUB(j)  (1280 + 64 * (j))
#define XB_XGEN(j)  (2304 + 64 * (j))
#define XB_TOP      3328
#define XB_TOPGEN   3392
#define XCD_BAR_WORDS 3456
#define XB_SPIN_CAP (1u << 18)

__device__ __forceinline__ unsigned xb_ld(unsigned* p)              { return __hip_atomic_load(p, __ATOMIC_RELAXED, __HIP_MEMORY_SCOPE_AGENT); }
__device__ __forceinline__ unsigned xb_add(unsigned* p, unsigned v) { return __hip_atomic_fetch_add(p, v, __ATOMIC_RELAXED, __HIP_MEMORY_SCOPE_AGENT); }
__device__ __forceinline__ unsigned xb_xcc_id() { return (unsigned)__builtin_amdgcn_s_getreg((3 << 11) | 20) & 0xFu; }
#define XB_SPIN(cond, bar) do { unsigned _sp = 0; while (cond) { __builtin_amdgcn_s_sleep(1); \
    if ((++_sp & 255u) == 0u) { if (xb_ld(&(bar)[XB_TMO])) break; if (_sp > XB_SPIN_CAP) { atomicAdd(&(bar)[XB_TMO], 1u); break; } } } } while (0)

struct XcdBarrier {
    unsigned* bar; unsigned x;
    volatile LAS unsigned* st;
};

__device__ __forceinline__ XcdBarrier xcd_barrier_post(unsigned* bar, volatile LAS unsigned* st) {
    XcdBarrier b; b.bar = bar; b.x = xb_xcc_id(); b.st = st;
    if (threadIdx.x == 0) (void)xb_add(&bar[XB_XCNT(b.x)], 1u);
    return b;
}
__device__ __forceinline__ void xcd_barrier_complete(unsigned* bar, unsigned x, unsigned& nloc, unsigned& nx) {
    const unsigned G = gridDim.x * gridDim.y * gridDim.z;
    unsigned sum, cnt, mine, sp = 0u;
    for (;;) {
        sum = 0u; cnt = 0u; mine = 0u;
#pragma unroll
        for (unsigned j = 0; j < 16; ++j) { const unsigned c = xb_ld(&bar[XB_XCNT(j)]); sum += c; cnt += (c > 0u) ? 1u : 0u; mine = (j == x) ? c : mine; }
        if (sum == G) break;
        __builtin_amdgcn_s_sleep(1);
        if ((++sp & 255u) == 0u) { if (xb_ld(&bar[XB_TMO])) break; if (sp > XB_SPIN_CAP) { atomicAdd(&bar[XB_TMO], 1u); break; } }
    }
    nloc = mine > 0u ? mine : 1u; nx = cnt > 0u ? cnt : 1u;
}

__device__ __forceinline__ void xcd_barrier(const XcdBarrier& b) {
    asm volatile("s_waitcnt vmcnt(0)" ::: "memory");
    __syncthreads();
    if (threadIdx.x == 0) {
        unsigned* bar = b.bar;
        __builtin_amdgcn_s_waitcnt(0);
        unsigned nloc = b.st[0], nx = b.st[1];
        if (nloc == 0u) { xcd_barrier_complete(bar, b.x, nloc, nx); b.st[0] = nloc; b.st[1] = nx; }
        const unsigned old = xb_add(&bar[XB_XSUB(b.x)], 1u);
        const unsigned gen = old / nloc;
        if (old + 1u == (gen + 1u) * nloc) {
            __builtin_amdgcn_fence(__ATOMIC_RELEASE, "agent");
            asm volatile("s_waitcnt vmcnt(0)" ::: "memory");
            const unsigned og = xb_add(&bar[XB_TOP], 1u);
            const unsigned tg = og / nx;
            if (og + 1u == (tg + 1u) * nx) xb_add(&bar[XB_TOPGEN], 1u);
            else XB_SPIN(xb_ld(&bar[XB_TOPGEN]) == tg, bar);
            __builtin_amdgcn_fence(__ATOMIC_ACQUIRE, "agent");
            xb_add(&bar[XB_XGEN(b.x)], 1u);
            asm volatile("s_waitcnt vmcnt(0)" ::: "memory");
        } else {
            XB_SPIN(xb_ld(&bar[XB_XGEN(b.x)]) == gen, bar);
            __builtin_amdgcn_fence(__ATOMIC_ACQUIRE, "agent");
            asm volatile("s_waitcnt vmcnt(0)" ::: "memory");
        }
    }
    __syncthreads();
}

constexpr int NATT = 704;
struct Args { const float* in[30]; float* out; unsigned char* ws; };
#define CAS __attribute__((address_space(4)))
#define GSYNC() do { XcdBarrier b_; b_.bar = (unsigned*)(((const CAS Args*)__builtin_amdgcn_kernarg_segment_ptr())->ws + 4096); b_.x = xb_xcc_id(); b_.st = (volatile LAS unsigned*)(lds + MISC_OFF + 32); xcd_barrier(b_); } while (0)
#ifdef PROBE_SEL1
#define STAMP() do { if (blockIdx.x == 0 && threadIdx.x == 0) { unsigned long long* ts_ = (unsigned long long*)(((const CAS Args*)__builtin_amdgcn_kernarg_segment_ptr())->ws + 1024); ts_[nstamp] = __builtin_amdgcn_s_memrealtime(); } ++nstamp; } while (0)
#else
#define STAMP() do {} while (0)
#endif

__global__ void __launch_bounds__(512, 2) mk_fwd(Args a) {
    extern __shared__ __attribute__((aligned(16))) unsigned char lds_raw[];
    cg::grid_group grid = cg::this_grid();
    LAS unsigned char* lds = (LAS unsigned char*)lds_raw;
    const int wave_s = __builtin_amdgcn_readfirstlane((int)(threadIdx.x >> 6));
    int nstamp = 0; (void)nstamp;
    if (threadIdx.x < 32) ((LAS unsigned*)(lds + MISC_OFF))[threadIdx.x] = 0u;
    if (blockIdx.x == 0) { unsigned* cz = (unsigned*)(((const CAS Args*)__builtin_amdgcn_kernarg_segment_ptr())->ws);
        for (int i = threadIdx.x; i < 16384; i += 512) __hip_atomic_store(cz + i, 0u, __ATOMIC_RELAXED, __HIP_MEMORY_SCOPE_AGENT); }
    __syncthreads();
    grid.sync();
    (void)xcd_barrier_post((unsigned*)(((const CAS Args*)__builtin_amdgcn_kernarg_segment_ptr())->ws + 4096), (volatile LAS unsigned*)(lds + MISC_OFF + 32));
    STAMP();
#define IDS() const CAS Args* ap_ = (const CAS Args*)__builtin_amdgcn_kernarg_segment_ptr(); asm volatile("" : "+s"(ap_)); \
    int tid; asm volatile("v_mbcnt_lo_u32_b32 %0, -1, 0\n\tv_mbcnt_hi_u32_b32 %0, -1, %0" : "=v"(tid)); tid += wave_s * 64; const int lane = tid & 63, wave = __builtin_amdgcn_readfirstlane(tid >> 6); \
    const int G = gridDim.x, bx = blockIdx.x, vcu = (G % 8 == 0) ? (bx % 8) * (G / 8) + bx / 8 : bx; \
    const int gw = vcu * 8 + wave, NGW = G * 8, gt = bx * 512 + tid, NGT = G * 512; (void)lane; (void)gw; (void)NGW; (void)gt; (void)NGT; (void)vcu
#define INP(i) (ap_->in[i])
#define WSP(T, off) ((T*)(ap_->ws + (off)))
#define OUTP (ap_->out)
    {
        IDS();
        const float *x = INP(0), *pin = INP(1), *g_ffn1 = INP(2), *w1_a = INP(3), *w3_a = INP(4), *w2_a = INP(5), *g_mix = INP(6), *w_in = INP(7);
        const float *a_re = INP(9), *a_im = INP(10), *log_dt = INP(11), *b_re = INP(12), *b_im = INP(13);
        const float *w_glu = INP(17), *g_attn_out = INP(19), *g_ssm_out = INP(20), *w_out = INP(21), *g_ffn2 = INP(22), *w1_b = INP(23), *w3_b = INP(24), *w2_b = INP(25);
        const float *g_ple = INP(26), *w_ple_gate = INP(27), *w_ple_proj = INP(28);
        float* AP = WSP(float, WS_AP); float* BB = WSP(float, WS_BB); bf16_t* Wf = WSP(bf16_t, WS_WF); float* ssq0 = WSP(float, WS_SSQ0);
        bf16_t *W13a = WSP(bf16_t, WS_W13A), *W2a = WSP(bf16_t, WS_W2A), *Win = WSP(bf16_t, WS_WIN), *Wglu = WSP(bf16_t, WS_WGLU), *WoA = WSP(bf16_t, WS_WOA);
        bf16_t *W13b = WSP(bf16_t, WS_W13B), *W2b = WSP(bf16_t, WS_W2B), *Wg = WSP(bf16_t, WS_WG), *Wp = WSP(bf16_t, WS_WP), *PB = WSP(bf16_t, WS_PB), *XB = WSP(bf16_t, WS_XB);
        LAS float* scr = (LAS float*)(lds + wave * 16384);
        constexpr int I_13 = 16 * 176, I_IN = 16 * 64;
        constexpr int NITEMS = I_13 + I_IN;
        for (int it = gw; it < NITEMS; it += NGW) {
            int r = it;
            if (r < I_13) { tr_w13(w1_a, w3_a, g_ffn1, W13a, r, scr, lane); continue; } r -= I_13;
            { const int R0 = 32 * (r % 64); tr_item(w_in, 2056, 64 * (r / 64), R0 < 1536 ? R0 : R0 + 8, g_mix, Win, DMODEL, R0, scr, lane); }
        }
        for (int m = gw; m < TOK; m += 2 * NGW) {
            const int m2 = m + NGW; const bool has2 = m2 < TOK; const int mb = has2 ? m2 : m;
            const f32x4* xr = (const f32x4*)(x + (size_t)m * DMODEL) + lane; const f32x4* xr2 = (const f32x4*)(x + (size_t)mb * DMODEL) + lane;
            f32x4 va[4], vb[4];
#pragma unroll
            for (int j = 0; j < 4; ++j) { va[j] = __builtin_nontemporal_load(xr + 64 * j); vb[j] = __builtin_nontemporal_load(xr2 + 64 * j); }
            const f32x4 pa = __builtin_nontemporal_load((const f32x4*)(pin + (size_t)m * PLE) + lane), pb = __builtin_nontemporal_load((const f32x4*)(pin + (size_t)mb * PLE) + lane);
            u32x2* o8 = (u32x2*)(XB + (size_t)m * DMODEL) + lane; u32x2* o8b = (u32x2*)(XB + (size_t)mb * DMODEL) + lane; float ss = 0.f, ss2 = 0.f;
#pragma unroll
            for (int j = 0; j < 4; ++j) { const f32x4 v = va[j]; ss += (v[0] * v[0] + v[1] * v[1]) + (v[2] * v[2] + v[3] * v[3]); u32x2 w; w.x = pkbf(v[0], v[1]); w.y = pkbf(v[2], v[3]); o8[64 * j] = w; }
            ss = wave_sum(ss); if (lane < 16) ssq0[(size_t)m * 16 + lane] = lane == 0 ? ss : 0.f;
            { u32x2 w; w.x = pkbf(pa[0], pa[1]); w.y = pkbf(pa[2], pa[3]); *((u32x2*)(PB + (size_t)m * PLE) + lane) = w; }
            if (has2) {
#pragma unroll
                for (int j = 0; j < 4; ++j) { const f32x4 v = vb[j]; ss2 += (v[0] * v[0] + v[1] * v[1]) + (v[2] * v[2] + v[3] * v[3]); u32x2 w; w.x = pkbf(v[0], v[1]); w.y = pkbf(v[2], v[3]); o8b[64 * j] = w; }
                ss2 = wave_sum(ss2); if (lane < 16) ssq0[(size_t)m2 * 16 + lane] = lane == 0 ? ss2 : 0.f;
                u32x2 w; w.x = pkbf(pb[0], pb[1]); w.y = pkbf(pb[2], pb[3]); *((u32x2*)(PB + (size_t)m2 * PLE) + lane) = w; }
        }
        if (gt < 16384) { const int n = gt >> 10, k = gt & 1023; const float v = n < 8 ? g_mix[k] * w_in[(size_t)k * 2056 + 1536 + n] : 0.f; Wf[gt] = (bf16_t)(pkbf(v, 0.f) & 0xffffu); }
        if (gt < 2048) {
            const int g = gt >> 6; const double dt = exp((double)log_dt[g]), ar = a_re[gt], ai = a_im[gt];
            double cs, sn; cis_d(dt * ai, cs, sn); const double dec = exp(dt * ar), Ar = dec * cs, Ai = dec * sn;
            const double nr = Ar - 1.0, ni = Ai, den = ar * ar + ai * ai, f_r = (nr * ar + ni * ai) / den, f_i = (ni * ar - nr * ai) / den;
            float* ap = AP + gt * 36; double pr = 1.0, pi = 0.0;
            for (int n = 0; n <= 16; ++n) { ap[2 * n] = (float)pr; ap[2 * n + 1] = (float)pi; if (n < 16) { const double t_ = pr * Ar - pi * Ai; pi = pr * Ai + pi * Ar; pr = t_; } }
            double qr = pr * pr - pi * pi, qi = 2.0 * pr * pi; const double q2r = qr * qr - qi * qi, q2i = 2.0 * qr * qi; ap[34] = (float)q2r; ap[35] = (float)q2i;
            for (int h = 0; h < 16; ++h) { const double br = b_re[gt * 16 + h], bi = b_im[gt * 16 + h]; BB[gt * 32 + 2 * h] = (float)(f_r * br - f_i * bi); BB[gt * 32 + 2 * h + 1] = (float)(f_r * bi + f_i * br); }
        }
    }
    GSYNC(); STAMP();

    {
        IDS();
        pg8::Gemm gm{WSP(bf16_t, WS_XB), WSP(bf16_t, WS_W13A), TOK, 2 * DFF, DMODEL}; pg8::StaticOrder S; S.init(TOK, 2 * DFF, G, bx);
        EpiSwiglu E{WSP(bf16_t, WS_H1), WSP(float, WS_SSQ0)};
        pg8::gemm_phase<EpiSwiglu, pg8::StaticOrder, true, true>(lds, gm, S, E, tid);
    }
    if ((int)blockIdx.x >= (int)gridDim.x / 2) {
        IDS();
        const float *c_re = INP(14), *c_im = INP(15), *d_skip = INP(16);
        const float* AP = WSP(float, WS_AP); const float* BB = WSP(float, WS_BB); bf16_t* Ktab = WSP(bf16_t, WS_KTAB); bf16_t* Pend = WSP(bf16_t, WS_PEND); bf16_t* Cc = WSP(bf16_t, WS_CC);
        const int gt2 = (bx - G / 2) * 512 + tid, NGT2 = (G - G / 2) * 512;
        { const float *w2_a = INP(5), *w_glu = INP(17), *g_attn_out = INP(19), *g_ssm_out = INP(20), *w_out = INP(21), *w_ple_proj = INP(28);
          bf16_t *W2a = WSP(bf16_t, WS_W2A), *Wglu = WSP(bf16_t, WS_WGLU), *WoA = WSP(bf16_t, WS_WOA), *Wp = WSP(bf16_t, WS_WP);
          LAS float* scr = (LAS float*)(lds + wave * 16384);
          constexpr int I_2 = 44 * 32, I_GLU = 8 * 16, I_O = 8 * 32, I_P = 4 * 32;
          for (int it = (bx - G / 2) * 8 + wave; it < I_2 + I_GLU + 2 * I_O + I_P; it += (G - G / 2) * 8) {
              int r = it;
              if (r < I_2) { tr_item(w2_a, DMODEL, 64 * (r / 32), 32 * (r % 32), nullptr, W2a, DFF, 32 * (r % 32), scr, lane); continue; } r -= I_2;
              if (r < I_GLU) { tr_item(w_glu, HW, 64 * (r / 16), 32 * (r % 16), nullptr, Wglu, HW, 32 * (r % 16), scr, lane); continue; } r -= I_GLU;
              if (r < 2 * I_O) { const int kb = r / 32; tr_item(w_out, DMODEL, 64 * kb, 32 * (r % 32), kb < 8 ? g_attn_out : g_ssm_out - HW, WoA, DMODEL, 32 * (r % 32), scr, lane); continue; } r -= 2 * I_O;
              tr_item(w_ple_proj, DMODEL, 64 * (r / 32), 32 * (r % 32), nullptr, Wp, PLE, 32 * (r % 32), scr, lane);
          } }
        for (int idx = gt2; idx < 131072; idx += NGT2) {
            const int g = idx >> 12, j = (idx >> 8) & 15, h = (idx >> 4) & 15, hp = idx & 15; float s = 0.f;
#pragma unroll 16
            for (int p = 0; p < 64; ++p) { const float Cr = c_re[(g * 16 + h) * 64 + p], Ci = c_im[(g * 16 + h) * 64 + p], Ar = AP[(g * 64 + p) * 36 + 2 * j], Ai = AP[(g * 64 + p) * 36 + 2 * j + 1];
                const float Wr = Cr * Ar - Ci * Ai, Wi = Cr * Ai + Ci * Ar, Br = BB[(g * 64 + p) * 32 + 2 * hp], Bi = BB[(g * 64 + p) * 32 + 2 * hp + 1]; s += Wr * Br - Wi * Bi; }
            if (j == 0 && h == hp) s += d_skip[g * 16 + h];
            Ktab[idx] = (bf16_t)(pkbf(s, 0.f) & 0xffffu);
        }
        for (int idx = gt2; idx < 1048576; idx += NGT2) {
            { const int g = idx >> 15, comp = (idx >> 8) & 127, k = idx & 255, p = comp & 63, im = comp >> 6, sl = k >> 4, hp = k & 15;
              const float Ar = AP[(g * 64 + p) * 36 + 2 * (15 - sl)], Ai = AP[(g * 64 + p) * 36 + 2 * (15 - sl) + 1], Br = BB[(g * 64 + p) * 32 + 2 * hp], Bi = BB[(g * 64 + p) * 32 + 2 * hp + 1];
              const float v = im ? (Ar * Bi + Ai * Br) : (Ar * Br - Ai * Bi); Pend[idx] = (bf16_t)(pkbf(v, 0.f) & 0xffffu); }
            { const int g = idx >> 15, n = (idx >> 7) & 255, tl = n >> 4, h = n & 15, comp = idx & 127, p = comp & 63, im = comp >> 6;
              const float Cr = c_re[(g * 16 + h) * 64 + p], Ci = c_im[(g * 16 + h) * 64 + p], Ar = AP[(g * 64 + p) * 36 + 2 * (tl + 1)], Ai = AP[(g * 64 + p) * 36 + 2 * (tl + 1) + 1];
              const float v = im ? -(Cr * Ai + Ci * Ar) : (Cr * Ar - Ci * Ai); Cc[idx] = (bf16_t)(pkbf(v, 0.f) & 0xffffu); }
        }
    }
    GSYNC(); STAMP();
    {
        IDS();
        pg8::Gemm gm{WSP(bf16_t, WS_H1), WSP(bf16_t, WS_W2A), TOK, DMODEL, DFF}; pg8::StaticOrder S; S.init(TOK, DMODEL, G, bx);
        EpiRes<false, false> E{INP(0), WSP(bf16_t, WS_XB), WSP(float, WS_SSQ1), nullptr, 0.5f};
        pg8::gemm_phase<EpiRes<false, false>, pg8::StaticOrder, true, true>(lds, gm, S, E, tid);
    }
    GSYNC(); STAMP();
    {
        IDS();
        const float* b_f = INP(8); const bf16_t* XB = WSP(bf16_t, WS_XB); const bf16_t* Wf = WSP(bf16_t, WS_WF); const float* ssq1 = WSP(float, WS_SSQ1); float* LOGF = WSP(float, WS_LOGF);
        const int fr = lane & 15, fq = lane >> 4;
        for (int it = gw >> 1; it < TOK / 16; it += NGW >> 1) {
            const int t0 = it * 16, kh = wave & 1; f32x4 acc0 = (f32x4){0.f, 0.f, 0.f, 0.f}, acc1 = acc0;
            const bf16_t* ap = XB + (size_t)(t0 + fr) * DMODEL + 8 * fq + 512 * kh; const bf16_t* bp = Wf + fr * DMODEL + 8 * fq + 512 * kh;
            bf16x8 av[16], bv[16];
#pragma unroll
            for (int ks = 0; ks < 16; ++ks) { av[ks] = *(const bf16x8*)(ap + 32 * ks); bv[ks] = *(const bf16x8*)(bp + 32 * ks); }
#pragma unroll
            for (int ks = 0; ks < 16; ks += 2) { acc0 = __builtin_amdgcn_mfma_f32_16x16x32_bf16(av[ks], bv[ks], acc0, 0, 0, 0); acc1 = __builtin_amdgcn_mfma_f32_16x16x32_bf16(av[ks + 1], bv[ks + 1], acc1, 0, 0, 0); }
            f32x4 acc = acc0 + acc1;
            LAS f32x4* xch = (LAS f32x4*)(lds + (wave >> 1) * 1024) + lane;
            if (kh) *xch = acc;
            __syncthreads();
            if (!kh) { acc = acc + *xch;
                if (fr < 8) { const int r0 = t0 + 4 * fq; const float bf = b_f[fr]; f32x4 o;
#pragma unroll
                    for (int i = 0; i < 4; ++i) { const float z = rstd_row<16>(ssq1, r0 + i, 1.f / 1024.f) * acc[i] + bf; o[i] = fminf(z, 0.f) - log1pf(expf(-fabsf(z))); }
                    *(f32x4*)(LOGF + (size_t)((r0 >> 13) * 8 + fr) * SEQL + (r0 & 8191)) = o; } }
            __syncthreads();
        }
        pg8::Gemm gm{XB, WSP(bf16_t, WS_WIN), TOK, 2048, DMODEL}; pg8::StaticOrder S; S.init(TOK, 2048, G, bx);
        EpiQKVU E{WSP(bf16_t, WS_Q), WSP(bf16_t, WS_U), ssq1, WSP(unsigned, WS_CTL) + 13312};
        pg8::gemm_phase<EpiQKVU, pg8::StaticOrder, true, true>(lds, gm, S, E, tid);
    }
    GSYNC(); STAMP();
    {
        volatile LAS int* qs = (volatile LAS int*)(lds + MISC_OFF);
        for (;;) {
            IDS();
            if (tid == 0) qs[0] = (int)__hip_atomic_fetch_add(WSP(unsigned, WS_CTL) + 64, 1u, __ATOMIC_RELAXED, __HIP_MEMORY_SCOPE_AGENT);
            __syncthreads();
            const int item = __builtin_amdgcn_readfirstlane(qs[0]);
            __syncthreads();
            if (item >= 64 + NATT + 352 + 256 + 128) break;
            if (item >= 64 + NATT + 352 + 256) {
                const int j_ = item - (64 + NATT + 352 + 256);
                if (tid == 0) { unsigned* dn = WSP(unsigned, WS_CTL) + 13400 + (j_ >> 6);
                    for (unsigned sp = 0; sp < (1u << 22); ++sp) { if (__hip_atomic_load(dn, __ATOMIC_RELAXED, __HIP_MEMORY_SCOPE_AGENT) >= 32u) break; __builtin_amdgcn_s_sleep(8); }
                    __builtin_amdgcn_fence(__ATOMIC_ACQUIRE, "agent"); asm volatile("s_waitcnt vmcnt(0)" ::: "memory"); }
                __syncthreads();
                pg8::Gemm gm{WSP(bf16_t, WS_Y), WSP(bf16_t, WS_WGLU), TOK, HW, HW}; StrideOrder S{j_, 1 << 28, 128, 2};
                EpiGlu E{WSP(bf16_t, WS_Y), INP(18), WSP(bf16_t, WS_SSMO), WSP(float, WS_SSQS)};
                pg8::gemm_phase<EpiGlu, StrideOrder, true, true>(lds, gm, S, E, tid); continue; }
            if (item >= 64 + NATT + 352) {
                pg8::Gemm gm{WSP(bf16_t, WS_PB), WSP(bf16_t, WS_WP), TOK, DMODEL, PLE}; StrideOrder S{item - (64 + NATT + 352), 1 << 28, 256, 4};
                EpiBf16P E{WSP(bf16_t, WS_PP)};
                pg8::gemm_phase<EpiBf16P, StrideOrder, true, true>(lds, gm, S, E, tid); continue; }
            if (item >= 64 + NATT) {
                tr_w13(INP(23), INP(24), INP(22), WSP(bf16_t, WS_W13B), (item - (64 + NATT)) * 8 + wave, (LAS float*)(lds + wave * 16384), lane);
                __syncthreads(); continue; }
            const bool is_ssm = item < 64;
#ifdef PROBE_SEL1
            const unsigned long long t0_ = __builtin_amdgcn_s_memrealtime();
#endif
            if (is_ssm) ssm_item(item, WSP(bf16_t, WS_U), WSP(bf16_t, WS_KTAB), WSP(bf16_t, WS_PEND), WSP(bf16_t, WS_CC), WSP(float, WS_AP), WSP(bf16_t, WS_Y), lds, tid, WSP(unsigned, WS_CTL) + 13400 + (item >> 5));
            else { const int a_ = item - 64; int kind, bh, qb;
                if (a_ < 64) { kind = 2; bh = a_ & 15; qb = 19 - (a_ >> 4); }
                else if (a_ < 64 + 576) { const int c_ = a_ - 64, lvl = c_ / 48, r_ = c_ % 48; kind = r_ >> 4; bh = r_ & 15; qb = kind < 2 ? 31 - lvl : 15 - lvl; }
                else { const int c_ = a_ - 640; kind = 2; bh = c_ & 15; qb = 3 - (c_ >> 4); }
                const int ntf = 4 * (qb + 1), tm = ntf >> 1, tb = kind == 0 ? tm : 0, te = kind == 1 ? tm : ntf, mode = kind == 2 ? 0 : (kind == 0 ? 2 : 1), sid = kind < 2 ? (qb - 20) * 16 + bh : 0;
                attn_body::attn_unit<96>(bh >> 3, bh & 7, qb, tb, te, mode, (sid < 60 ? WSP(float, 180 * MiB) + (size_t)sid * PARTF : sid < 105 ? WSP(float, WS_W2B) + (size_t)(sid - 60) * PARTF : WSP(float, 236 * MiB) + (size_t)(sid - 105) * PARTF), WSP(unsigned, WS_CTL) + 12288 + sid, WSP(unsigned, WS_CTL) + 13312 + 2 * bh,
                    WSP(attn_body::bf16, WS_Q), WSP(attn_body::bf16, WS_K), WSP(attn_body::bf16, WS_V), WSP(attn_body::bf16, WS_Q), WSP(float, WS_LOGF), WSP(float, WS_SSQA), (char*)lds_raw, tid); }
#ifdef PROBE_SEL1
            if (tid == 0) { const unsigned d_ = (unsigned)(__builtin_amdgcn_s_memrealtime() - t0_); atomicMax(WSP(unsigned, WS_CTL) + (is_ssm ? 128 : 129), d_); if (is_ssm) atomicMin(WSP(unsigned, WS_CTL) + 130, ~d_); }
#endif
        }
    }
    GSYNC(); STAMP();
    {
        { IDS(); pg8::Gemm gm{WSP(bf16_t, WS_Q), WSP(bf16_t, WS_WOA), TOK, DMODEL, DMODEL, WSP(bf16_t, WS_SSMO), HW}; pg8::StaticOrder S; S.init(TOK, DMODEL, G, bx);
          EpiOut E{WSP(bf16_t, WS_XB), WSP(float, WS_SSQ2), WSP(float, WS_SSQA), WSP(float, WS_SSQS)};
          pg8::gemm_phase<EpiOut, pg8::StaticOrder, true, true>(lds, gm, S, E, tid); }
    }
    GSYNC(); STAMP();
    {
        IDS();
        pg8::Gemm gm{WSP(bf16_t, WS_XB), WSP(bf16_t, WS_W13B), TOK, 2 * DFF, DMODEL}; pg8::StaticOrder S; S.init(TOK, 2 * DFF, G, bx);
        EpiSwiglu E{WSP(bf16_t, WS_H1), WSP(float, WS_SSQ2)};
        pg8::gemm_phase<EpiSwiglu, pg8::StaticOrder, true, true>(lds, gm, S, E, tid);
    }
    if ((int)blockIdx.x >= (int)gridDim.x / 2) {
        IDS();
        const float *w2_b = INP(25), *g_ple = INP(26), *w_ple_gate = INP(27); bf16_t *W2b = WSP(bf16_t, WS_W2B), *Wg = WSP(bf16_t, WS_WG);
        LAS float* scr = (LAS float*)(lds + wave * 16384);
        constexpr int I_2 = 44 * 32, I_G = 16 * 32;
        for (int it = (bx - G / 2) * 8 + wave; it < I_2 + I_G; it += (G - G / 2) * 8) {
            int r = it;
            if (r < I_2) { tr_item(w2_b, DMODEL, 64 * (r / 32), 32 * (r % 32), nullptr, W2b, DFF, 32 * (r % 32), scr, lane); continue; } r -= I_2;
            tr_item(w_ple_gate, DMODEL, 64 * (r / 32), 32 * (r % 32), g_ple, Wg, DMODEL, 32 * (r % 32), scr, lane);
        }
    }
    GSYNC(); STAMP();
    {
        IDS();
        pg8::Gemm gm{WSP(bf16_t, WS_H1), WSP(bf16_t, WS_W2B), TOK, DMODEL, DFF}; pg8::StaticOrder S; S.init(TOK, DMODEL, G, bx);
        EpiRes<false, true> E{nullptr, WSP(bf16_t, WS_XB), WSP(float, WS_SSQ3), nullptr, 0.5f};
        pg8::gemm_phase<EpiRes<false, true>, pg8::StaticOrder, true, true>(lds, gm, S, E, tid);
    }
    GSYNC(); STAMP();
    {
        if ((int)gridDim.x == 256) { IDS(); pg8::Gemm gm{WSP(bf16_t, WS_XB), WSP(bf16_t, WS_WG), TOK, DMODEL, DMODEL}; pg8::StaticOrder S; S.init(TOK, DMODEL, G, bx);
          EpiGateFinal E{WSP(bf16_t, WS_XB), OUTP, WSP(bf16_t, WS_PP), WSP(float, WS_SSQ3), WSP(float, WS_SSQ4), WSP(unsigned, WS_CTL) + 4608, INP(29), (LAS float*)(lds + RING_BYTES)};
          pg8::gemm_phase<EpiGateFinal, pg8::StaticOrder, true, true>(lds, gm, S, E, tid); }
        else { IDS(); pg8::Gemm gm{WSP(bf16_t, WS_XB), WSP(bf16_t, WS_WG), TOK, DMODEL, DMODEL}; pg8::StaticOrder S; S.init(TOK, DMODEL, G, bx);
          EpiGate E{WSP(bf16_t, WS_XB), OUTP, WSP(bf16_t, WS_PP), WSP(float, WS_SSQ3), WSP(float, WS_SSQ4)};
          pg8::gemm_phase<EpiGate, pg8::StaticOrder, true, true>(lds, gm, S, E, tid); }
    }
    if ((int)gridDim.x != 256) {
    GSYNC(); STAMP();
    { IDS(); const float* ssq4 = WSP(float, WS_SSQ4); float* out = OUTP; const float* g_final = INP(29);
    for (int m = gw; m < TOK; m += NGW) {
        const float rs = rstd_row<16>(ssq4, m, 1.f / 1024.f); f32x4* o = (f32x4*)(out + (size_t)m * DMODEL) + lane; const f32x4* gf = (const f32x4*)g_final + lane;
#pragma unroll
        for (int j = 0; j < 4; ++j) { const f32x4 v = o[64 * j], gg = gf[64 * j]; o[64 * j] = v * rs * gg; }
    } }
    }
#ifdef PROBE_SEL1
    GSYNC(); STAMP();
    if (blockIdx.x == 0) { IDS(); const unsigned long long* ts_ = (const unsigned long long*)(ap_->ws + 1024); const unsigned* cw = WSP(unsigned, WS_CTL);
        float dur[15];
#pragma unroll
        for (int k = 0; k < 11; ++k) dur[k] = (float)(ts_[k + 1] - ts_[k]) * 0.01f;
        dur[11] = (float)cw[128] * 0.01f; dur[12] = (float)cw[129] * 0.01f; dur[13] = (float)(~cw[130]) * 0.01f; dur[14] = (float)(ts_[11] - ts_[0]) * 0.01f;
        float t1 = 0.f, t2 = 0.f;
#pragma unroll
        for (int k = 0; k < 15; ++k) { if (k == PROBE_SEL1) t1 = dur[k]; if (k == PROBE_SEL2) t2 = dur[k]; }
        if (tid == 0) OUTP[0] += t1 * 0.01f;
        for (int r = tid; r < 1024; r += 512) OUTP[(size_t)(r * 16) * DMODEL + 1] += t2 * 0.01f; }
#endif
}

extern "C" void kernel_launch(void* const* d_in, const int* in_sizes, int n_in, void* d_out, int out_size, void* d_ws, size_t ws_size, hipStream_t stream) {
    static int grid = 0;
    if (grid == 0) {
        if (n_in != 30 || out_size != TOK * DMODEL || ws_size < WS_END) { fprintf(stderr, "kernel_launch: unexpected problem (n_in %d out %d ws %zu)\n", n_in, out_size, ws_size); grid = -1; return; }
        int dev = 0, cus = 0, per_cu = 0;
        (void)hipGetDevice(&dev); (void)hipDeviceGetAttribute(&cus, hipDeviceAttributeMultiprocessorCount, dev);
        if (hipFuncSetAttribute((const void*)mk_fwd, hipFuncAttributeMaxDynamicSharedMemorySize, LDS_BYTES) != hipSuccess) { fprintf(stderr, "kernel_launch: hipFuncSetAttribute failed\n"); grid = -1; return; }
        if (hipOccupancyMaxActiveBlocksPerMultiprocessor(&per_cu, (const void*)mk_fwd, 512, LDS_BYTES) != hipSuccess || per_cu < 1) { fprintf(stderr, "kernel_launch: occupancy query gave %d\n", per_cu); per_cu = 1; }
        (void)hipGetLastError();
        grid = cus * per_cu;
    }
    if (grid < 0) return;
    Args a{};
    for (int i = 0; i < 30; ++i) a.in[i] = (const float*)d_in[i];
    a.out = (float*)d_out; a.ws = (unsigned char*)d_ws;
    void* args[] = {&a};
    hipError_t e = hipLaunchCooperativeKernel((const void*)mk_fwd, dim3(grid), dim3(512), args, LDS_BYTES, stream);
    if (e != hipSuccess) fprintf(stderr, "kernel_launch: cooperative launch failed: %s (grid %d)\n", hipGetErrorString(e), grid);
}
```

```cpp
#include <hip/hip_runtime.h>
#include <hip/hip_bf16.h>
#include <cmath>
#include <hip/hip_cooperative_groups.h>
#include <cstdio>
#include <cstdint>
namespace cg = cooperative_groups;
template <int MASK> __device__ __forceinline__ float sx(float v) { return __builtin_bit_cast(float, __builtin_amdgcn_ds_swizzle(__builtin_bit_cast(int, v), (MASK << 10) | 0x1f)); }
__device__ __forceinline__ float sum32(float v) { unsigned a = __builtin_bit_cast(unsigned, v), b = a; asm volatile("v_nop\n\tv_nop\n\tv_permlane32_swap_b32 %0, %1" : "+v"(a), "+v"(b)); return __builtin_bit_cast(float, a) + __builtin_bit_cast(float, b); }
__device__ __forceinline__ float max32(float v) { unsigned a = __builtin_bit_cast(unsigned, v), b = a; asm volatile("v_nop\n\tv_nop\n\tv_permlane32_swap_b32 %0, %1" : "+v"(a), "+v"(b)); return __builtin_fmaxf(__builtin_bit_cast(float, a), __builtin_bit_cast(float, b)); }
namespace pg8 {
#define PG8_LAS __attribute__((address_space(3)))
typedef unsigned short bf16_t;
typedef short bf16x8 __attribute__((ext_vector_type(8)));
typedef float f32x4 __attribute__((ext_vector_type(4)));
typedef unsigned u32x4 __attribute__((ext_vector_type(4)));
constexpr int BM = 256, BK = 64, HALF = 128, HTB = HALF * BK * 2  , STAGE_BYTES = 8 * HTB, NXCD = 8, WGM = 8;

__host__ __device__ __forceinline__ int lds_byte(int r, int c) { const int st = (r >> 4) * 2 + (c >> 5), rr = r & 15, cc = c & 31, ob = rr * 64 + cc * 2; return st * 1024 + (ob ^ (((ob >> 9) & 1) << 5)); }
__host__ __device__ __forceinline__ void stage_rc(int b, int& R, int& C) { const int st = b / 1024, sb = b % 1024, swz = sb ^ (((sb >> 9) & 1) << 5); R = (st >> 1) * 16 + swz / 64; C = (st & 1) * 32 + (swz % 64) / 2; }
__host__ __device__ __forceinline__ int perm32(int rho) { const int n = rho >> 4, i = rho & 15; return 8 * (i >> 2) + 4 * n + (i & 3); }

struct Unit { int pm, pn; };
struct Gemm { const bf16_t* A; const bf16_t* Bt; int M, N, K; const bf16_t* A2 = nullptr; int lda = 0; };

struct StaticOrder {
    int nM, nN, nwg, G, c;
    __host__ __device__ void init(int M, int N, int G_, int c_) { nM = M / BM; nN = N / BM; nwg = nM * nN; G = G_; c = c_; }
    __host__ __device__ bool next(int i, Unit& u) const {
        const long L = (long)i * G + c; if (L >= nwg) return false;
        int wgid = (int)L; { const int q = nwg / NXCD, r = nwg % NXCD, xcd = wgid % NXCD, off = wgid / NXCD; wgid = (xcd < r ? xcd * (q + 1) : r * (q + 1) + (xcd - r) * q) + off; }
        const int nig = WGM * nN, gid = wgid / nig, fm = gid * WGM, gsz = (nM - fm) < WGM ? (nM - fm) : WGM;
        u.pm = fm + ((wgid % nig) % gsz); u.pn = (wgid % nig) / gsz; return true;
    }
    __device__ __forceinline__ void a_ready(const Unit&) const {}
    __device__ __forceinline__ void done(const Unit&) const {}
};

__device__ __forceinline__ unsigned cvt_pk_bf16(float lo, float hi) { unsigned r; asm volatile("v_cvt_pk_bf16_f32 %0, %1, %2" : "=v"(r) : "v"(lo), "v"(hi)); return r; }
typedef float f32x2 __attribute__((ext_vector_type(2)));
template <class Epi, class Sched, bool ALIGN_EPI = false, bool SP2 = false>
__device__ __forceinline__ void gemm_phase(PG8_LAS unsigned char* lds, const Gemm g, const Sched& S, const Epi& E, int tid_in) {
    int tid_ = tid_in; asm volatile("" : "+v"(tid_)); const int tid = tid_, wid = __builtin_amdgcn_readfirstlane(tid >> 6), lane = tid & 63, wr = wid >> 2, wc = wid & 3, fr = lane & 15, fq = lane >> 4;
    const int K = g.K, nt = K / BK, lda = g.lda ? g.lda : K, ksplit = g.A2 ? nt / 2 : nt;
    unsigned voffA[2], voffB[2];
#pragma unroll
    for (int i = 0; i < 2; ++i) { int R, C; stage_rc(tid * 16 + i * 8192, R, C); const int Rb = Epi::PERM ? ((R & ~31) + perm32(R & 31)) : R;
        voffA[i] = (unsigned)(R * lda + C) * 2u; voffB[i] = (unsigned)(Rb * K + C) * 2u; }
    const size_t kstep = (size_t)(BK * 2);
    const size_t hstep = (size_t)HALF * K * 2;
    const size_t tstep = 2 * hstep; const size_t hstepA = (size_t)HALF * lda * 2, tstepA = 2 * hstepA;
    const unsigned ldsw = (unsigned)wid * 1024u;
    const int aoff = lds_byte(wr * 64 + fr, fq * 8), boff = lds_byte(wc * 32 + fr, fq * 8);
#define PG8_SA(b, h) (((b) * 2 + (h)) * HTB)
#define PG8_SB(b, h) ((4 + (b) * 2 + (h)) * HTB)
#define PG8_STAGE(bufoff, gbase, voff) do { _Pragma("unroll") for (int _i = 0; _i < 2; ++_i) \
        __builtin_amdgcn_global_load_lds((const unsigned*)((const char*)(gbase) + (voff)[_i]), (PG8_LAS unsigned*)(lds + (bufoff) + ldsw + _i * 8192), 16, 0, 0); } while (0)
#define PG8_LDA(dst, b, h) do { _Pragma("unroll") for (int m = 0; m < 4; ++m) _Pragma("unroll") for (int k = 0; k < 2; ++k) dst[m][k] = *(const PG8_LAS bf16x8*)(lds + PG8_SA(b, h) + aoff + m * 2048 + k * 1024); } while (0)
#define PG8_LDB(dst, b, h) do { _Pragma("unroll") for (int n = 0; n < 2; ++n) _Pragma("unroll") for (int k = 0; k < 2; ++k) dst[n][k] = *(const PG8_LAS bf16x8*)(lds + PG8_SB(b, h) + boff + n * 2048 + k * 1024); } while (0)
#define PG8_MMA(ai, bj, At, Bt) do { __builtin_amdgcn_s_setprio(1); _Pragma("unroll") for (int m = 0; m < 4; ++m) _Pragma("unroll") for (int n = 0; n < 2; ++n) _Pragma("unroll") for (int k = 0; k < 2; ++k) \
        acc[ai][bj][m][n] = __builtin_amdgcn_mfma_f32_16x16x32_bf16(Bt[n][k], At[m][k], acc[ai][bj][m][n], 0, 0, 0); __builtin_amdgcn_s_setprio(0); } while (0)
#define PG8_WAIT_V(n) asm volatile("s_waitcnt vmcnt(" #n ")" ::: "memory")
#define PG8_WAIT_L(n) asm volatile("s_waitcnt lgkmcnt(" #n ")" ::: "memory")
#define PG8_BAR __builtin_amdgcn_s_barrier()
#define PG8_SCHED __builtin_amdgcn_sched_barrier(0)
    Unit cur, nxt; int ui = 0;
    if (!S.next(0, cur)) return;
    f32x4 acc[2][2][4][2];
#pragma unroll
    for (int a = 0; a < 2; ++a)
#pragma unroll
        for (int b = 0; b < 2; ++b)
#pragma unroll
            for (int m = 0; m < 4; ++m)
#pragma unroll
                for (int n = 0; n < 2; ++n) acc[a][b][m][n] = (f32x4){0.f, 0.f, 0.f, 0.f};
    bf16x8 At[4][2], B0[2][2], B1[2][2];
    const char* cA = (const char*)g.A + (size_t)cur.pm * tstepA; const char* cA2 = (const char*)g.A2 + (size_t)cur.pm * tstepA; const char* cB = (const char*)g.Bt + (size_t)cur.pn * tstep;
    S.a_ready(cur);
    if constexpr (SP2) {
        PG8_STAGE(PG8_SB(0, 0), cB, voffB); PG8_STAGE(PG8_SB(0, 1), cB + hstep, voffB); PG8_STAGE(PG8_SA(0, 0), cA, voffA); PG8_STAGE(PG8_SA(0, 1), cA + hstepA, voffA);
        if (wr == 1) PG8_BAR;
        PG8_WAIT_V(2); PG8_BAR;
        PG8_STAGE(PG8_SB(1, 0), cB + kstep, voffB); PG8_STAGE(PG8_SA(1, 0), cA + kstep, voffA); PG8_STAGE(PG8_SB(1, 1), cB + hstep + kstep, voffB);
        PG8_WAIT_V(6); PG8_BAR;
    } else {
        PG8_STAGE(PG8_SB(0, 0), cB, voffB); PG8_STAGE(PG8_SA(0, 0), cA, voffA); PG8_STAGE(PG8_SB(0, 1), cB + hstep, voffB); PG8_STAGE(PG8_SA(0, 1), cA + hstepA, voffA);
        if (wr == 1) PG8_BAR;
        PG8_WAIT_V(4); PG8_BAR;
        PG8_STAGE(PG8_SB(1, 0), cB + kstep, voffB); PG8_STAGE(PG8_SA(1, 0), cA + kstep, voffA); PG8_STAGE(PG8_SB(1, 1), cB + hstep + kstep, voffB);
        PG8_WAIT_V(6); PG8_BAR;
    }
    for (;;) {
        const bool has_next = S.next(ui + 1, nxt);
        const char* nA = has_next ? (const char*)g.A + (size_t)nxt.pm * tstepA : cA; const char* nA2 = has_next ? (const char*)g.A2 + (size_t)nxt.pm * tstepA : cA2; const char* nB = has_next ? (const char*)g.Bt + (size_t)nxt.pn * tstep : cB;
        for (int t = 0; t < nt; t += 2) {
            const bool last = (t == nt - 2);
            const char* a1 = (t + 1 < ksplit) ? cA + (size_t)(t + 1) * kstep : cA2 + (size_t)(t + 1 - ksplit) * kstep;
            const char* a2 = last ? nA : ((t + 2 < ksplit) ? cA + (size_t)(t + 2) * kstep : cA2 + (size_t)(t + 2 - ksplit) * kstep); const char* b2 = last ? nB : cB + (size_t)(t + 2) * kstep;
            const char* a3 = a2 + kstep; const char* b3 = b2 + kstep;
            if (last && has_next) S.a_ready(nxt);
            if constexpr (Epi::MIDK) { if (t == nt / 2) { int l_; asm volatile("v_mbcnt_lo_u32_b32 %0, -1, 0\n\tv_mbcnt_hi_u32_b32 %0, -1, %0" : "=v"(l_)); E.mid(acc, cur, wr, wc, l_ & 15, l_ >> 4); } }
            if constexpr (SP2) {
            PG8_LDB(B0, 0, 0); PG8_LDB(B1, 0, 1); PG8_SCHED; PG8_LDA(At, 0, 0); PG8_STAGE(PG8_SA(1, 1), a1 + hstepA, voffA);
            PG8_WAIT_V(8); PG8_WAIT_L(0); PG8_BAR; PG8_MMA(0, 0, At, B0); PG8_MMA(0, 1, At, B1); PG8_BAR; PG8_SCHED;
            PG8_LDA(At, 0, 1); PG8_STAGE(PG8_SB(0, 0), b2, voffB); PG8_STAGE(PG8_SB(0, 1), b2 + hstep, voffB); PG8_STAGE(PG8_SA(0, 0), a2, voffA);
            PG8_WAIT_V(8); PG8_WAIT_L(0); PG8_BAR; PG8_MMA(1, 0, At, B0); PG8_MMA(1, 1, At, B1); PG8_BAR; PG8_SCHED;
            PG8_LDB(B0, 1, 0); PG8_LDB(B1, 1, 1); PG8_SCHED; PG8_LDA(At, 1, 0); PG8_STAGE(PG8_SA(0, 1), a2 + hstepA, voffA);
            PG8_WAIT_V(8); PG8_WAIT_L(0); PG8_BAR; PG8_MMA(0, 0, At, B0); PG8_MMA(0, 1, At, B1); PG8_BAR; PG8_SCHED;
            PG8_LDA(At, 1, 1); PG8_STAGE(PG8_SB(1, 0), b3, voffB); PG8_STAGE(PG8_SB(1, 1), b3 + hstep, voffB); PG8_STAGE(PG8_SA(1, 0), a3, voffA);
            PG8_WAIT_V(8); PG8_WAIT_L(0); PG8_BAR; PG8_MMA(1, 0, At, B0); PG8_MMA(1, 1, At, B1); PG8_BAR; PG8_SCHED;
            } else {
            PG8_LDB(B0, 0, 0); PG8_SCHED; PG8_LDA(At, 0, 0); PG8_STAGE(PG8_SA(1, 1), a1 + hstepA, voffA);
            PG8_WAIT_L(8); PG8_BAR; PG8_WAIT_L(0); PG8_MMA(0, 0, At, B0); PG8_BAR; PG8_SCHED;
            PG8_LDB(B1, 0, 1); PG8_STAGE(PG8_SB(0, 0), b2, voffB);
            PG8_BAR; PG8_WAIT_L(0); PG8_MMA(0, 1, At, B1); PG8_BAR;
            PG8_LDA(At, 0, 1); PG8_STAGE(PG8_SA(0, 0), a2, voffA);
            PG8_BAR; PG8_WAIT_L(0); PG8_MMA(1, 0, At, B0); PG8_BAR; PG8_SCHED;
            PG8_STAGE(PG8_SB(0, 1), b2 + hstep, voffB);
            PG8_WAIT_V(6); PG8_BAR; PG8_MMA(1, 1, At, B1); PG8_BAR;
            PG8_LDB(B0, 1, 0); PG8_SCHED; PG8_LDA(At, 1, 0); PG8_STAGE(PG8_SA(0, 1), a2 + hstepA, voffA);
            PG8_WAIT_L(8); PG8_BAR; PG8_WAIT_L(0); PG8_MMA(0, 0, At, B0); PG8_BAR; PG8_SCHED;
            PG8_LDB(B1, 1, 1); PG8_STAGE(PG8_SB(1, 0), b3, voffB);
            PG8_BAR; PG8_WAIT_L(0); PG8_MMA(0, 1, At, B1); PG8_BAR;
            PG8_LDA(At, 1, 1); PG8_STAGE(PG8_SA(1, 0), a3, voffA);
            PG8_BAR; PG8_WAIT_L(0); PG8_MMA(1, 0, At, B0); PG8_BAR; PG8_SCHED;
            PG8_STAGE(PG8_SB(1, 1), b3 + hstep, voffB);
            PG8_WAIT_V(6); PG8_BAR; PG8_MMA(1, 1, At, B1); PG8_BAR;
            }
        }
        if constexpr (ALIGN_EPI) { if (wr == 0) PG8_BAR; }
        if constexpr (!Epi::AFTER_DRAIN) { int l_; asm volatile("v_mbcnt_lo_u32_b32 %0, -1, 0\n\tv_mbcnt_hi_u32_b32 %0, -1, %0" : "=v"(l_)); E(acc, cur, wr, wc, l_ & 15, l_ >> 4); S.done(cur); }
        if (!has_next) break;
#pragma unroll
        for (int a = 0; a < 2; ++a)
#pragma unroll
            for (int b = 0; b < 2; ++b)
#pragma unroll
                for (int m = 0; m < 4; ++m)
#pragma unroll
                    for (int n = 0; n < 2; ++n) acc[a][b][m][n] = (f32x4){0.f, 0.f, 0.f, 0.f};
        cur = nxt; cA = nA; cA2 = nA2; cB = nB; ++ui;
        if constexpr (ALIGN_EPI) { if (wr == 1) PG8_BAR; }
    }
    PG8_WAIT_V(0);
    if constexpr (!ALIGN_EPI) { if (wr == 0) PG8_BAR; }
    PG8_BAR;
    if constexpr (Epi::AFTER_DRAIN) { E.fused(acc, cur, wr, wc, fr, fq, lds, wid, lane); S.done(cur); }
#undef PG8_SA
#undef PG8_SB
#undef PG8_STAGE
#undef PG8_LDA
#undef PG8_LDB
#undef PG8_MMA
#undef PG8_WAIT_V
#undef PG8_WAIT_L
#undef PG8_BAR
#undef PG8_SCHED
}
}

#ifndef PG8_SP2
#define PG8_SP2 true
#endif
#ifndef PG8_ALIGN
#define PG8_ALIGN true
#endif
#include <hip/hip_bf16.h>
#include <cmath>
namespace attn_body {
using bf16=__hip_bfloat16;
using bf16x8=__attribute__((ext_vector_type(8)))short;
using s16x4=__attribute__((ext_vector_type(4)))short;
using f32x16=__attribute__((ext_vector_type(16)))float;
using u32x4=__attribute__((ext_vector_type(4)))unsigned;
using f32x4v=__attribute__((ext_vector_type(4)))float;
constexpr int BATCH=2,NHEAD=8,SEQ=8192,D=64,DM=NHEAD*D;
constexpr int NW=8,QBLK=32,QB=QBLK*NW,KVBLK=64,NQB=SEQ/QB;
constexpr int ATTN_PITCH=DM, ATTN_UNIT_ROWS=QB;
__device__ __forceinline__ int crow(int r,int hi){return (r&3)+8*(r>>2)+4*hi;}
#define SBAR() __builtin_amdgcn_sched_barrier(0)
__device__ __forceinline__ void cmask(f32x16&p0,f32x16&p1,int jb,int qrel,int hi){
  const float NEG=-INFINITY; int kb=64*jb+4*hi;
  #pragma unroll
  for(int r=0;r<16;++r){int kv=kb+(r&3)+8*(r>>2); if(kv>qrel)p0[r]=NEG; if(kv+32>qrel)p1[r]=NEG;}
}

constexpr int NSLOT=3, SLOTB=8192;
constexpr int LDS_K=0, LDS_V=NSLOT*SLOTB, LDS_WS=2*NSLOT*SLOTB, LDS_OST=LDS_WS+NW*64*4, LDS_BIAS=LDS_OST+NW*4096, LDS_WT=LDS_BIAS+SEQ*4, LDS_BYTES=LDS_WT+64;
constexpr float C2=0.125f*1.4426950408889634f;
__device__ __forceinline__ void glds16(const void*gsrc,unsigned lds_dst){unsigned keep;
  asm volatile("s_mov_b32 %0, m0\n\ts_mov_b32 m0, %2\n\ts_nop 0\n\tglobal_load_lds_dwordx4 %1, off\n\ts_mov_b32 m0, %0":"=&s"(keep):"v"(gsrc),"s"(lds_dst):"memory");}
__device__ __forceinline__ float max3f(float a,float b,float c){float r;asm("v_max3_f32 %0, %1, %2, %3":"=v"(r):"v"(a),"v"(b),"v"(c));return r;}
__device__ __forceinline__ float max2f(float a,float b){float r;asm("v_max_f32_e32 %0, %1, %2":"=v"(r):"v"(a),"v"(b));return r;}
__device__ __forceinline__ float fadd_s(float a,float b){float r;asm("v_add_f32_e32 %0, %1, %2":"=v"(r):"v"(a),"v"(b));return r;}
__device__ __forceinline__ float fsub_s(float a,float b){float r;asm("v_sub_f32_e32 %0, %1, %2":"=v"(r):"v"(a),"v"(b));return r;}
typedef float f32x2_t __attribute__((ext_vector_type(2))); typedef __bf16 bf16x2_t __attribute__((ext_vector_type(2)));
__device__ __forceinline__ unsigned cvtpk_s(float lo,float hi){f32x2_t v={lo,hi};bf16x2_t b=__builtin_convertvector(v,bf16x2_t);return __builtin_bit_cast(unsigned,b);}
#define WAIT_BAR(N) asm volatile("s_waitcnt vmcnt(" #N ") lgkmcnt(0)\n\ts_barrier":::"memory")

__device__ __forceinline__ void qkt(f32x16&p0,f32x16&p1,const char*Kslot,const bf16x8*qr,int r32,int hi){
  const char*kb=Kslot+hi*1024+r32*16;
  #pragma unroll
  for(int d0=0;d0<4;++d0){
    const bf16x8 b0=*reinterpret_cast<const bf16x8*>(kb+d0*2048);
    const bf16x8 b1=*reinterpret_cast<const bf16x8*>(kb+d0*2048+512);
    p0=__builtin_amdgcn_mfma_f32_32x32x16_bf16(b0,qr[d0],p0,0,0,0);p1=__builtin_amdgcn_mfma_f32_32x32x16_bf16(b1,qr[d0],p1,0,0,0);}
}
typedef __attribute__((address_space(3))) const char* lds_cptr;
typedef short v4i16_t __attribute__((ext_vector_type(4)));
__device__ __forceinline__ void kload8(bf16x8*kf,lds_cptr kp){
  kf[0]=*(const __attribute__((address_space(3))) bf16x8*)(kp);      kf[1]=*(const __attribute__((address_space(3))) bf16x8*)(kp+512);
  kf[2]=*(const __attribute__((address_space(3))) bf16x8*)(kp+2048); kf[3]=*(const __attribute__((address_space(3))) bf16x8*)(kp+2560);
  kf[4]=*(const __attribute__((address_space(3))) bf16x8*)(kp+4096); kf[5]=*(const __attribute__((address_space(3))) bf16x8*)(kp+4608);
  kf[6]=*(const __attribute__((address_space(3))) bf16x8*)(kp+6144); kf[7]=*(const __attribute__((address_space(3))) bf16x8*)(kp+6656);
}
__device__ __forceinline__ void kload2(bf16x8*kf,lds_cptr kp,int j){ kf[2*j]=*(const __attribute__((address_space(3))) bf16x8*)(kp+j*2048); kf[2*j+1]=*(const __attribute__((address_space(3))) bf16x8*)(kp+j*2048+512); }
__device__ __forceinline__ s16x4 vtr(lds_cptr p){ return __builtin_bit_cast(s16x4,__builtin_amdgcn_ds_read_tr16_b64_v4i16((__attribute__((address_space(3))) v4i16_t*)p)); }
__device__ __forceinline__ float rowmax(const f32x16&p0,const f32x16&p1){
  float a=max3f(p0[0],p0[1],p1[0]),b=max3f(p0[2],p0[3],p1[1]);a=max3f(a,p1[2],p1[3]);
  #pragma unroll
  for(int r=4;r<16;r+=4){a=max3f(a,p0[r],p0[r+1]);b=max3f(b,p0[r+2],p0[r+3]);a=max3f(a,p1[r],p1[r+1]);b=max3f(b,p1[r+2],p1[r+3]);}
  const float m=max2f(a,b);
  auto rr=__builtin_amdgcn_permlane32_swap(__float_as_uint(m),__float_as_uint(m),false,false);
  return max2f(__uint_as_float(rr[0]),__uint_as_float(rr[1]));
}
__device__ __forceinline__ void pv(f32x16*o,int vb,bf16x8 pa0,bf16x8 pa1,bf16x8 pa2,bf16x8 pa3){
  #pragma unroll
  for(int d0=0;d0<2;++d0){s16x4 lo[4],hi[4];
    #pragma unroll
    for(int ks=0;ks<4;++ks){
      asm volatile("ds_read_b64_tr_b16 %0,%1 offset:%c2":"=&v"(lo[ks]):"v"(vb),"i"(d0*4096+ks*1024):"memory");
      asm volatile("ds_read_b64_tr_b16 %0,%1 offset:%c2":"=&v"(hi[ks]):"v"(vb),"i"(d0*4096+ks*1024+512):"memory");}
    asm volatile("s_waitcnt lgkmcnt(0)":::"memory");SBAR();
    #define PK(k) (bf16x8){lo[k][0],lo[k][1],lo[k][2],lo[k][3],hi[k][0],hi[k][1],hi[k][2],hi[k][3]}
    o[d0]=__builtin_amdgcn_mfma_f32_32x32x16_bf16(pa0,PK(0),o[d0],0,0,0);
    o[d0]=__builtin_amdgcn_mfma_f32_32x32x16_bf16(pa1,PK(1),o[d0],0,0,0);
    o[d0]=__builtin_amdgcn_mfma_f32_32x32x16_bf16(pa2,PK(2),o[d0],0,0,0);
    o[d0]=__builtin_amdgcn_mfma_f32_32x32x16_bf16(pa3,PK(3),o[d0],0,0,0);
    #undef PK
  }
}

#ifndef ATTN_STORE16
#define ATTN_STORE16(p,v) (*(u32x4*)(p)=(v))
#endif
template<int THRL> __device__ __forceinline__ void attn_unit(int b,int h,int qb,int tb_in,int te,int mode,float*__restrict__ part,unsigned*pcnt,const unsigned*kmaxp,const bf16*Q,const bf16*__restrict__ K,const bf16*__restrict__ V,bf16*O,const float*__restrict__ logf,float*__restrict__ ssqA,char*shm,int tid_in){
  int tid_=tid_in; asm volatile("":"+v"(tid_)); const int tid=tid_,lane=tid&63,r32=lane&31,hi=lane>>5; const int wid=__builtin_amdgcn_readfirstlane(tid>>6);
  const long rowbase=(long)b*SEQ; const int q0=qb*QB;
  const bf16*Qw=Q+(rowbase+q0+wid*QBLK)*DM+h*D;
  const lds_cptr shm3=(lds_cptr)shm;
  typedef __attribute__((address_space(3))) float* lds_fptr; typedef __attribute__((address_space(3))) f32x4v* lds_f4ptr;
  const lds_fptr biasL=(lds_fptr)(shm3+LDS_BIAS); const lds_fptr wtot=(lds_fptr)(shm3+LDS_WT);
  bf16x8 qr[4];
  #pragma unroll
  for(int d0=0;d0<4;++d0)qr[d0]=*reinterpret_cast<const bf16x8*>(&Qw[(long)r32*DM+d0*16+hi*8]);
  float qn=0.f;
  #pragma unroll
  for(int d0=0;d0<4;++d0){
    #pragma unroll
    for(int e=0;e<8;++e){const float qv=__uint_as_float(((unsigned)(unsigned short)qr[d0][e])<<16);qn+=qv*qv;}}
  qn=sum32(qn);
  qn=__builtin_fmaxf(qn,sx<1>(qn));qn=__builtin_fmaxf(qn,sx<2>(qn));qn=__builtin_fmaxf(qn,sx<4>(qn));qn=__builtin_fmaxf(qn,sx<8>(qn));qn=__builtin_fmaxf(qn,sx<16>(qn));
  { const int nkeys=q0+QB; const int k0=tid*16; const float*lf=logf+(long)(b*NHEAD+h)*SEQ+k0;
    f32x4v v0={0.f,0.f,0.f,0.f},v1=v0,v2=v0,v3=v0;
    if(k0<nkeys){v0=*(const f32x4v*)(lf);v1=*(const f32x4v*)(lf+4);v2=*(const f32x4v*)(lf+8);v3=*(const f32x4v*)(lf+12);}
    const float tot=((v0[0]+v0[1])+(v0[2]+v0[3]))+((v1[0]+v1[1])+(v1[2]+v1[3]))+((v2[0]+v2[1])+(v2[2]+v2[3]))+((v3[0]+v3[1])+(v3[2]+v3[3]));
    float x=tot;
    #pragma unroll
    for(int off=1;off<64;off<<=1){const float y=__builtin_bit_cast(float,__builtin_amdgcn_ds_bpermute(((lane+off)&63)<<2,__builtin_bit_cast(int,x)));if(lane+off<64)x+=y;}
    if(lane==0){wtot[wid]=x;wtot[8+wid]=qn;}
    __syncthreads();
    float wsum=0.f;
    #pragma unroll
    for(int w=1;w<NW;++w){const float t_=wtot[w];if(w>wid)wsum+=t_;}
    float run=(x-tot)+wsum;
    if(k0<nkeys){ const float L2E=1.4426950408889634f; f32x4v o0,o1,o2,o3;
      o3[3]=run*L2E;run+=v3[3];o3[2]=run*L2E;run+=v3[2];o3[1]=run*L2E;run+=v3[1];o3[0]=run*L2E;run+=v3[0];
      o2[3]=run*L2E;run+=v2[3];o2[2]=run*L2E;run+=v2[2];o2[1]=run*L2E;run+=v2[1];o2[0]=run*L2E;run+=v2[0];
      o1[3]=run*L2E;run+=v1[3];o1[2]=run*L2E;run+=v1[2];o1[1]=run*L2E;run+=v1[1];o1[0]=run*L2E;run+=v1[0];
      o0[3]=run*L2E;run+=v0[3];o0[2]=run*L2E;run+=v0[2];o0[1]=run*L2E;run+=v0[1];o0[0]=run*L2E;
      lds_f4ptr bo=(lds_f4ptr)(biasL+k0); bo[0]=o0;bo[1]=o1;bo[2]=o2;bo[3]=o3; }
    __syncthreads(); }
  int tb=tb_in; bool emptyA=false;
  { float qmx=wtot[8];
    #pragma unroll
    for(int w=1;w<NW;++w)qmx=__builtin_fmaxf(qmx,wtot[8+w]);
    const float kmx=__uint_as_float(__hip_atomic_load(kmaxp,__ATOMIC_RELAXED,__HIP_MEMORY_SCOPE_AGENT))+__uint_as_float(__hip_atomic_load(kmaxp+1,__ATOMIC_RELAXED,__HIP_MEMORY_SCOPE_AGENT));
    const float Bq=__builtin_sqrtf(qmx*kmx)*1.02f;   const float thr=biasL[q0]-150.f-2.f*Bq;
    const int ntf=(q0+QB)/KVBLK; const int skipf=(tid<ntf)?(biasL[KVBLK*tid+KVBLK-1]<thr?1:0):0;
    const unsigned long long bal=__ballot(skipf);
    __syncthreads();
    if(lane==0&&wid<2)wtot[wid]=(float)__popcll(bal);
    __syncthreads();
    int t0=((int)wtot[0]+(int)wtot[1])&~1; emptyA=(mode==1&&t0>=te); if(t0>te-4)t0=te-4; if(t0>tb)tb=t0;
    __syncthreads(); }
  if(!emptyA){
  const bf16*Kh=K+(rowbase+(long)tb*KVBLK)*DM+h*D,*Vh=V+(rowbase+(long)tb*KVBLK)*DM+h*D;
  const unsigned lds0=(unsigned)(uintptr_t)shm;
  float*wsf=(float*)(shm+LDS_WS)+wid*64;
  const bf16*ksrc=Kh+(long)lane*DM+wid*8;
  const bf16*vsrc=Vh+(long)(16*(wid&3)+(lane>>2))*DM+(wid>>2)*32+(lane&3)*8;
  const unsigned kdst=lds0+LDS_K+wid*1024, vdst=lds0+LDS_V+wid*1024;
  #define DMA_K(t,slot) glds16(ksrc+(long)(t)*KVBLK*DM,(unsigned)__builtin_amdgcn_readfirstlane(kdst+(slot)))
  #define DMA_V(t,slot) glds16(vsrc+(long)(t)*KVBLK*DM,(unsigned)__builtin_amdgcn_readfirstlane(vdst+(slot)))
  const int vb0=(int)(lds0+LDS_V)+((lane>>4)&1)*32+(lane&3)*8+(4*hi+((lane&15)>>2))*64;
  const char*Kbase=shm+LDS_K; bf16x8 kf[8];
  const lds_cptr kp0=shm3+LDS_K+hi*1024+r32*16; const lds_cptr vp0=shm3+LDS_V+((lane>>4)&1)*32+(lane&3)*8+(4*hi+((lane&15)>>2))*64;
  const int NT=te-tb;
  const lds_fptr biasp=biasL+4*hi+tb*KVBLK;
  #define BLD(X0,X1,tt) do{ const lds_fptr bp_=biasp+(tt)*KVBLK; \
    _Pragma("unroll") for(int j_=0;j_<4;++j_){ const f32x4v a_=*(const lds_f4ptr)(bp_+8*j_); const f32x4v b_=*(const lds_f4ptr)(bp_+32+8*j_); \
      X0[4*j_]=a_[0];X0[4*j_+1]=a_[1];X0[4*j_+2]=a_[2];X0[4*j_+3]=a_[3]; X1[4*j_]=b_[0];X1[4*j_+1]=b_[1];X1[4*j_+2]=b_[2];X1[4*j_+3]=b_[3]; } }while(0)
  #define BSUB(X,B) do{ const f32x2_t mh2_={mhat,mhat}; _Pragma("unroll") for(int r_=(B);r_<(B)+8;r_+=2){ f32x2_t t_={X[r_],X[r_+1]}; t_=t_-mh2_; X[r_]=t_.x; X[r_+1]=t_.y; } }while(0)
  DMA_K(0,0);DMA_V(0,0);DMA_K(1,SLOTB);
  float mhat=0.f,l_reg=0.f;f32x16 o[2];o[0]=f32x16{};o[1]=f32x16{};
  const int qrel=wid*QBLK+r32;
  #define CMASK(P0,P1,t) do{int jb_=(t)-(NT-4); if(jb_>=0&&mode!=1)cmask(P0,P1,jb_,qrel,hi);}while(0)
  bool resc=false;
  #define START(P0,P1) do{ const float rm=rowmax(P0,P1); resc=false; \
    { const float dl=rm; mhat=fadd_s(mhat,dl); \
      _Pragma("unroll") for(int r=0;r<16;++r){P0[r]=fsub_s(P0[r],dl);P1[r]=fsub_s(P1[r],dl);} } \
    _Pragma("unroll") for(int r=0;r<16;++r)P0[r]=__builtin_amdgcn_exp2f(P0[r]); }while(0)
  #define RESC() do{ if(resc){ asm volatile("s_waitcnt lgkmcnt(0)":::"memory"); \
      _Pragma("unroll") for(int d_=0;d_<2;++d_) _Pragma("unroll") for(int r=0;r<16;++r)o[d_][r]*=wsf[crow(r,hi)]; } }while(0)
  f32x16 pA0,pA1,pB0,pB1;
  int sl_prev=0,sl_cur=0,sl_next=SLOTB;
  #define ROT() do{sl_prev=sl_cur;sl_cur=sl_next;sl_next=(sl_next==(NSLOT-1)*SLOTB)?0:sl_next+SLOTB;}while(0)
  DMA_K(2,2*SLOTB);
  WAIT_BAR(3);
  BLD(pA0,pA1,0);
  qkt(pA0,pA1,Kbase,qr,r32,hi);asm volatile("s_nop 15\n\ts_nop 7":"+v"(pA0),"+v"(pA1));CMASK(pA0,pA1,0);
  START(pA0,pA1);
  _Pragma("unroll") for(int r=0;r<16;++r)pA1[r]=__builtin_amdgcn_exp2f(pA1[r]);
  BLD(pB0,pB1,1); BSUB(pB0,0); BSUB(pB0,8); BSUB(pB1,0); BSUB(pB1,8);
  WAIT_BAR(0);
  DMA_K(3,0);DMA_V(1,SLOTB);
  ROT();
  kload8(kf,kp0+sl_cur);
  WAIT_BAR(2);
  s16x4 vlo[8],vhi[8]; u32x4 pw0,pw1,pw2,pw3;
  #define PKW(P,B) cvtpk_s(P[B],P[B+1])
  #define PAF(k) __builtin_bit_cast(bf16x8,pw##k)
  #define VFR(i) (bf16x8){vlo[i][0],vlo[i][1],vlo[i][2],vlo[i][3],vhi[i][0],vhi[i][1],vhi[i][2],vhi[i][3]}
  #define PIN(x) asm volatile("":"+v"(x))
  #define MX3(a,b,c) __builtin_fmaxf(__builtin_fmaxf((a),(b)),(c))
  #define GAPA(MF,A0,A1,A2,A3,W0,W1,PW) do{ MF; sacc+=A0; sacc+=A1; sacc+=A2; sacc+=A3; PIN(sacc); W0; W1; PIN(PW); SBAR(); }while(0)
  #define EX(v) __builtin_amdgcn_exp2f(v)
  #define GAPB(MF,X,B) do{ MF; X[B]=EX(X[B]); X[B+1]=EX(X[B+1]); X[B+2]=EX(X[B+2]); X[B+3]=EX(X[B+3]); PIN(X); SBAR(); }while(0)
  #define VRD(i) do{ vlo[i]=vtr(vp_+(((i)>>2)*4096+((i)&3)*1024)); vhi[i]=vtr(vp_+(((i)>>2)*4096+((i)&3)*1024+512)); }while(0)
  #define KRD(G,j) do{ if(G){ kload2(kf,kp0+sl_next,j); SBAR(); } }while(0)
  #define STEP(C0,C1,P0,P1,t,GK,GV,GL) do{ SBAR(); \
    const lds_cptr vp_=vp0+sl_prev; \
    VRD(0); SBAR(); float sacc=(P0[0]+P0[1]); \
    GAPA(C0=__builtin_amdgcn_mfma_f32_32x32x16_bf16(kf[0],qr[0],C0,0,0,0), P0[2],P0[3],P0[4],P0[5],     pw0[0]=PKW(P0,0), pw0[1]=PKW(P0,2), pw0); \
    VRD(4); SBAR(); GAPA(C1=__builtin_amdgcn_mfma_f32_32x32x16_bf16(kf[1],qr[0],C1,0,0,0), P0[6],P0[7],P0[8],P0[9],     pw0[2]=PKW(P0,4), pw0[3]=PKW(P0,6), pw0); \
    VRD(1); SBAR(); GAPA(C0=__builtin_amdgcn_mfma_f32_32x32x16_bf16(kf[2],qr[1],C0,0,0,0),   P0[10],P0[11],P0[12],P0[13], pw1[0]=PKW(P0,8), pw1[1]=PKW(P0,10), pw1); \
    VRD(5); SBAR(); GAPA(C1=__builtin_amdgcn_mfma_f32_32x32x16_bf16(kf[3],qr[1],C1,0,0,0),   P0[14],P0[15],P1[0],P1[1],   pw1[2]=PKW(P0,12),pw1[3]=PKW(P0,14), pw1); \
    VRD(2); SBAR(); GAPA(C0=__builtin_amdgcn_mfma_f32_32x32x16_bf16(kf[4],qr[2],C0,0,0,0),   P1[2],P1[3],P1[4],P1[5],     pw2[0]=PKW(P1,0), pw2[1]=PKW(P1,2), pw2); \
    VRD(6); SBAR(); GAPA(C1=__builtin_amdgcn_mfma_f32_32x32x16_bf16(kf[5],qr[2],C1,0,0,0),   P1[6],P1[7],P1[8],P1[9],     pw2[2]=PKW(P1,4), pw2[3]=PKW(P1,6), pw2); \
    VRD(3); SBAR(); GAPA(C0=__builtin_amdgcn_mfma_f32_32x32x16_bf16(kf[6],qr[3],C0,0,0,0),   P1[10],P1[11],P1[12],P1[13], pw3[0]=PKW(P1,8), pw3[1]=PKW(P1,10), pw3); \
    VRD(7); SBAR(); GAPA(C1=__builtin_amdgcn_mfma_f32_32x32x16_bf16(kf[7],qr[3],C1,0,0,0),   P1[14],P1[15],0.f,0.f,       pw3[2]=PKW(P1,12),pw3[3]=PKW(P1,14), pw3); \
    l_reg+=sacc; \
    if(GK){DMA_K((t)+3,sl_cur);} if(GV){DMA_V((t)+1,sl_next);} \
    CMASK(C0,C1,t); \
    { float a=MX3(C0[0],C0[1],C1[0]),b=MX3(C0[2],C0[3],C1[1]); a=MX3(a,C1[2],C1[3]); \
      _Pragma("unroll") for(int r=4;r<16;r+=4){a=MX3(a,C0[r],C0[r+1]);b=MX3(b,C0[r+2],C0[r+3]);a=MX3(a,C1[r],C1[r+1]);b=MX3(b,C1[r+2],C1[r+3]);} \
      float rm=__builtin_fmaxf(a,b); { auto rr=__builtin_amdgcn_permlane32_swap(__float_as_uint(rm),__float_as_uint(rm),false,false); rm=__builtin_fmaxf(__uint_as_float(rr[0]),__uint_as_float(rr[1])); } \
      resc=false; \
      if(__builtin_expect(__any(rm>(float)THRL),0)){ const float dl=__builtin_fmaxf(rm,0.f); mhat+=dl; \
        _Pragma("unroll") for(int r=0;r<16;++r){C0[r]-=dl;C1[r]-=dl;} \
        const float f=__builtin_amdgcn_exp2f(-dl); l_reg*=f; if(hi==0)wsf[r32]=f; resc=true; } } \
    SBAR(); \
    if(GL){ BLD(P0,P1,(t)+1); SBAR(); } \
    GAPB(o[0]=__builtin_amdgcn_mfma_f32_32x32x16_bf16(PAF(0),VFR(0),o[0],0,0,0), C0,0); \
    GAPB(o[1]=__builtin_amdgcn_mfma_f32_32x32x16_bf16(PAF(0),VFR(4),o[1],0,0,0), C0,4); \
    KRD(GL,0); GAPB(o[0]=__builtin_amdgcn_mfma_f32_32x32x16_bf16(PAF(1),VFR(1),o[0],0,0,0), C0,8); \
    KRD(GL,1); GAPB(o[1]=__builtin_amdgcn_mfma_f32_32x32x16_bf16(PAF(1),VFR(5),o[1],0,0,0), C0,12); \
    KRD(GL,2); if(GL){BSUB(P0,0);} GAPB(o[0]=__builtin_amdgcn_mfma_f32_32x32x16_bf16(PAF(2),VFR(2),o[0],0,0,0), C1,0); \
    KRD(GL,3); if(GL){BSUB(P0,8);} GAPB(o[1]=__builtin_amdgcn_mfma_f32_32x32x16_bf16(PAF(2),VFR(6),o[1],0,0,0), C1,4); \
    if(GL){BSUB(P1,0);} GAPB(o[0]=__builtin_amdgcn_mfma_f32_32x32x16_bf16(PAF(3),VFR(3),o[0],0,0,0), C1,8); \
    if(GL){BSUB(P1,8);} GAPB(o[1]=__builtin_amdgcn_mfma_f32_32x32x16_bf16(PAF(3),VFR(7),o[1],0,0,0), C1,12); \
    }while(0)
  int t=1;
  #undef CMASK
  #define CMASK(P0,P1,t) do{}while(0)
  for(;t+5<NT;t+=2){
    STEP(pB0,pB1,pA0,pA1,t,true,true,true);     WAIT_BAR(2); RESC(); ROT();
    STEP(pA0,pA1,pB0,pB1,t+1,true,true,true);   WAIT_BAR(2); RESC(); ROT();
  }
  #undef CMASK
  #define CMASK(P0,P1,t) do{int jb_=(t)-(NT-4); if(jb_>=0&&mode!=1)cmask(P0,P1,jb_,qrel,hi);}while(0)
  #define ENDW(tt) do{ if((tt)+3<NT){WAIT_BAR(2);} else if((tt)+2<NT){WAIT_BAR(1);} else {WAIT_BAR(0);} }while(0)
  for(;t+1<NT;t+=2){
    STEP(pB0,pB1,pA0,pA1,t,(t+3<NT),(t+1<NT),(t+1<NT));       ENDW(t);   RESC(); ROT();
    STEP(pA0,pA1,pB0,pB1,t+1,(t+4<NT),(t+2<NT),(t+2<NT));     ENDW(t+1); RESC(); ROT();
  }
  STEP(pB0,pB1,pA0,pA1,NT-1,false,false,false); RESC();
  { float sacc=pB0[0]+pB0[1]; _Pragma("unroll") for(int r=2;r<16;++r)sacc+=pB0[r]; _Pragma("unroll") for(int r=0;r<16;++r)sacc+=pB1[r]; l_reg+=sacc;
    pw0=(u32x4){PKW(pB0,0),PKW(pB0,2),PKW(pB0,4),PKW(pB0,6)};pw1=(u32x4){PKW(pB0,8),PKW(pB0,10),PKW(pB0,12),PKW(pB0,14)};pw2=(u32x4){PKW(pB1,0),PKW(pB1,2),PKW(pB1,4),PKW(pB1,6)};pw3=(u32x4){PKW(pB1,8),PKW(pB1,10),PKW(pB1,12),PKW(pB1,14)};
    SBAR(); pv(o,vb0+sl_cur,PAF(0),PAF(1),PAF(2),PAF(3)); }
  #undef PKW
  #undef PAF
  #undef VFR
  #undef PIN
  #undef MX3
  #undef GAPA
  #undef GAPB
  #undef EX
  #undef VRD
  #undef KRD
  #undef STEP
  #undef ENDW
  {auto rr=__builtin_amdgcn_permlane32_swap(__float_as_uint(l_reg),__float_as_uint(l_reg),false,false);l_reg=__uint_as_float(rr[0])+__uint_as_float(rr[1]);}
  if(mode==0){
  if(hi==0)wsf[32+r32]=l_reg;asm volatile("s_waitcnt lgkmcnt(0)":::"memory");
  float rli[16];
  #pragma unroll
  for(int r=0;r<16;++r)rli[r]=__builtin_amdgcn_rcpf(wsf[32+crow(r,hi)]);
  bf16*Ow=O+(rowbase+q0+wid*QBLK)*DM+h*D;
  { bf16*stg=(bf16*)(shm+LDS_OST)+wid*2048;
    #pragma unroll
    for(int r=0;r<16;++r){const int orow=crow(r,hi);
      #pragma unroll
      for(int d0=0;d0<2;++d0)stg[orow*64+d0*32+r32]=__float2bfloat16(o[d0][r]*rli[r]);}
    asm volatile("s_waitcnt lgkmcnt(0)":::"memory");
    #pragma unroll
    for(int i=0;i<4;++i){const int row=i*8+(lane>>3),ch=lane&7; const u32x4 v=*(const u32x4*)(stg+row*64+ch*8); ATTN_STORE16(Ow+(long)row*DM+ch*8,v);
      float ss=0.f;
      #pragma unroll
      for(int e=0;e<4;++e){const float lo_=__uint_as_float(v[e]<<16),hi_=__uint_as_float(v[e]&0xffff0000u);ss+=lo_*lo_+hi_*hi_;}
      ss+=sx<1>(ss);ss+=sx<2>(ss);ss+=sx<4>(ss);
      if(ch==0)ssqA[(rowbase+q0+wid*QBLK+row)*NHEAD+h]=ss;} }
  } else {
    float*PO=part+(long)(mode-1)*QB*D+(long)(wid*QBLK)*D;
    #pragma unroll
    for(int r=0;r<16;++r){const int orow=crow(r,hi);
      #pragma unroll
      for(int d0=0;d0<2;++d0)__hip_atomic_store(PO+orow*D+d0*32+r32,o[d0][r],__ATOMIC_RELAXED,__HIP_MEMORY_SCOPE_AGENT);}
    if(hi==0){ float*PM=part+2*QB*D+(mode-1)*QB+wid*QBLK; __hip_atomic_store(PM+r32,mhat,__ATOMIC_RELAXED,__HIP_MEMORY_SCOPE_AGENT); __hip_atomic_store(PM+2*QB+r32,l_reg,__ATOMIC_RELAXED,__HIP_MEMORY_SCOPE_AGENT); }
  }
  asm volatile("s_waitcnt lgkmcnt(0)\n\ts_barrier":::"memory");
  } else if(tid<QB){ float*PM=part+2*QB*D; __hip_atomic_store(PM+tid,-1e30f,__ATOMIC_RELAXED,__HIP_MEMORY_SCOPE_AGENT); __hip_atomic_store(PM+2*QB+tid,0.f,__ATOMIC_RELAXED,__HIP_MEMORY_SCOPE_AGENT); }
  if(mode!=0){
    asm volatile("s_waitcnt vmcnt(0)":::"memory"); __syncthreads();
    if(tid==0){
      const unsigned old=__hip_atomic_fetch_add(pcnt,1u,__ATOMIC_RELAXED,__HIP_MEMORY_SCOPE_AGENT);
      if(old==1u){ __builtin_amdgcn_fence(__ATOMIC_ACQUIRE,"agent"); asm volatile("s_waitcnt vmcnt(0)":::"memory"); }
      wtot[0]=(old==1u)?1.f:0.f; }
    __syncthreads();
    const bool merger=wtot[0]!=0.f;
    __syncthreads();
    if(merger){ const int row=tid>>1,ch=tid&1; const float*PA=part+(long)row*D+ch*32,*PB=PA+(long)QB*D; const float*PM=part+2*QB*D;
      const float MA=PM[row],MB=PM[QB+row],LA=PM[2*QB+row],LB=PM[3*QB+row]; const float m=__builtin_fmaxf(MA,MB);
      const bool ua=LA>0.f,ub=LB>0.f; const float wA=ua?__builtin_amdgcn_exp2f(MA-m):0.f,wB=ub?__builtin_amdgcn_exp2f(MB-m):0.f; const float inv=__builtin_amdgcn_rcpf(LA*wA+LB*wB); const float cA=wA*inv,cB=wB*inv;
      bf16*Om=O+(rowbase+q0+row)*DM+h*D+ch*32; float ss=0.f;
      #pragma unroll
      for(int i=0;i<4;++i){ const f32x4v z4={0.f,0.f,0.f,0.f}; const f32x4v a0=ua?*(const f32x4v*)(PA+8*i):z4,a1=ua?*(const f32x4v*)(PA+8*i+4):z4,b0=ub?*(const f32x4v*)(PB+8*i):z4,b1=ub?*(const f32x4v*)(PB+8*i+4):z4;
        u32x4 w; w[0]=cvtpk_s(a0[0]*cA+b0[0]*cB,a0[1]*cA+b0[1]*cB); w[1]=cvtpk_s(a0[2]*cA+b0[2]*cB,a0[3]*cA+b0[3]*cB); w[2]=cvtpk_s(a1[0]*cA+b1[0]*cB,a1[1]*cA+b1[1]*cB); w[3]=cvtpk_s(a1[2]*cA+b1[2]*cB,a1[3]*cA+b1[3]*cB);
        ATTN_STORE16(Om+8*i,w);
        #pragma unroll
        for(int e=0;e<4;++e){const float lo_=__uint_as_float(w[e]<<16),hi_=__uint_as_float(w[e]&0xffff0000u);ss+=lo_*lo_+hi_*hi_;} }
      ss+=sx<1>(ss);
      if(ch==0)ssqA[(rowbase+q0+row)*NHEAD+h]=ss; }
  }
  #undef DMA_K
  #undef DMA_V
  #undef BLD
  #undef BSUB
  #undef CMASK
  #undef START
  #undef RESC
  #undef ROT
}
constexpr int ATTN_LDS_BYTES=LDS_BYTES;
#undef SBAR
#undef WAIT_BAR
}
#define LAS __attribute__((address_space(3)))
#define GAS __attribute__((address_space(1)))
using pg8::f32x4; using pg8::u32x4; using pg8::bf16_t; using pg8::bf16x8; using pg8::Unit; using pg8::BM; using pg8::HALF;
typedef unsigned u32x2 __attribute__((ext_vector_type(2)));
constexpr int TOK = 16384, DMODEL = 1024, DFF = 2816, HW = 512, SEQL = 8192, PLE = 256, NGRP = 32;
constexpr float L2E = 1.4426950408889634f;
constexpr float QSCALE = 0.125f * L2E;
constexpr size_t MiB = 1u << 20;
constexpr size_t WS_CTL = 0, WS_AP = 1 * MiB, WS_BB = WS_AP + 512 * 1024, WS_KTAB = 2 * MiB, WS_PEND = 3 * MiB, WS_CC = 5 * MiB, WS_WF = 7 * MiB, WS_LOGF = 8 * MiB;
constexpr size_t WS_SSQ0 = 9 * MiB, WS_SSQ1 = 10 * MiB, WS_SSQ2 = 11 * MiB, WS_SSQ3 = 12 * MiB, WS_SSQ4 = 13 * MiB, WS_SSQA = 14 * MiB, WS_SSQS = 14 * MiB + 512 * 1024;
constexpr size_t WS_W13A = 16 * MiB, WS_W2A = 27 * MiB, WS_WIN = 33 * MiB, WS_WGLU = 37 * MiB, WS_WOA = 38 * MiB, WS_WOS = 39 * MiB, WS_W13B = 40 * MiB, WS_W2B = 51 * MiB, WS_WG = 57 * MiB, WS_WP = 59 * MiB;
constexpr size_t PARTF = 2 * 256 * 64 + 4 * 256;
static_assert(60 * PARTF * 4 <= 8 * MiB && 45 * PARTF * 4 <= 6 * MiB && 151 * PARTF * 4 <= 20 * MiB, "partial record chunks");
constexpr size_t WS_PART_UNUSED = 188 * MiB;
constexpr size_t WS_PB = 60 * MiB, WS_XB = 68 * MiB, WS_H1 = 100 * MiB;
constexpr size_t WS_Q = 100 * MiB, WS_K = 116 * MiB, WS_V = 132 * MiB, WS_U = 148 * MiB, WS_Y = 164 * MiB, WS_SSMO = 188 * MiB, WS_PP = 204 * MiB, WS_END = 256 * MiB;
static_assert(WS_K == WS_Q + 16 * MiB && WS_V == WS_Q + 32 * MiB, "EpiQKVU pointer arithmetic");
constexpr int RING_BYTES = 131072, LDS_BYTES = 147456, MISC_OFF = LDS_BYTES - 256;

__device__ __forceinline__ float sigm(float w) { return __builtin_amdgcn_rcpf(1.f + __builtin_amdgcn_exp2f(-L2E * w)); }
__device__ __forceinline__ unsigned pkbf(float lo, float hi) { return pg8::cvt_pk_bf16(lo, hi); }
__device__ __forceinline__ float bflo(unsigned w) { return __uint_as_float(w << 16); }
__device__ __forceinline__ float bfhi(unsigned w) { return __uint_as_float(w & 0xffff0000u); }
template <int NP> __device__ __forceinline__ float rstd_row(const float* ssq, int row, float invn) {
    const f32x4* p = (const f32x4*)(ssq + (size_t)row * NP); float s = 0.f;
#pragma unroll
    for (int i = 0; i < NP / 4; ++i) { const f32x4 v = p[i]; s += (v[0] + v[1]) + (v[2] + v[3]); }
    return __builtin_amdgcn_rsqf(s * invn + 1e-6f);
}
template <int NP> __device__ __forceinline__ void rstd8(const float* ssq, int pm, int wr, int fr, int fq, float invn, float (&rs)[2][4]) {
    int lrow = pm * BM + wr * 64 + fq * 16 + fr; asm volatile("" : "+v"(lrow));
    const float r0 = rstd_row<NP>(ssq, lrow, invn), r1 = rstd_row<NP>(ssq, lrow + HALF, invn);
#pragma unroll
    for (int m = 0; m < 4; ++m) { rs[0][m] = __builtin_bit_cast(float, __builtin_amdgcn_ds_bpermute((16 * m + fr) << 2, __builtin_bit_cast(int, r0))); rs[1][m] = __builtin_bit_cast(float, __builtin_amdgcn_ds_bpermute((16 * m + fr) << 2, __builtin_bit_cast(int, r1))); }
}
__device__ __forceinline__ float wave_sum(float v) {
    v += sx<1>(v); v += sx<2>(v); v += sx<4>(v); v += sx<8>(v); v += sx<16>(v); v = sum32(v);
    return v;
}

struct EpiSwiglu {
    static constexpr bool PERM = true, AFTER_DRAIN = false, MIDK = false;
    bf16_t* O; const float* ssq;
    __device__ __forceinline__ void operator()(const f32x4 (&acc)[2][2][4][2], const Unit& u, int wr, int wc, int fr, int fq) const {
        int row0 = u.pm * BM + wr * 64 + fr, col0 = u.pn * 128 + wc * 32 + 8 * fq; asm volatile("" : "+v"(row0));
        float rs8[2][4]; rstd8<16>(ssq, u.pm, wr, fr, fq, 1.f / 1024.f, rs8);
#pragma unroll
        for (int ai = 0; ai < 2; ++ai)
#pragma unroll
            for (int m = 0; m < 4; ++m) { asm volatile("" ::: "memory"); const int row = row0 + ai * HALF + m * 16; const float rs = rs8[ai][m];
                const f32x4 a0 = acc[ai][0][m][0] * rs, a1 = acc[ai][0][m][1] * rs, b0 = acc[ai][1][m][0] * rs, b1 = acc[ai][1][m][1] * rs; f32x4 h0, h1;
#pragma unroll
                for (int e = 0; e < 4; ++e) { h0[e] = a0[e] * sigm(a0[e]) * b0[e]; h1[e] = a1[e] * sigm(a1[e]) * b1[e]; }
                u32x4 w; w.x = pkbf(h0[0], h0[1]); w.y = pkbf(h0[2], h0[3]); w.z = pkbf(h1[0], h1[1]); w.w = pkbf(h1[2], h1[3]);
                *(u32x4*)(O + (size_t)row * DFF + col0) = w; }
    }
};
template <bool NORM, bool BASEB> struct EpiRes {
    static constexpr bool PERM = true, AFTER_DRAIN = false, MIDK = false;
    const float* basef; bf16_t* xb; float* ssqo; const float* ssqi; float coef;
    __device__ __forceinline__ void operator()(const f32x4 (&acc)[2][2][4][2], const Unit& u, int wr, int wc, int fr, int fq) const {
        int row0 = u.pm * BM + wr * 64 + fr, col0 = u.pn * BM + wc * 32 + 8 * fq; asm volatile("" : "+v"(row0));
        float rs8[2][4]; if (NORM) rstd8<8>(ssqi, u.pm, wr, fr, fq, 1.f / 512.f, rs8);
#pragma unroll
        for (int ai = 0; ai < 2; ++ai) { asm volatile("" ::: "memory");
            f32x4 xv[4][2][2];
#pragma unroll
            for (int m = 0; m < 4; ++m)
#pragma unroll
                for (int bj = 0; bj < 2; ++bj) { const size_t off = (size_t)(row0 + ai * HALF + m * 16) * DMODEL + col0 + bj * HALF;
                    if (BASEB) { const u32x4 bv = *(const u32x4*)(xb + off); xv[m][bj][0] = (f32x4){bflo(bv.x), bfhi(bv.x), bflo(bv.y), bfhi(bv.y)}; xv[m][bj][1] = (f32x4){bflo(bv.z), bfhi(bv.z), bflo(bv.w), bfhi(bv.w)}; }
                    else { xv[m][bj][0] = __builtin_nontemporal_load((const f32x4*)(basef + off)); xv[m][bj][1] = __builtin_nontemporal_load((const f32x4*)(basef + off + 4)); } }
#pragma unroll
            for (int m = 0; m < 4; ++m) { const int row = row0 + ai * HALF + m * 16; float alpha = coef; if (NORM) alpha *= rs8[ai][m]; float ss = 0.f;
#pragma unroll
                for (int bj = 0; bj < 2; ++bj) { const size_t off = (size_t)row * DMODEL + col0 + bj * HALF;
                    const f32x4 v0 = xv[m][bj][0] + acc[ai][bj][m][0] * alpha, v1 = xv[m][bj][1] + acc[ai][bj][m][1] * alpha;
                    u32x4 w; w.x = pkbf(v0[0], v0[1]); w.y = pkbf(v0[2], v0[3]); w.z = pkbf(v1[0], v1[1]); w.w = pkbf(v1[2], v1[3]); *(u32x4*)(xb + off) = w;
                    ss += (v0[0] * v0[0] + v0[1] * v0[1]) + (v0[2] * v0[2] + v0[3] * v0[3]) + (v1[0] * v1[0] + v1[1] * v1[1]) + (v1[2] * v1[2] + v1[3] * v1[3]); }
                ss += sx<16>(ss); ss = sum32(ss); if (fq == 0) ssqo[(size_t)row * 16 + u.pn * 4 + wc] = ss; } }
    }
};
struct EpiOut {
    static constexpr bool PERM = true, AFTER_DRAIN = false, MIDK = true;
    bf16_t* xb; float* ssqo; const float* ssqA; const float* ssqS;
    __device__ __forceinline__ void mid(f32x4 (&acc)[2][2][4][2], const Unit& u, int wr, int wc, int fr, int fq) const {
        float ra8[2][4], rb8[2][4]; rstd8<8>(ssqA, u.pm, wr, fr, fq, 1.f / 512.f, ra8); rstd8<8>(ssqS, u.pm, wr, fr, fq, 1.f / 512.f, rb8);
#pragma unroll
        for (int ai = 0; ai < 2; ++ai)
#pragma unroll
            for (int m = 0; m < 4; ++m) { const float ratio = ra8[ai][m] * __builtin_amdgcn_rcpf(rb8[ai][m]);
#pragma unroll
                for (int bj = 0; bj < 2; ++bj) { acc[ai][bj][m][0] *= ratio; acc[ai][bj][m][1] *= ratio; } }
    }
    __device__ __forceinline__ void operator()(const f32x4 (&acc)[2][2][4][2], const Unit& u, int wr, int wc, int fr, int fq) const {
        EpiRes<true, true> E{nullptr, xb, ssqo, ssqS, 1.f}; E(acc, u, wr, wc, fr, fq);
    }
};
struct StrideOrder {
    int first, stride, total, nN;
    __device__ __forceinline__ bool next(int i, Unit& u) const { const int id = first + i * stride; if (id >= total) return false; u.pm = id / nN; u.pn = id % nN; return true; }
    __device__ __forceinline__ void a_ready(const Unit&) const {}
    __device__ __forceinline__ void done(const Unit&) const {}
};
struct EpiQKVU {
    static constexpr bool PERM = true, AFTER_DRAIN = false, MIDK = false;
    bf16_t *Q, *U; const float* ssq; unsigned* kmax;
    __device__ __forceinline__ void operator()(const f32x4 (&acc)[2][2][4][2], const Unit& u, int wr, int wc, int fr, int fq) const {
        int row0 = u.pm * BM + wr * 64 + fr, part = u.pn >> 1, c0 = (u.pn & 1) * 256 + wc * 32 + 8 * fq; asm volatile("" : "+v"(row0));
        bf16_t* dstb = Q + (size_t)part * (size_t)(8 * MiB); const float sc = part == 0 ? QSCALE : 1.f;
        float rs8[2][4]; rstd8<16>(ssq, u.pm, wr, fr, fq, 1.f / 1024.f, rs8); float mxb[2] = {0.f, 0.f};
#pragma unroll
        for (int ai = 0; ai < 2; ++ai)
#pragma unroll
            for (int m = 0; m < 4; ++m) { asm volatile("" ::: "memory"); const int row = row0 + ai * HALF + m * 16; const float rs = rs8[ai][m] * sc;
#pragma unroll
                for (int bj = 0; bj < 2; ++bj) { const int c = c0 + bj * HALF; const f32x4 v0 = acc[ai][bj][m][0] * rs, v1 = acc[ai][bj][m][1] * rs;
                    if (part == 1) { float p2 = ((v0[0] * v0[0] + v0[1] * v0[1]) + (v0[2] * v0[2] + v0[3] * v0[3])) + ((v1[0] * v1[0] + v1[1] * v1[1]) + (v1[2] * v1[2] + v1[3] * v1[3])); p2 += sx<16>(p2); p2 = sum32(p2); mxb[bj] = __builtin_fmaxf(mxb[bj], p2); }
                    u32x4 w; w.x = pkbf(v0[0], v0[1]); w.y = pkbf(v0[2], v0[3]); w.z = pkbf(v1[0], v1[1]); w.w = pkbf(v1[2], v1[3]);
                    if (part < 3) *(u32x4*)(dstb + (size_t)row * HW + c) = w;
                    else { const int g = c >> 4, half = (c >> 3) & 1, b = row >> 13, t = row & 8191; *(u32x4*)(U + ((size_t)((b * NGRP + g) * SEQL + t)) * 16 + half * 8) = w; } } }
        if (part == 1) {
#pragma unroll
            for (int bj = 0; bj < 2; ++bj) { float mx = mxb[bj];
                mx = __builtin_fmaxf(mx, sx<1>(mx)); mx = __builtin_fmaxf(mx, sx<2>(mx)); mx = __builtin_fmaxf(mx, sx<4>(mx)); mx = __builtin_fmaxf(mx, sx<8>(mx));
                if (fr == 0 && fq == 0) __hip_atomic_fetch_max(kmax + (((u.pm >> 5) * 8 + (u.pn & 1) * 4 + bj * 2 + (wc >> 1)) << 1) + (wc & 1), __float_as_uint(mx), __ATOMIC_RELAXED, __HIP_MEMORY_SCOPE_AGENT); } }
    }
};
struct EpiGlu {
    static constexpr bool PERM = true, AFTER_DRAIN = false, MIDK = false;
    const bf16_t* Y; const float* bglu; bf16_t* O; float* ssqo;
    __device__ __forceinline__ void operator()(const f32x4 (&acc)[2][2][4][2], const Unit& u, int wr, int wc, int fr, int fq) const {
        int row0 = u.pm * BM + wr * 64 + fr, c0 = u.pn * BM + wc * 32 + 8 * fq; asm volatile("" : "+v"(row0));
#pragma unroll
        for (int ai = 0; ai < 2; ++ai)
#pragma unroll
            for (int m = 0; m < 4; ++m) { asm volatile("" ::: "memory"); const int row = row0 + ai * HALF + m * 16; float ss = 0.f;
#pragma unroll
                for (int bj = 0; bj < 2; ++bj) { const int c = c0 + bj * HALF; const u32x4 yv = *(const u32x4*)(Y + (size_t)row * HW + c);
                    const f32x4 b0 = *(const f32x4*)(bglu + c), b1 = *(const f32x4*)(bglu + c + 4); const f32x4 a0 = acc[ai][bj][m][0] + b0, a1 = acc[ai][bj][m][1] + b1;
                    float o[8]; o[0] = bflo(yv.x) * sigm(a0[0]); o[1] = bfhi(yv.x) * sigm(a0[1]); o[2] = bflo(yv.y) * sigm(a0[2]); o[3] = bfhi(yv.y) * sigm(a0[3]);
                    o[4] = bflo(yv.z) * sigm(a1[0]); o[5] = bfhi(yv.z) * sigm(a1[1]); o[6] = bflo(yv.w) * sigm(a1[2]); o[7] = bfhi(yv.w) * sigm(a1[3]);
                    u32x4 w; w.x = pkbf(o[0], o[1]); w.y = pkbf(o[2], o[3]); w.z = pkbf(o[4], o[5]); w.w = pkbf(o[6], o[7]); *(u32x4*)(O + (size_t)row * HW + c) = w;
#pragma unroll
                    for (int e = 0; e < 8; ++e) ss += o[e] * o[e]; }
                ss += sx<16>(ss); ss = sum32(ss); if (fq == 0) ssqo[(size_t)row * 8 + u.pn * 4 + wc] = ss; }
    }
};
struct EpiBf16P {
    static constexpr bool PERM = true, AFTER_DRAIN = false, MIDK = false;
    bf16_t* O;
    __device__ __forceinline__ void operator()(const f32x4 (&acc)[2][2][4][2], const Unit& u, int wr, int wc, int fr, int fq) const {
        int row0 = u.pm * BM + wr * 64 + fr, c0 = u.pn * BM + wc * 32 + 8 * fq; asm volatile("" : "+v"(row0));
#pragma unroll
        for (int ai = 0; ai < 2; ++ai)
#pragma unroll
            for (int m = 0; m < 4; ++m) { asm volatile("" ::: "memory"); const int row = row0 + ai * HALF + m * 16;
#pragma unroll
                for (int bj = 0; bj < 2; ++bj) { const f32x4 v0 = acc[ai][bj][m][0], v1 = acc[ai][bj][m][1];
                    u32x4 w; w.x = pkbf(v0[0], v0[1]); w.y = pkbf(v0[2], v0[3]); w.z = pkbf(v1[0], v1[1]); w.w = pkbf(v1[2], v1[3]); *(u32x4*)(O + (size_t)row * DMODEL + c0 + bj * HALF) = w; } }
    }
};
struct EpiGate {
    static constexpr bool PERM = true, AFTER_DRAIN = false, MIDK = false;
    const bf16_t* base; float* out; const bf16_t* pp; const float* ssqi; float* ssqo;
    __device__ __forceinline__ void operator()(const f32x4 (&acc)[2][2][4][2], const Unit& u, int wr, int wc, int fr, int fq) const {
        int row0 = u.pm * BM + wr * 64 + fr, c0 = u.pn * BM + wc * 32 + 8 * fq; asm volatile("" : "+v"(row0));
        float rs8[2][4]; rstd8<16>(ssqi, u.pm, wr, fr, fq, 1.f / 1024.f, rs8);
#pragma unroll
        for (int ai = 0; ai < 2; ++ai)
#pragma unroll
            for (int m = 0; m < 4; ++m) { asm volatile("" ::: "memory"); const int row = row0 + ai * HALF + m * 16; const float rs = rs8[ai][m]; float ss = 0.f;
#pragma unroll
                for (int bj = 0; bj < 2; ++bj) { const size_t off = (size_t)row * DMODEL + c0 + bj * HALF; const u32x4 pv = *(const u32x4*)(pp + off);
                    const u32x4 bv = *(const u32x4*)(base + off); const f32x4 x0 = (f32x4){bflo(bv.x), bfhi(bv.x), bflo(bv.y), bfhi(bv.y)}, x1 = (f32x4){bflo(bv.z), bfhi(bv.z), bflo(bv.w), bfhi(bv.w)}; const f32x4 a0 = acc[ai][bj][m][0] * rs, a1 = acc[ai][bj][m][1] * rs; f32x4 v0, v1;
                    v0[0] = x0[0] + sigm(a0[0]) * bflo(pv.x); v0[1] = x0[1] + sigm(a0[1]) * bfhi(pv.x); v0[2] = x0[2] + sigm(a0[2]) * bflo(pv.y); v0[3] = x0[3] + sigm(a0[3]) * bfhi(pv.y);
                    v1[0] = x1[0] + sigm(a1[0]) * bflo(pv.z); v1[1] = x1[1] + sigm(a1[1]) * bfhi(pv.z); v1[2] = x1[2] + sigm(a1[2]) * bflo(pv.w); v1[3] = x1[3] + sigm(a1[3]) * bfhi(pv.w);
                    *(f32x4*)(out + off) = v0; *(f32x4*)(out + off + 4) = v1;
                    ss += (v0[0] * v0[0] + v0[1] * v0[1]) + (v0[2] * v0[2] + v0[3] * v0[3]) + (v1[0] * v1[0] + v1[1] * v1[1]) + (v1[2] * v1[2] + v1[3] * v1[3]); }
                ss += sx<16>(ss); ss = sum32(ss); if (fq == 0) ssqo[(size_t)row * 16 + u.pn * 4 + wc] = ss; }
    }
};

struct EpiGateFinal {
    static constexpr bool PERM = true, AFTER_DRAIN = false, MIDK = false;
    const bf16_t* base; float* out; const bf16_t* pp; const float* ssqi; float* ssqo; unsigned* cnt; const float* gfin;
    __device__ __forceinline__ void operator()(const f32x4 (&acc)[2][2][4][2], const Unit& u, int wr, int wc, int fr, int fq) const {
        int row0 = u.pm * BM + wr * 64 + fr, c0 = u.pn * BM + wc * 32 + 8 * fq; asm volatile("" : "+v"(row0));
        float rs8[2][4]; rstd8<16>(ssqi, u.pm, wr, fr, fq, 1.f / 1024.f, rs8);
        f32x4 v[2][4][2][2];
#pragma unroll
        for (int am = 0; am < 4; ++am) { asm volatile("" ::: "memory"); const int ai = am >> 1;
            u32x4 pvv[2][2], bvv[2][2];
#pragma unroll
            for (int mm = 0; mm < 2; ++mm)
#pragma unroll
                for (int bj = 0; bj < 2; ++bj) { const size_t off = (size_t)(row0 + ai * HALF + ((am & 1) * 2 + mm) * 16) * DMODEL + c0 + bj * HALF; pvv[mm][bj] = *(const u32x4*)(pp + off); bvv[mm][bj] = *(const u32x4*)(base + off); }
#pragma unroll
            for (int mm = 0; mm < 2; ++mm) { const int m = (am & 1) * 2 + mm; const int row = row0 + ai * HALF + m * 16; const float rs = rs8[ai][m]; float ss = 0.f;
#pragma unroll
                for (int bj = 0; bj < 2; ++bj) { const u32x4 pv = pvv[mm][bj];
                    const u32x4 bv = bvv[mm][bj]; const f32x4 x0 = (f32x4){bflo(bv.x), bfhi(bv.x), bflo(bv.y), bfhi(bv.y)}, x1 = (f32x4){bflo(bv.z), bfhi(bv.z), bflo(bv.w), bfhi(bv.w)}; const f32x4 a0 = acc[ai][bj][m][0] * rs, a1 = acc[ai][bj][m][1] * rs; f32x4 v0, v1;
                    v0[0] = x0[0] + sigm(a0[0]) * bflo(pv.x); v0[1] = x0[1] + sigm(a0[1]) * bfhi(pv.x); v0[2] = x0[2] + sigm(a0[2]) * bflo(pv.y); v0[3] = x0[3] + sigm(a0[3]) * bfhi(pv.y);
                    v1[0] = x1[0] + sigm(a1[0]) * bflo(pv.z); v1[1] = x1[1] + sigm(a1[1]) * bfhi(pv.z); v1[2] = x1[2] + sigm(a1[2]) * bflo(pv.w); v1[3] = x1[3] + sigm(a1[3]) * bfhi(pv.w);
                    v[ai][m][bj][0] = v0; v[ai][m][bj][1] = v1;
                    ss += (v0[0] * v0[0] + v0[1] * v0[1]) + (v0[2] * v0[2] + v0[3] * v0[3]) + (v1[0] * v1[0] + v1[1] * v1[1]) + (v1[2] * v1[2] + v1[3] * v1[3]); }
                ss += sx<16>(ss); ss = sum32(ss);
                if (fq == 0) __hip_atomic_store(ssqo + (size_t)row * 16 + u.pn * 4 + wc, ss, __ATOMIC_RELAXED, __HIP_MEMORY_SCOPE_AGENT); } }
        asm volatile("s_waitcnt vmcnt(0)" ::: "memory");
        unsigned* c = cnt + 64 * u.pm;
        if (fr == 0 && fq == 0) __hip_atomic_fetch_add(c, 1u, __ATOMIC_RELAXED, __HIP_MEMORY_SCOPE_AGENT);
        for (unsigned sp = 0; sp < (1u << 22); ++sp) {
            if ((unsigned)__builtin_amdgcn_readfirstlane(__hip_atomic_load(c, __ATOMIC_RELAXED, __HIP_MEMORY_SCOPE_AGENT)) >= 32u) break;
            __builtin_amdgcn_s_sleep(2); }
        __builtin_amdgcn_fence(__ATOMIC_ACQUIRE, "agent");
#pragma unroll
        for (int ai = 0; ai < 2; ++ai)
#pragma unroll
            for (int m = 0; m < 4; ++m) { asm volatile("" ::: "memory"); const int row = row0 + ai * HALF + m * 16; const float* ps = ssqo + (size_t)row * 16 + 4 * fq;
                float s4 = (__hip_atomic_load(ps, __ATOMIC_RELAXED, __HIP_MEMORY_SCOPE_AGENT) + __hip_atomic_load(ps + 1, __ATOMIC_RELAXED, __HIP_MEMORY_SCOPE_AGENT))
                         + (__hip_atomic_load(ps + 2, __ATOMIC_RELAXED, __HIP_MEMORY_SCOPE_AGENT) + __hip_atomic_load(ps + 3, __ATOMIC_RELAXED, __HIP_MEMORY_SCOPE_AGENT));
                s4 += sx<16>(s4); s4 = sum32(s4);
                const float rstd = __builtin_amdgcn_rsqf(s4 * (1.f / 1024.f) + 1e-6f);
#pragma unroll
                for (int bj = 0; bj < 2; ++bj) { const size_t off = (size_t)row * DMODEL + c0 + bj * HALF; const f32x4 g0 = *(const f32x4*)(gfin + c0 + bj * HALF), g1 = *(const f32x4*)(gfin + c0 + bj * HALF + 4);
                    __builtin_nontemporal_store(v[ai][m][bj][0] * rstd * g0, (f32x4*)(out + off)); __builtin_nontemporal_store(v[ai][m][bj][1] * rstd * g1, (f32x4*)(out + off + 4)); } }
    }
};

__device__ __forceinline__ void tr_item(const float* src, int srcN, int k0, int c0, const float* gain, bf16_t* dst, int dstPitch, int dstRow0, LAS float* scr, int lane) {
    float tv[32];
#pragma unroll
    for (int i = 0; i < 32; ++i) { const int kk = 2 * i + (lane >> 5); tv[i] = __builtin_nontemporal_load(src + (size_t)(k0 + kk) * srcN + c0 + (lane & 31)); }
    if (gain) {
#pragma unroll
        for (int i = 0; i < 32; ++i) tv[i] *= gain[k0 + 2 * i + (lane >> 5)]; }
#pragma unroll
    for (int i = 0; i < 32; ++i) scr[(2 * i + (lane >> 5)) * 33 + (lane & 31)] = tv[i];
    asm volatile("s_waitcnt lgkmcnt(0)" ::: "memory");
    const int c = lane & 7;
#pragma unroll
    for (int j = 0; j < 4; ++j) { const int n = (lane >> 3) + 8 * j; const LAS float* s = scr + (8 * c) * 33 + n;
        u32x4 o; o.x = pkbf(s[0 * 33], s[1 * 33]); o.y = pkbf(s[2 * 33], s[3 * 33]); o.z = pkbf(s[4 * 33], s[5 * 33]); o.w = pkbf(s[6 * 33], s[7 * 33]);
        *(u32x4*)(dst + (size_t)(dstRow0 + n) * dstPitch + k0 + 8 * c) = o; }
    asm volatile("s_waitcnt lgkmcnt(0)" ::: "memory");
}
__device__ __forceinline__ void tr_w13(const float* w1, const float* w3, const float* gain, bf16_t* dst, int item, LAS float* scr, int lane) {
    const int nblk = 5632 / 32, kb = item / nblk, nb = item % nblk, R0 = 32 * nb, tile = R0 >> 8, r = R0 & 255;
    tr_item(r < 128 ? w1 : w3, DFF, 64 * kb, 128 * tile + (r & 127), gain, dst, DMODEL, R0, scr, lane);
}
__device__ __forceinline__ void cis_d(double a, double& c, double& s) {
    const double k = rint(a * 0.63661977236758134);
    const double r = fma(-k, 6.123233995736766e-17, fma(-k, 1.5707963267948966, a)), r2 = r * r;
    const double sp = r * (1.0 + r2 * (-1.0 / 6 + r2 * (1.0 / 120 + r2 * (-1.0 / 5040 + r2 * (1.0 / 362880 + r2 * (-1.0 / 39916800 + r2 * (1.0 / 6227020800.0)))))));
    const double cp = 1.0 + r2 * (-0.5 + r2 * (1.0 / 24 + r2 * (-1.0 / 720 + r2 * (1.0 / 40320 + r2 * (-1.0 / 3628800 + r2 * (1.0 / 479001600.0 + r2 * (-1.0 / 87178291200.0)))))));
    const int q = ((int)k) & 3;
    c = (q == 0) ? cp : (q == 1) ? -sp : (q == 2) ? -cp : sp;
    s = (q == 0) ? sp : (q == 1) ? cp : (q == 2) ? -sp : -cp;
}
__device__ __forceinline__ float gelu_tanh(float y) { return y * sigm(1.5957691216057308f * (y + 0.044715f * y * y * y)); }

__device__ __forceinline__ void ssm_item(int bg, const bf16_t* U, const bf16_t* Ktab, const bf16_t* Pend, const bf16_t* Cc, const float* AP, bf16_t* Yout, LAS unsigned char* lds, int tid, unsigned* done) {
    asm volatile("" : "+v"(tid));
    const int lane = tid & 63, wid = __builtin_amdgcn_readfirstlane(tid >> 6), fr = lane & 15, fq = lane >> 4;
    const int b = bg >> 5, g = bg & 31;
    const bf16_t* Ub = U + (size_t)bg * SEQL * 16; const bf16_t* Kt = Ktab + g * 4096; const bf16_t* Pe = Pend + g * 32768; const bf16_t* Cg = Cc + g * 32768; const float* APg = AP + g * 64 * 36;
    float a16r[4], a16i[4];
#pragma unroll
    for (int pt = 0; pt < 4; ++pt) { a16r[pt] = APg[(16 * pt + fr) * 36 + 32]; a16i[pt] = APg[(16 * pt + fr) * 36 + 33]; }
    const float a64r = APg[lane * 36 + 34], a64i = APg[lane * 36 + 35];
    float cr = 0.f, ci = 0.f;
    LAS float* Ebuf = (LAS float*)lds; LAS float* Cbuf = (LAS float*)(lds + 16384); LAS unsigned short* XP = (LAS unsigned short*)(lds + 32768) + wid * (16 * 136);
    const int slot = wid * 4 + fq;
    LAS unsigned short* PendL = (LAS unsigned short*)(lds + 67584); LAS unsigned short* KtL = (LAS unsigned short*)(lds + 135168);
    { const GAS u32x4* ps = (const GAS u32x4*)Pe; u32x4 tv[8];
#pragma unroll
      for (int i = 0; i < 8; ++i) tv[i] = ps[tid + 512 * i];
      const u32x4 kv = ((const GAS u32x4*)Kt)[tid];
#pragma unroll
      for (int i = 0; i < 8; ++i) { const int c = tid + 512 * i; *(LAS u32x4*)(PendL + (c >> 5) * 264 + (c & 31) * 8) = tv[i]; }
      *(LAS u32x4*)(KtL + tid * 8) = kv; }
    __syncthreads();
    for (int seg = 0; seg < 4; ++seg) {
        const int c0 = seg * 128 + wid * 16;
        bf16x8 uf[8];
        { const bf16_t* ub = Ub + ((size_t)(c0 + fr) * 16 + (fq >> 1)) * 16 + 8 * (fq & 1); asm volatile("" : "+v"(ub));
#pragma unroll
        for (int ks = 0; ks < 8; ++ks) uf[ks] = *(const GAS bf16x8*)(ub + 32 * ks); }
        f32x4 S[8];
#pragma unroll
        for (int nt = 0; nt < 8; ++nt) { const LAS unsigned short* pn = PendL + (16 * nt + fr) * 264 + 8 * fq; S[nt] = (f32x4){0.f, 0.f, 0.f, 0.f};
#pragma unroll
            for (int ks = 0; ks < 8; ++ks) { const bf16x8 pf = *(const LAS bf16x8*)(pn + 32 * ks); S[nt] = __builtin_amdgcn_mfma_f32_16x16x32_bf16(uf[ks], pf, S[nt], 0, 0, 0); } }
        f32x4 Y[16];
#pragma unroll
        for (int tl = 0; tl < 16; ++tl) Y[tl] = (f32x4){0.f, 0.f, 0.f, 0.f};
#pragma unroll
        for (int d = 0; d < 16; ++d) { const int j = d - (fq >> 1); bf16x8 kfv = *(const LAS bf16x8*)(KtL + ((j < 0 ? 0 : j) * 16 + fr) * 16 + 8 * (fq & 1)); if (j < 0) kfv = (bf16x8){0, 0, 0, 0, 0, 0, 0, 0};
#pragma unroll
            for (int ks = 0; ks < 8; ++ks) if (d + 2 * ks < 16) Y[d + 2 * ks] = __builtin_amdgcn_mfma_f32_16x16x32_bf16(kfv, uf[ks], Y[d + 2 * ks], 0, 0, 0); }
#pragma unroll
        for (int pt = 0; pt < 4; ++pt) { float xr = 0.f, xi = 0.f;
#pragma unroll
            for (int i = 0; i < 4; ++i) { const float nr = a16r[pt] * xr - a16i[pt] * xi + S[pt][i], ni = a16r[pt] * xi + a16i[pt] * xr + S[pt + 4][i]; xr = nr; xi = ni; }
            Ebuf[slot * 128 + 16 * pt + fr] = xr; Ebuf[slot * 128 + 64 + 16 * pt + fr] = xi; }
        __syncthreads();
        if (wid == 0) {
            float er[32], ei[32];
#pragma unroll
            for (int sl = 0; sl < 32; ++sl) { er[sl] = Ebuf[sl * 128 + lane]; ei[sl] = Ebuf[sl * 128 + 64 + lane]; }
#pragma unroll
            for (int sl = 0; sl < 32; ++sl) { Cbuf[sl * 128 + lane] = cr; Cbuf[sl * 128 + 64 + lane] = ci;
                const float nr = a64r * cr - a64i * ci + er[sl], ni = a64r * ci + a64i * cr + ei[sl]; cr = nr; ci = ni; }
        }
        __syncthreads();
#pragma unroll
        for (int pt = 0; pt < 4; ++pt) { float xr = Cbuf[slot * 128 + 16 * pt + fr], xi = Cbuf[slot * 128 + 64 + 16 * pt + fr];
#pragma unroll
            for (int i = 0; i < 4; ++i) { const unsigned w = pkbf(xr, xi); XP[(4 * fq + i) * 136 + 16 * pt + fr] = (unsigned short)(w & 0xffffu); XP[(4 * fq + i) * 136 + 64 + 16 * pt + fr] = (unsigned short)(w >> 16);
                const float nr = a16r[pt] * xr - a16i[pt] * xi + S[pt][i], ni = a16r[pt] * xi + a16i[pt] * xr + S[pt + 4][i]; xr = nr; xi = ni; } }
        asm volatile("s_waitcnt lgkmcnt(0)" ::: "memory");
        bf16x8 xf[4];
#pragma unroll
        for (int ks = 0; ks < 4; ++ks) xf[ks] = *(const LAS bf16x8*)(XP + fr * 136 + 32 * ks + 8 * fq);
#pragma unroll
        for (int tl = 0; tl < 16; ++tl) { const bf16_t* cp = Cg + (tl * 16 + fr) * 128 + 8 * fq; if ((tl & 3) == 0) asm volatile("" : "+v"(cp) :: "memory"); else asm volatile("" : "+v"(cp));
#pragma unroll
            for (int ks = 0; ks < 4; ++ks) { const bf16x8 cf = *(const GAS bf16x8*)(cp + 32 * ks); Y[tl] = __builtin_amdgcn_mfma_f32_16x16x32_bf16(cf, xf[ks], Y[tl], 0, 0, 0); } }
        bf16_t* yo = Yout + ((size_t)b * SEQL + (size_t)(c0 + fr) * 16) * HW + g * 16 + 4 * fq; asm volatile("" : "+v"(yo));
#pragma unroll
        for (int tl = 0; tl < 16; ++tl) { u32x2 w; w.x = pkbf(gelu_tanh(Y[tl][0]), gelu_tanh(Y[tl][1])); w.y = pkbf(gelu_tanh(Y[tl][2]), gelu_tanh(Y[tl][3])); *(GAS u32x2*)(yo + (size_t)tl * HW) = w; }
        asm volatile("s_waitcnt lgkmcnt(0)" ::: "memory");
    }
    asm volatile("s_waitcnt vmcnt(0)" ::: "memory");
    __syncthreads();
    if (tid == 0) { __builtin_amdgcn_fence(__ATOMIC_RELEASE, "agent"); asm volatile("s_waitcnt vmcnt(0)" ::: "memory"); __hip_atomic_fetch_add(done, 1u, __ATOMIC_RELAXED, __HIP_MEMORY_SCOPE_AGENT); }
}

#define XB_TMO      128
#define XB_XCNT(j)  (256  + 64 * (j))
#define XB_XSUB(j)  (1280 + 64 * (j))
#define XB_XGEN(j)  (2304 + 64 * (j))
#define XB_TOP      3328
#define XB_TOPGEN   3392
#define XCD_BAR_WORDS 3456
#define XB_SPIN_CAP (1u << 18)

__device__ __forceinline__ unsigned xb_ld(unsigned* p)              { return __hip_atomic_load(p, __ATOMIC_RELAXED, __HIP_MEMORY_SCOPE_AGENT); }
__device__ __forceinline__ unsigned xb_add(unsigned* p, unsigned v) { return __hip_atomic_fetch_add(p, v, __ATOMIC_RELAXED, __HIP_MEMORY_SCOPE_AGENT); }
__device__ __forceinline__ unsigned xb_xcc_id() { return (unsigned)__builtin_amdgcn_s_getreg((3 << 11) | 20) & 0xFu; }
#define XB_SPIN(cond, bar) do { unsigned _sp = 0; while (cond) { __builtin_amdgcn_s_sleep(1); \
    if ((++_sp & 255u) == 0u) { if (xb_ld(&(bar)[XB_TMO])) break; if (_sp > XB_SPIN_CAP) { atomicAdd(&(bar)[XB_TMO], 1u); break; } } } } while (0)

struct XcdBarrier {
    unsigned* bar; unsigned x;
    volatile LAS unsigned* st;
};

__device__ __forceinline__ XcdBarrier xcd_barrier_post(unsigned* bar, volatile LAS unsigned* st) {
    XcdBarrier b; b.bar = bar; b.x = xb_xcc_id(); b.st = st;
    if (threadIdx.x == 0) (void)xb_add(&bar[XB_XCNT(b.x)], 1u);
    return b;
}
__device__ __forceinline__ void xcd_barrier_complete(unsigned* bar, unsigned x, unsigned& nloc, unsigned& nx) {
    const unsigned G = gridDim.x * gridDim.y * gridDim.z;
    unsigned sum, cnt, mine, sp = 0u;
    for (;;) {
        sum = 0u; cnt = 0u; mine = 0u;
#pragma unroll
        for (unsigned j = 0; j < 16; ++j) { const unsigned c = xb_ld(&bar[XB_XCNT(j)]); sum += c; cnt += (c > 0u) ? 1u : 0u; mine = (j == x) ? c : mine; }
        if (sum == G) break;
        __builtin_amdgcn_s_sleep(1);
        if ((++sp & 255u) == 0u) { if (xb_ld(&bar[XB_TMO])) break; if (sp > XB_SPIN_CAP) { atomicAdd(&bar[XB_TMO], 1u); break; } }
    }
    nloc = mine > 0u ? mine : 1u; nx = cnt > 0u ? cnt : 1u;
}

__device__ __forceinline__ void xcd_barrier(const XcdBarrier& b) {
    asm volatile("s_waitcnt vmcnt(0)" ::: "memory");
    __syncthreads();
    if (threadIdx.x == 0) {
        unsigned* bar = b.bar;
        __builtin_amdgcn_s_waitcnt(0);
        unsigned nloc = b.st[0], nx = b.st[1];
        if (nloc == 0u) { xcd_barrier_complete(bar, b.x, nloc, nx); b.st[0] = nloc; b.st[1] = nx; }
        const unsigned old = xb_add(&bar[XB_XSUB(b.x)], 1u);
        const unsigned gen = old / nloc;
        if (old + 1u == (gen + 1u) * nloc) {
            __builtin_amdgcn_fence(__ATOMIC_RELEASE, "agent");
            asm volatile("s_waitcnt vmcnt(0)" ::: "memory");
            const unsigned og = xb_add(&bar[XB_TOP], 1u);
            const unsigned tg = og / nx;
            if (og + 1u == (tg + 1u) * nx) xb_add(&bar[XB_TOPGEN], 1u);
            else XB_SPIN(xb_ld(&bar[XB_TOPGEN]) == tg, bar);
            __builtin_amdgcn_fence(__ATOMIC_ACQUIRE, "agent");
            xb_add(&bar[XB_XGEN(b.x)], 1u);
            asm volatile("s_waitcnt vmcnt(0)" ::: "memory");
        } else {
            XB_SPIN(xb_ld(&bar[XB_XGEN(b.x)]) == gen, bar);
            __builtin_amdgcn_fence(__ATOMIC_ACQUIRE, "agent");
            asm volatile("s_waitcnt vmcnt(0)" ::: "memory");
        }
    }
    __syncthreads();
}

constexpr int NATT = 704;
struct Args { const float* in[30]; float* out; unsigned char* ws; };
#define CAS __attribute__((address_space(4)))
#define GSYNC() do { XcdBarrier b_; b_.bar = (unsigned*)(((const CAS Args*)__builtin_amdgcn_kernarg_segment_ptr())->ws + 4096); b_.x = xb_xcc_id(); b_.st = (volatile LAS unsigned*)(lds + MISC_OFF + 32); xcd_barrier(b_); } while (0)
#ifdef PROBE_SEL1
#define STAMP() do { if (blockIdx.x == 0 && threadIdx.x == 0) { unsigned long long* ts_ = (unsigned long long*)(((const CAS Args*)__builtin_amdgcn_kernarg_segment_ptr())->ws + 1024); ts_[nstamp] = __builtin_amdgcn_s_memrealtime(); } ++nstamp; } while (0)
#else
#define STAMP() do {} while (0)
#endif

__global__ void __launch_bounds__(512, 2) mk_fwd(Args a) {
    extern __shared__ __attribute__((aligned(16))) unsigned char lds_raw[];
    cg::grid_group grid = cg::this_grid();
    LAS unsigned char* lds = (LAS unsigned char*)lds_raw;
    const int wave_s = __builtin_amdgcn_readfirstlane((int)(threadIdx.x >> 6));
    int nstamp = 0; (void)nstamp;
    if (threadIdx.x < 32) ((LAS unsigned*)(lds + MISC_OFF))[threadIdx.x] = 0u;
    if (blockIdx.x == 0) { unsigned* cz = (unsigned*)(((const CAS Args*)__builtin_amdgcn_kernarg_segment_ptr())->ws);
        for (int i = threadIdx.x; i < 4480; i += 512) if (i < 128 || i >= 1024) __hip_atomic_store(cz + i, 0u, __ATOMIC_RELAXED, __HIP_MEMORY_SCOPE_AGENT);
        if (threadIdx.x < 64) __hip_atomic_store(cz + 4608 + 64 * threadIdx.x, 0u, __ATOMIC_RELAXED, __HIP_MEMORY_SCOPE_AGENT);
        if (threadIdx.x < 256) __hip_atomic_store(cz + 12288 + threadIdx.x, 0u, __ATOMIC_RELAXED, __HIP_MEMORY_SCOPE_AGENT);
        if (threadIdx.x < 96) __hip_atomic_store(cz + 13312 + threadIdx.x, 0u, __ATOMIC_RELAXED, __HIP_MEMORY_SCOPE_AGENT); }
    __syncthreads();
    grid.sync();
    (void)xcd_barrier_post((unsigned*)(((const CAS Args*)__builtin_amdgcn_kernarg_segment_ptr())->ws + 4096), (volatile LAS unsigned*)(lds + MISC_OFF + 32));
    STAMP();
#define IDS() const CAS Args* ap_ = (const CAS Args*)__builtin_amdgcn_kernarg_segment_ptr(); asm volatile("" : "+s"(ap_)); \
    int tid; asm volatile("v_mbcnt_lo_u32_b32 %0, -1, 0\n\tv_mbcnt_hi_u32_b32 %0, -1, %0" : "=v"(tid)); tid += wave_s * 64; const int lane = tid & 63, wave = __builtin_amdgcn_readfirstlane(tid >> 6); \
    const int G = gridDim.x, bx = blockIdx.x, vcu = (G % 8 == 0) ? (bx % 8) * (G / 8) + bx / 8 : bx; \
    const int gw = vcu * 8 + wave, NGW = G * 8, gt = bx * 512 + tid, NGT = G * 512; (void)lane; (void)gw; (void)NGW; (void)gt; (void)NGT; (void)vcu
#define INP(i) (ap_->in[i])
#define WSP(T, off) ((T*)(ap_->ws + (off)))
#define OUTP (ap_->out)
    {
        IDS();
        const float *x = INP(0), *pin = INP(1), *g_ffn1 = INP(2), *w1_a = INP(3), *w3_a = INP(4), *w2_a = INP(5), *g_mix = INP(6), *w_in = INP(7);
        const float *a_re = INP(9), *a_im = INP(10), *log_dt = INP(11), *b_re = INP(12), *b_im = INP(13);
        const float *w_glu = INP(17), *g_attn_out = INP(19), *g_ssm_out = INP(20), *w_out = INP(21), *g_ffn2 = INP(22), *w1_b = INP(23), *w3_b = INP(24), *w2_b = INP(25);
        const float *g_ple = INP(26), *w_ple_gate = INP(27), *w_ple_proj = INP(28);
        float* AP = WSP(float, WS_AP); float* BB = WSP(float, WS_BB); bf16_t* Wf = WSP(bf16_t, WS_WF); float* ssq0 = WSP(float, WS_SSQ0);
        bf16_t *W13a = WSP(bf16_t, WS_W13A), *W2a = WSP(bf16_t, WS_W2A), *Win = WSP(bf16_t, WS_WIN), *Wglu = WSP(bf16_t, WS_WGLU), *WoA = WSP(bf16_t, WS_WOA);
        bf16_t *W13b = WSP(bf16_t, WS_W13B), *W2b = WSP(bf16_t, WS_W2B), *Wg = WSP(bf16_t, WS_WG), *Wp = WSP(bf16_t, WS_WP), *PB = WSP(bf16_t, WS_PB), *XB = WSP(bf16_t, WS_XB);
        LAS float* scr = (LAS float*)(lds + wave * 16384);
        constexpr int I_13 = 16 * 176, I_IN = 16 * 64;
        constexpr int NITEMS = I_13 + I_IN;
        for (int it = gw; it < NITEMS; it += NGW) {
            int r = it;
            if (r < I_13) { tr_w13(w1_a, w3_a, g_ffn1, W13a, r, scr, lane); continue; } r -= I_13;
            { const int R0 = 32 * (r % 64); tr_item(w_in, 2056, 64 * (r / 64), R0 < 1536 ? R0 : R0 + 8, g_mix, Win, DMODEL, R0, scr, lane); }
        }
        for (int m = gw; m < TOK; m += 2 * NGW) {
            const int m2 = m + NGW; const bool has2 = m2 < TOK; const int mb = has2 ? m2 : m;
            const f32x4* xr = (const f32x4*)(x + (size_t)m * DMODEL) + lane; const f32x4* xr2 = (const f32x4*)(x + (size_t)mb * DMODEL) + lane;
            f32x4 va[4], vb[4];
#pragma unroll
            for (int j = 0; j < 4; ++j) { va[j] = __builtin_nontemporal_load(xr + 64 * j); vb[j] = __builtin_nontemporal_load(xr2 + 64 * j); }
            const f32x4 pa = __builtin_nontemporal_load((const f32x4*)(pin + (size_t)m * PLE) + lane), pb = __builtin_nontemporal_load((const f32x4*)(pin + (size_t)mb * PLE) + lane);
            u32x2* o8 = (u32x2*)(XB + (size_t)m * DMODEL) + lane; u32x2* o8b = (u32x2*)(XB + (size_t)mb * DMODEL) + lane; float ss = 0.f, ss2 = 0.f;
#pragma unroll
            for (int j = 0; j < 4; ++j) { const f32x4 v = va[j]; ss += (v[0] * v[0] + v[1] * v[1]) + (v[2] * v[2] + v[3] * v[3]); u32x2 w; w.x = pkbf(v[0], v[1]); w.y = pkbf(v[2], v[3]); o8[64 * j] = w; }
            ss = wave_sum(ss); if (lane < 16) ssq0[(size_t)m * 16 + lane] = lane == 0 ? ss : 0.f;
            { u32x2 w; w.x = pkbf(pa[0], pa[1]); w.y = pkbf(pa[2], pa[3]); *((u32x2*)(PB + (size_t)m * PLE) + lane) = w; }
            if (has2) {
#pragma unroll
                for (int j = 0; j < 4; ++j) { const f32x4 v = vb[j]; ss2 += (v[0] * v[0] + v[1] * v[1]) + (v[2] * v[2] + v[3] * v[3]); u32x2 w; w.x = pkbf(v[0], v[1]); w.y = pkbf(v[2], v[3]); o8b[64 * j] = w; }
                ss2 = wave_sum(ss2); if (lane < 16) ssq0[(size_t)m2 * 16 + lane] = lane == 0 ? ss2 : 0.f;
                u32x2 w; w.x = pkbf(pb[0], pb[1]); w.y = pkbf(pb[2], pb[3]); *((u32x2*)(PB + (size_t)m2 * PLE) + lane) = w; }
        }
        if (gt < 16384) { const int n = gt >> 10, k = gt & 1023; const float v = n < 8 ? g_mix[k] * w_in[(size_t)k * 2056 + 1536 + n] : 0.f; Wf[gt] = (bf16_t)(pkbf(v, 0.f) & 0xffffu); }
        if (gt < 2048) {
            const int g = gt >> 6; const double dt = exp((double)log_dt[g]), ar = a_re[gt], ai = a_im[gt];
            double cs, sn; cis_d(dt * ai, cs, sn); const double dec = exp(dt * ar), Ar = dec * cs, Ai = dec * sn;
            const double nr = Ar - 1.0, ni = Ai, den = ar * ar + ai * ai, f_r = (nr * ar + ni * ai) / den, f_i = (ni * ar - nr * ai) / den;
            float* ap = AP + gt * 36; double pr = 1.0, pi = 0.0;
            for (int n = 0; n <= 16; ++n) { ap[2 * n] = (float)pr; ap[2 * n + 1] = (float)pi; if (n < 16) { const double t_ = pr * Ar - pi * Ai; pi = pr * Ai + pi * Ar; pr = t_; } }
            double qr = pr * pr - pi * pi, qi = 2.0 * pr * pi; const double q2r = qr * qr - qi * qi, q2i = 2.0 * qr * qi; ap[34] = (float)q2r; ap[35] = (float)q2i;
            for (int h = 0; h < 16; ++h) { const double br = b_re[gt * 16 + h], bi = b_im[gt * 16 + h]; BB[gt * 32 + 2 * h] = (float)(f_r * br - f_i * bi); BB[gt * 32 + 2 * h + 1] = (float)(f_r * bi + f_i * br); }
        }
    }
    GSYNC(); STAMP();

    {
        IDS();
        pg8::Gemm gm{WSP(bf16_t, WS_XB), WSP(bf16_t, WS_W13A), TOK, 2 * DFF, DMODEL}; pg8::StaticOrder S; S.init(TOK, 2 * DFF, G, bx);
        EpiSwiglu E{WSP(bf16_t, WS_H1), WSP(float, WS_SSQ0)};
        pg8::gemm_phase<EpiSwiglu, pg8::StaticOrder, true, true>(lds, gm, S, E, tid);
    }
    if ((int)blockIdx.x >= (int)gridDim.x / 2) {
        IDS();
        const float *c_re = INP(14), *c_im = INP(15), *d_skip = INP(16);
        const float* AP = WSP(float, WS_AP); const float* BB = WSP(float, WS_BB); bf16_t* Ktab = WSP(bf16_t, WS_KTAB); bf16_t* Pend = WSP(bf16_t, WS_PEND); bf16_t* Cc = WSP(bf16_t, WS_CC);
        const int gt2 = (bx - G / 2) * 512 + tid, NGT2 = (G - G / 2) * 512;
        { const float *w2_a = INP(5), *w_glu = INP(17), *g_attn_out = INP(19), *g_ssm_out = INP(20), *w_out = INP(21), *w_ple_proj = INP(28);
          bf16_t *W2a = WSP(bf16_t, WS_W2A), *Wglu = WSP(bf16_t, WS_WGLU), *WoA = WSP(bf16_t, WS_WOA), *Wp = WSP(bf16_t, WS_WP);
          LAS float* scr = (LAS float*)(lds + wave * 16384);
          constexpr int I_2 = 44 * 32, I_GLU = 8 * 16, I_O = 8 * 32, I_P = 4 * 32;
          for (int it = (bx - G / 2) * 8 + wave; it < I_2 + I_GLU + 2 * I_O + I_P; it += (G - G / 2) * 8) {
              int r = it;
              if (r < I_2) { tr_item(w2_a, DMODEL, 64 * (r / 32), 32 * (r % 32), nullptr, W2a, DFF, 32 * (r % 32), scr, lane); continue; } r -= I_2;
              if (r < I_GLU) { tr_item(w_glu, HW, 64 * (r / 16), 32 * (r % 16), nullptr, Wglu, HW, 32 * (r % 16), scr, lane); continue; } r -= I_GLU;
              if (r < 2 * I_O) { const int kb = r / 32; tr_item(w_out, DMODEL, 64 * kb, 32 * (r % 32), kb < 8 ? g_attn_out : g_ssm_out - HW, WoA, DMODEL, 32 * (r % 32), scr, lane); continue; } r -= 2 * I_O;
              tr_item(w_ple_proj, DMODEL, 64 * (r / 32), 32 * (r % 32), nullptr, Wp, PLE, 32 * (r % 32), scr, lane);
          } }
        for (int idx = gt2; idx < 131072; idx += NGT2) {
            const int g = idx >> 12, j = (idx >> 8) & 15, h = (idx >> 4) & 15, hp = idx & 15; float s = 0.f;
#pragma unroll 16
            for (int p = 0; p < 64; ++p) { const float Cr = c_re[(g * 16 + h) * 64 + p], Ci = c_im[(g * 16 + h) * 64 + p], Ar = AP[(g * 64 + p) * 36 + 2 * j], Ai = AP[(g * 64 + p) * 36 + 2 * j + 1];
                const float Wr = Cr * Ar - Ci * Ai, Wi = Cr * Ai + Ci * Ar, Br = BB[(g * 64 + p) * 32 + 2 * hp], Bi = BB[(g * 64 + p) * 32 + 2 * hp + 1]; s += Wr * Br - Wi * Bi; }
            if (j == 0 && h == hp) s += d_skip[g * 16 + h];
            Ktab[idx] = (bf16_t)(pkbf(s, 0.f) & 0xffffu);
        }
        for (int idx = gt2; idx < 1048576; idx += NGT2) {
            { const int g = idx >> 15, comp = (idx >> 8) & 127, k = idx & 255, p = comp & 63, im = comp >> 6, sl = k >> 4, hp = k & 15;
              const float Ar = AP[(g * 64 + p) * 36 + 2 * (15 - sl)], Ai = AP[(g * 64 + p) * 36 + 2 * (15 - sl) + 1], Br = BB[(g * 64 + p) * 32 + 2 * hp], Bi = BB[(g * 64 + p) * 32 + 2 * hp + 1];
              const float v = im ? (Ar * Bi + Ai * Br) : (Ar * Br - Ai * Bi); Pend[idx] = (bf16_t)(pkbf(v, 0.f) & 0xffffu); }
            { const int g = idx >> 15, n = (idx >> 7) & 255, tl = n >> 4, h = n & 15, comp = idx & 127, p = comp & 63, im = comp >> 6;
              const float Cr = c_re[(g * 16 + h) * 64 + p], Ci = c_im[(g * 16 + h) * 64 + p], Ar = AP[(g * 64 + p) * 36 + 2 * (tl + 1)], Ai = AP[(g * 64 + p) * 36 + 2 * (tl + 1) + 1];
              const float v = im ? -(Cr * Ai + Ci * Ar) : (Cr * Ar - Ci * Ai); Cc[idx] = (bf16_t)(pkbf(v, 0.f) & 0xffffu); }
        }
    }
    GSYNC(); STAMP();
    {
        IDS();
        pg8::Gemm gm{WSP(bf16_t, WS_H1), WSP(bf16_t, WS_W2A), TOK, DMODEL, DFF}; pg8::StaticOrder S; S.init(TOK, DMODEL, G, bx);
        EpiRes<false, false> E{INP(0), WSP(bf16_t, WS_XB), WSP(float, WS_SSQ1), nullptr, 0.5f};
        pg8::gemm_phase<EpiRes<false, false>, pg8::StaticOrder, true, true>(lds, gm, S, E, tid);
    }
    GSYNC(); STAMP();
    {
        IDS();
        const float* b_f = INP(8); const bf16_t* XB = WSP(bf16_t, WS_XB); const bf16_t* Wf = WSP(bf16_t, WS_WF); const float* ssq1 = WSP(float, WS_SSQ1); float* LOGF = WSP(float, WS_LOGF);
        const int fr = lane & 15, fq = lane >> 4;
        for (int it = gw >> 1; it < TOK / 16; it += NGW >> 1) {
            const int t0 = it * 16, kh = wave & 1; f32x4 acc0 = (f32x4){0.f, 0.f, 0.f, 0.f}, acc1 = acc0;
            const bf16_t* ap = XB + (size_t)(t0 + fr) * DMODEL + 8 * fq + 512 * kh; const bf16_t* bp = Wf + fr * DMODEL + 8 * fq + 512 * kh;
            bf16x8 av[16], bv[16];
#pragma unroll
            for (int ks = 0; ks < 16; ++ks) { av[ks] = *(const bf16x8*)(ap + 32 * ks); bv[ks] = *(const bf16x8*)(bp + 32 * ks); }
#pragma unroll
            for (int ks = 0; ks < 16; ks += 2) { acc0 = __builtin_amdgcn_mfma_f32_16x16x32_bf16(av[ks], bv[ks], acc0, 0, 0, 0); acc1 = __builtin_amdgcn_mfma_f32_16x16x32_bf16(av[ks + 1], bv[ks + 1], acc1, 0, 0, 0); }
            f32x4 acc = acc0 + acc1;
            LAS f32x4* xch = (LAS f32x4*)(lds + (wave >> 1) * 1024) + lane;
            if (kh) *xch = acc;
            __syncthreads();
            if (!kh) { acc = acc + *xch;
                if (fr < 8) { const int r0 = t0 + 4 * fq; const float bf = b_f[fr]; f32x4 o;
#pragma unroll
                    for (int i = 0; i < 4; ++i) { const float z = rstd_row<16>(ssq1, r0 + i, 1.f / 1024.f) * acc[i] + bf; o[i] = fminf(z, 0.f) - log1pf(expf(-fabsf(z))); }
                    *(f32x4*)(LOGF + (size_t)((r0 >> 13) * 8 + fr) * SEQL + (r0 & 8191)) = o; } }
            __syncthreads();
        }
        pg8::Gemm gm{XB, WSP(bf16_t, WS_WIN), TOK, 2048, DMODEL}; pg8::StaticOrder S; S.init(TOK, 2048, G, bx);
        EpiQKVU E{WSP(bf16_t, WS_Q), WSP(bf16_t, WS_U), ssq1, WSP(unsigned, WS_CTL) + 13312};
        pg8::gemm_phase<EpiQKVU, pg8::StaticOrder, true, true>(lds, gm, S, E, tid);
    }
    GSYNC(); STAMP();
    {
        volatile LAS int* qs = (volatile LAS int*)(lds + MISC_OFF);
        int qfirst = 1;
        for (;;) {
            IDS();
            int item;
            if (qfirst) { item = bx; qfirst = 0; }
            else {
                if (tid == 0) qs[0] = G + (int)__hip_atomic_fetch_add(WSP(unsigned, WS_CTL) + 64, 1u, __ATOMIC_RELAXED, __HIP_MEMORY_SCOPE_AGENT);
                __syncthreads();
                item = __builtin_amdgcn_readfirstlane(qs[0]);
                __syncthreads(); }
            if (item >= 64 + NATT + 176 + 256 + 128) break;
            if (item >= 64 + NATT + 176 + 256) {
                const int j_ = item - (64 + NATT + 176 + 256);
                if (tid == 0) { unsigned* dn = WSP(unsigned, WS_CTL) + 13400 + (j_ >> 6);
                    for (unsigned sp = 0; sp < (1u << 22); ++sp) { if (__hip_atomic_load(dn, __ATOMIC_RELAXED, __HIP_MEMORY_SCOPE_AGENT) >= 32u) break; __builtin_amdgcn_s_sleep(8); }
                    __builtin_amdgcn_fence(__ATOMIC_ACQUIRE, "agent"); asm volatile("s_waitcnt vmcnt(0)" ::: "memory"); }
                __syncthreads();
                pg8::Gemm gm{WSP(bf16_t, WS_Y), WSP(bf16_t, WS_WGLU), TOK, HW, HW}; StrideOrder S{j_, 1 << 28, 128, 2};
                EpiGlu E{WSP(bf16_t, WS_Y), INP(18), WSP(bf16_t, WS_SSMO), WSP(float, WS_SSQS)};
                pg8::gemm_phase<EpiGlu, StrideOrder, true, true>(lds, gm, S, E, tid); continue; }
            if (item >= 64 + NATT + 176) {
                pg8::Gemm gm{WSP(bf16_t, WS_PB), WSP(bf16_t, WS_WP), TOK, DMODEL, PLE}; StrideOrder S{item - (64 + NATT + 176), 1 << 28, 256, 4};
                EpiBf16P E{WSP(bf16_t, WS_PP)};
                pg8::gemm_phase<EpiBf16P, StrideOrder, true, true>(lds, gm, S, E, tid); continue; }
            if (item >= 64 + NATT) {
                tr_w13(INP(23), INP(24), INP(22), WSP(bf16_t, WS_W13B), (item - (64 + NATT)) * 16 + wave * 2, (LAS float*)(lds + wave * 16384), lane);
                tr_w13(INP(23), INP(24), INP(22), WSP(bf16_t, WS_W13B), (item - (64 + NATT)) * 16 + wave * 2 + 1, (LAS float*)(lds + wave * 16384), lane);
                __syncthreads(); continue; }
            const bool is_ssm = item < 64;
#ifdef PROBE_SEL1
            const unsigned long long t0_ = __builtin_amdgcn_s_memrealtime();
#endif
            if (is_ssm) ssm_item(item, WSP(bf16_t, WS_U), WSP(bf16_t, WS_KTAB), WSP(bf16_t, WS_PEND), WSP(bf16_t, WS_CC), WSP(float, WS_AP), WSP(bf16_t, WS_Y), lds, tid, WSP(unsigned, WS_CTL) + 13400 + (item >> 5));
            else { const int a_ = item - 64; int kind, bh, qb;
                if (a_ < 64) { kind = 2; bh = a_ & 15; qb = 19 - (a_ >> 4); }
                else if (a_ < 64 + 576) { const int c_ = a_ - 64, lvl = c_ / 48, r_ = c_ % 48; kind = r_ >> 4; bh = r_ & 15; qb = kind < 2 ? 31 - lvl : 15 - lvl; }
                else { const int c_ = a_ - 640; kind = 2; bh = c_ & 15; qb = 3 - (c_ >> 4); }
                const int ntf = 4 * (qb + 1), tm = ntf >> 1, tb = kind == 0 ? tm : 0, te = kind == 1 ? tm : ntf, mode = kind == 2 ? 0 : (kind == 0 ? 2 : 1), sid = kind < 2 ? (qb - 20) * 16 + bh : 0;
                attn_body::attn_unit<96>(bh >> 3, bh & 7, qb, tb, te, mode, (sid < 60 ? WSP(float, 180 * MiB) + (size_t)sid * PARTF : sid < 105 ? WSP(float, WS_W2B) + (size_t)(sid - 60) * PARTF : WSP(float, 236 * MiB) + (size_t)(sid - 105) * PARTF), WSP(unsigned, WS_CTL) + 12288 + sid, WSP(unsigned, WS_CTL) + 13312 + 2 * bh,
                    WSP(attn_body::bf16, WS_Q), WSP(attn_body::bf16, WS_K), WSP(attn_body::bf16, WS_V), WSP(attn_body::bf16, WS_Q), WSP(float, WS_LOGF), WSP(float, WS_SSQA), (char*)lds_raw, tid); }
#ifdef PROBE_SEL1
            if (tid == 0) { const unsigned d_ = (unsigned)(__builtin_amdgcn_s_memrealtime() - t0_); atomicMax(WSP(unsigned, WS_CTL) + (is_ssm ? 128 : 129), d_); if (is_ssm) atomicMin(WSP(unsigned, WS_CTL) + 130, ~d_); }
#endif
        }
    }
    GSYNC(); STAMP();
    {
        { IDS(); pg8::Gemm gm{WSP(bf16_t, WS_Q), WSP(bf16_t, WS_WOA), TOK, DMODEL, DMODEL, WSP(bf16_t, WS_SSMO), HW}; pg8::StaticOrder S; S.init(TOK, DMODEL, G, bx);
          EpiOut E{WSP(bf16_t, WS_XB), WSP(float, WS_SSQ2), WSP(float, WS_SSQA), WSP(float, WS_SSQS)};
          pg8::gemm_phase<EpiOut, pg8::StaticOrder, true, true>(lds, gm, S, E, tid); }
    }
    GSYNC(); STAMP();
    {
        IDS();
        pg8::Gemm gm{WSP(bf16_t, WS_XB), WSP(bf16_t, WS_W13B), TOK, 2 * DFF, DMODEL}; pg8::StaticOrder S; S.init(TOK, 2 * DFF, G, bx);
        EpiSwiglu E{WSP(bf16_t, WS_H1), WSP(float, WS_SSQ2)};
        pg8::gemm_phase<EpiSwiglu, pg8::StaticOrder, true, true>(lds, gm, S, E, tid);
    }
    if ((int)blockIdx.x >= (int)gridDim.x / 2) {
        IDS();
        const float *w2_b = INP(25), *g_ple = INP(26), *w_ple_gate = INP(27); bf16_t *W2b = WSP(bf16_t, WS_W2B), *Wg = WSP(bf16_t, WS_WG);
        LAS float* scr = (LAS float*)(lds + wave * 16384);
        constexpr int I_2 = 44 * 32, I_G = 16 * 32;
        for (int it = (bx - G / 2) * 8 + wave; it < I_2 + I_G; it += (G - G / 2) * 8) {
            int r = it;
            if (r < I_2) { tr_item(w2_b, DMODEL, 64 * (r / 32), 32 * (r % 32), nullptr, W2b, DFF, 32 * (r % 32), scr, lane); continue; } r -= I_2;
            tr_item(w_ple_gate, DMODEL, 64 * (r / 32), 32 * (r % 32), g_ple, Wg, DMODEL, 32 * (r % 32), scr, lane);
        }
    }
    GSYNC(); STAMP();
    {
        IDS();
        pg8::Gemm gm{WSP(bf16_t, WS_H1), WSP(bf16_t, WS_W2B), TOK, DMODEL, DFF}; pg8::StaticOrder S; S.init(TOK, DMODEL, G, bx);
        EpiRes<false, true> E{nullptr, WSP(bf16_t, WS_XB), WSP(float, WS_SSQ3), nullptr, 0.5f};
        pg8::gemm_phase<EpiRes<false, true>, pg8::StaticOrder, true, true>(lds, gm, S, E, tid);
    }
    GSYNC(); STAMP();
    {
        if ((int)gridDim.x == 256) { IDS(); pg8::Gemm gm{WSP(bf16_t, WS_XB), WSP(bf16_t, WS_WG), TOK, DMODEL, DMODEL}; pg8::StaticOrder S; S.init(TOK, DMODEL, G, bx);
          EpiGateFinal E{WSP(bf16_t, WS_XB), OUTP, WSP(bf16_t, WS_PP), WSP(float, WS_SSQ3), WSP(float, WS_SSQ4), WSP(unsigned, WS_CTL) + 4608, INP(29)};
          pg8::gemm_phase<EpiGateFinal, pg8::StaticOrder, true, true>(lds, gm, S, E, tid); }
        else { IDS(); pg8::Gemm gm{WSP(bf16_t, WS_XB), WSP(bf16_t, WS_WG), TOK, DMODEL, DMODEL}; pg8::StaticOrder S; S.init(TOK, DMODEL, G, bx);
          EpiGate E{WSP(bf16_t, WS_XB), OUTP, WSP(bf16_t, WS_PP), WSP(float, WS_SSQ3), WSP(float, WS_SSQ4)};
          pg8::gemm_phase<EpiGate, pg8::StaticOrder, true, true>(lds, gm, S, E, tid); }
    }
    if ((int)gridDim.x != 256) {
    GSYNC(); STAMP();
    { IDS(); const float* ssq4 = WSP(float, WS_SSQ4); float* out = OUTP; const float* g_final = INP(29);
    for (int m = gw; m < TOK; m += NGW) {
        const float rs = rstd_row<16>(ssq4, m, 1.f / 1024.f); f32x4* o = (f32x4*)(out + (size_t)m * DMODEL) + lane; const f32x4* gf = (const f32x4*)g_final + lane;
#pragma unroll
        for (int j = 0; j < 4; ++j) { const f32x4 v = o[64 * j], gg = gf[64 * j]; o[64 * j] = v * rs * gg; }
    } }
    }
#ifdef PROBE_SEL1
    GSYNC(); STAMP();
    if (blockIdx.x == 0) { IDS(); const unsigned long long* ts_ = (const unsigned long long*)(ap_->ws + 1024); const unsigned* cw = WSP(unsigned, WS_CTL);
        float dur[15];
#pragma unroll
        for (int k = 0; k < 11; ++k) dur[k] = (float)(ts_[k + 1] - ts_[k]) * 0.01f;
        dur[11] = (float)cw[128] * 0.01f; dur[12] = (float)cw[129] * 0.01f; dur[13] = (float)(~cw[130]) * 0.01f; dur[14] = (float)(ts_[11] - ts_[0]) * 0.01f;
        float t1 = 0.f, t2 = 0.f;
#pragma unroll
        for (int k = 0; k < 15; ++k) { if (k == PROBE_SEL1) t1 = dur[k]; if (k == PROBE_SEL2) t2 = dur[k]; }
        if (tid == 0) OUTP[0] += t1 * 0.01f;
        for (int r = tid; r < 1024; r += 512) OUTP[(size_t)(r * 16) * DMODEL + 1] += t2 * 0.01f; }
#endif
}

extern "C" void kernel_launch(void* const* d_in, const int* in_sizes, int n_in, void* d_out, int out_size, void* d_ws, size_t ws_size, hipStream_t stream) {
    static int grid = 0;
    if (grid == 0) {
        if (n_in != 30 || out_size != TOK * DMODEL || ws_size < WS_END) { fprintf(stderr, "kernel_launch: unexpected problem (n_in %d out %d ws %zu)\n", n_in, out_size, ws_size); grid = -1; return; }
        int dev = 0, cus = 0, per_cu = 0;
        (void)hipGetDevice(&dev); (void)hipDeviceGetAttribute(&cus, hipDeviceAttributeMultiprocessorCount, dev);
        if (hipFuncSetAttribute((const void*)mk_fwd, hipFuncAttributeMaxDynamicSharedMemorySize, LDS_BYTES) != hipSuccess) { fprintf(stderr, "kernel_launch: hipFuncSetAttribute failed\n"); grid = -1; return; }
        if (hipOccupancyMaxActiveBlocksPerMultiprocessor(&per_cu, (const void*)mk_fwd, 512, LDS_BYTES) != hipSuccess || per_cu < 1) { fprintf(stderr, "kernel_launch: occupancy query gave %d\n", per_cu); per_cu = 1; }
        (void)hipGetLastError();
        grid = cus * per_cu;
    }
    if (grid < 0) return;
    Args a{};
    for (int i = 0; i < 30; ++i) a.in[i] = (const float*)d_in[i];
    a.out = (float*)d_out; a.ws = (unsigned char*)d_ws;
    void* args[] = {&a};
    hipError_t e = hipLaunchCooperativeKernel((const void*)mk_fwd, dim3(grid), dim3(512), args, LDS_BYTES, stream);
    if (e != hipSuccess) fprintf(stderr, "kernel_launch: cooperative launch failed: %s (grid %d)\n", hipGetErrorString(e), grid);
}
```

```cpp
#include <hip/hip_runtime.h>
#include <hip/hip_bf16.h>
#include <cmath>
#include <hip/hip_cooperative_groups.h>
#include <cstdio>
#include <cstdint>
namespace cg = cooperative_groups;
template <int MASK> __device__ __forceinline__ float sx(float v) { return __builtin_bit_cast(float, __builtin_amdgcn_ds_swizzle(__builtin_bit_cast(int, v), (MASK << 10) | 0x1f)); }
__device__ __forceinline__ float sum32(float v) { unsigned a = __builtin_bit_cast(unsigned, v), b = a; asm volatile("v_nop\n\tv_nop\n\tv_permlane32_swap_b32 %0, %1" : "+v"(a), "+v"(b)); return __builtin_bit_cast(float, a) + __builtin_bit_cast(float, b); }
__device__ __forceinline__ float max32(float v) { unsigned a = __builtin_bit_cast(unsigned, v), b = a; asm volatile("v_nop\n\tv_nop\n\tv_permlane32_swap_b32 %0, %1" : "+v"(a), "+v"(b)); return __builtin_fmaxf(__builtin_bit_cast(float, a), __builtin_bit_cast(float, b)); }
namespace pg8 {
#define PG8_LAS __attribute__((address_space(3)))
typedef unsigned short bf16_t;
typedef short bf16x8 __attribute__((ext_vector_type(8)));
typedef float f32x4 __attribute__((ext_vector_type(4)));
typedef unsigned u32x4 __attribute__((ext_vector_type(4)));
constexpr int BM = 256, BK = 64, HALF = 128, HTB = HALF * BK * 2  , STAGE_BYTES = 8 * HTB, NXCD = 8, WGM = 8;

__host__ __device__ __forceinline__ int lds_byte(int r, int c) { const int st = (r >> 4) * 2 + (c >> 5), rr = r & 15, cc = c & 31, ob = rr * 64 + cc * 2; return st * 1024 + (ob ^ (((ob >> 9) & 1) << 5)); }
__host__ __device__ __forceinline__ void stage_rc(int b, int& R, int& C) { const int st = b / 1024, sb = b % 1024, swz = sb ^ (((sb >> 9) & 1) << 5); R = (st >> 1) * 16 + swz / 64; C = (st & 1) * 32 + (swz % 64) / 2; }
__host__ __device__ __forceinline__ int perm32(int rho) { const int n = rho >> 4, i = rho & 15; return 8 * (i >> 2) + 4 * n + (i & 3); }

struct Unit { int pm, pn; };
struct Gemm { const bf16_t* A; const bf16_t* Bt; int M, N, K; const bf16_t* A2 = nullptr; int lda = 0; };

struct StaticOrder {
    int nM, nN, nwg, G, c;
    __host__ __device__ void init(int M, int N, int G_, int c_) { nM = M / BM; nN = N / BM; nwg = nM * nN; G = G_; c = c_; }
    __host__ __device__ bool next(int i, Unit& u) const {
        const long L = (long)i * G + c; if (L >= nwg) return false;
        int wgid = (int)L; { const int q = nwg / NXCD, r = nwg % NXCD, xcd = wgid % NXCD, off = wgid / NXCD; wgid = (xcd < r ? xcd * (q + 1) : r * (q + 1) + (xcd - r) * q) + off; }
        const int nig = WGM * nN, gid = wgid / nig, fm = gid * WGM, gsz = (nM - fm) < WGM ? (nM - fm) : WGM;
        u.pm = fm + ((wgid % nig) % gsz); u.pn = (wgid % nig) / gsz; return true;
    }
    __device__ __forceinline__ void a_ready(const Unit&) const {}
    __device__ __forceinline__ void done(const Unit&) const {}
};

__device__ __forceinline__ unsigned cvt_pk_bf16(float lo, float hi) { unsigned r; asm volatile("v_cvt_pk_bf16_f32 %0, %1, %2" : "=v"(r) : "v"(lo), "v"(hi)); return r; }
typedef float f32x2 __attribute__((ext_vector_type(2)));
template <class Epi, class Sched, bool ALIGN_EPI = false, bool SP2 = false>
__device__ __forceinline__ void gemm_phase(PG8_LAS unsigned char* lds, const Gemm g, const Sched& S, const Epi& E, int tid_in) {
    int tid_ = tid_in; asm volatile("" : "+v"(tid_)); const int tid = tid_, wid = __builtin_amdgcn_readfirstlane(tid >> 6), lane = tid & 63, wr = wid >> 2, wc = wid & 3, fr = lane & 15, fq = lane >> 4;
    const int K = g.K, nt = K / BK, lda = g.lda ? g.lda : K, ksplit = g.A2 ? nt / 2 : nt;
    unsigned voffA[2], voffB[2];
#pragma unroll
    for (int i = 0; i < 2; ++i) { int R, C; stage_rc(tid * 16 + i * 8192, R, C); const int Rb = Epi::PERM ? ((R & ~31) + perm32(R & 31)) : R;
        voffA[i] = (unsigned)(R * lda + C) * 2u; voffB[i] = (unsigned)(Rb * K + C) * 2u; }
    const size_t kstep = (size_t)(BK * 2);
    const size_t hstep = (size_t)HALF * K * 2;
    const size_t tstep = 2 * hstep; const size_t hstepA = (size_t)HALF * lda * 2, tstepA = 2 * hstepA;
    const unsigned ldsw = (unsigned)wid * 1024u;
    const int aoff = lds_byte(wr * 64 + fr, fq * 8), boff = lds_byte(wc * 32 + fr, fq * 8);
#define PG8_SA(b, h) (((b) * 2 + (h)) * HTB)
#define PG8_SB(b, h) ((4 + (b) * 2 + (h)) * HTB)
#define PG8_STAGE(bufoff, gbase, voff) do { _Pragma("unroll") for (int _i = 0; _i < 2; ++_i) \
        __builtin_amdgcn_global_load_lds((const unsigned*)((const char*)(gbase) + (voff)[_i]), (PG8_LAS unsigned*)(lds + (bufoff) + ldsw + _i * 8192), 16, 0, 0); } while (0)
#define PG8_LDA(dst, b, h) do { _Pragma("unroll") for (int m = 0; m < 4; ++m) _Pragma("unroll") for (int k = 0; k < 2; ++k) dst[m][k] = *(const PG8_LAS bf16x8*)(lds + PG8_SA(b, h) + aoff + m * 2048 + k * 1024); } while (0)
#define PG8_LDB(dst, b, h) do { _Pragma("unroll") for (int n = 0; n < 2; ++n) _Pragma("unroll") for (int k = 0; k < 2; ++k) dst[n][k] = *(const PG8_LAS bf16x8*)(lds + PG8_SB(b, h) + boff + n * 2048 + k * 1024); } while (0)
#define PG8_MMA(ai, bj, At, Bt) do { __builtin_amdgcn_s_setprio(1); _Pragma("unroll") for (int m = 0; m < 4; ++m) _Pragma("unroll") for (int n = 0; n < 2; ++n) _Pragma("unroll") for (int k = 0; k < 2; ++k) \
        acc[ai][bj][m][n] = __builtin_amdgcn_mfma_f32_16x16x32_bf16(Bt[n][k], At[m][k], acc[ai][bj][m][n], 0, 0, 0); __builtin_amdgcn_s_setprio(0); } while (0)
#define PG8_WAIT_V(n) asm volatile("s_waitcnt vmcnt(" #n ")" ::: "memory")
#define PG8_WAIT_L(n) asm volatile("s_waitcnt lgkmcnt(" #n ")" ::: "memory")
#define PG8_BAR __builtin_amdgcn_s_barrier()
#define PG8_SCHED __builtin_amdgcn_sched_barrier(0)
    Unit cur, nxt; int ui = 0;
    if (!S.next(0, cur)) return;
    f32x4 acc[2][2][4][2];
#pragma unroll
    for (int a = 0; a < 2; ++a)
#pragma unroll
        for (int b = 0; b < 2; ++b)
#pragma unroll
            for (int m = 0; m < 4; ++m)
#pragma unroll
                for (int n = 0; n < 2; ++n) acc[a][b][m][n] = (f32x4){0.f, 0.f, 0.f, 0.f};
    bf16x8 At[4][2], B0[2][2], B1[2][2];
    const char* cA = (const char*)g.A + (size_t)cur.pm * tstepA; const char* cA2 = (const char*)g.A2 + (size_t)cur.pm * tstepA; const char* cB = (const char*)g.Bt + (size_t)cur.pn * tstep;
    S.a_ready(cur);
    if constexpr (SP2) {
        PG8_STAGE(PG8_SB(0, 0), cB, voffB); PG8_STAGE(PG8_SB(0, 1), cB + hstep, voffB); PG8_STAGE(PG8_SA(0, 0), cA, voffA); PG8_STAGE(PG8_SA(0, 1), cA + hstepA, voffA);
        if (wr == 1) PG8_BAR;
        PG8_WAIT_V(2); PG8_BAR;
        PG8_STAGE(PG8_SB(1, 0), cB + kstep, voffB); PG8_STAGE(PG8_SA(1, 0), cA + kstep, voffA); PG8_STAGE(PG8_SB(1, 1), cB + hstep + kstep, voffB);
        PG8_WAIT_V(6); PG8_BAR;
    } else {
        PG8_STAGE(PG8_SB(0, 0), cB, voffB); PG8_STAGE(PG8_SA(0, 0), cA, voffA); PG8_STAGE(PG8_SB(0, 1), cB + hstep, voffB); PG8_STAGE(PG8_SA(0, 1), cA + hstepA, voffA);
        if (wr == 1) PG8_BAR;
        PG8_WAIT_V(4); PG8_BAR;
        PG8_STAGE(PG8_SB(1, 0), cB + kstep, voffB); PG8_STAGE(PG8_SA(1, 0), cA + kstep, voffA); PG8_STAGE(PG8_SB(1, 1), cB + hstep + kstep, voffB);
        PG8_WAIT_V(6); PG8_BAR;
    }
    for (;;) {
        const bool has_next = S.next(ui + 1, nxt);
        const char* nA = has_next ? (const char*)g.A + (size_t)nxt.pm * tstepA : cA; const char* nA2 = has_next ? (const char*)g.A2 + (size_t)nxt.pm * tstepA : cA2; const char* nB = has_next ? (const char*)g.Bt + (size_t)nxt.pn * tstep : cB;
        for (int t = 0; t < nt; t += 2) {
            const bool last = (t == nt - 2);
            const char* a1 = (t + 1 < ksplit) ? cA + (size_t)(t + 1) * kstep : cA2 + (size_t)(t + 1 - ksplit) * kstep;
            const char* a2 = last ? nA : ((t + 2 < ksplit) ? cA + (size_t)(t + 2) * kstep : cA2 + (size_t)(t + 2 - ksplit) * kstep); const char* b2 = last ? nB : cB + (size_t)(t + 2) * kstep;
            const char* a3 = a2 + kstep; const char* b3 = b2 + kstep;
            if (last && has_next) S.a_ready(nxt);
            if constexpr (Epi::MIDK) { if (t == nt / 2) { int l_; asm volatile("v_mbcnt_lo_u32_b32 %0, -1, 0\n\tv_mbcnt_hi_u32_b32 %0, -1, %0" : "=v"(l_)); E.mid(acc, cur, wr, wc, l_ & 15, l_ >> 4); } }
            if constexpr (SP2) {
            PG8_LDB(B0, 0, 0); PG8_LDB(B1, 0, 1); PG8_SCHED; PG8_LDA(At, 0, 0); PG8_STAGE(PG8_SA(1, 1), a1 + hstepA, voffA);
            PG8_WAIT_V(8); PG8_WAIT_L(0); PG8_BAR; PG8_MMA(0, 0, At, B0); PG8_MMA(0, 1, At, B1); PG8_BAR; PG8_SCHED;
            PG8_LDA(At, 0, 1); PG8_STAGE(PG8_SB(0, 0), b2, voffB); PG8_STAGE(PG8_SB(0, 1), b2 + hstep, voffB); PG8_STAGE(PG8_SA(0, 0), a2, voffA);
            PG8_WAIT_V(8); PG8_WAIT_L(0); PG8_BAR; PG8_MMA(1, 0, At, B0); PG8_MMA(1, 1, At, B1); PG8_BAR; PG8_SCHED;
            PG8_LDB(B0, 1, 0); PG8_LDB(B1, 1, 1); PG8_SCHED; PG8_LDA(At, 1, 0); PG8_STAGE(PG8_SA(0, 1), a2 + hstepA, voffA);
            PG8_WAIT_V(8); PG8_WAIT_L(0); PG8_BAR; PG8_MMA(0, 0, At, B0); PG8_MMA(0, 1, At, B1); PG8_BAR; PG8_SCHED;
            PG8_LDA(At, 1, 1); PG8_STAGE(PG8_SB(1, 0), b3, voffB); PG8_STAGE(PG8_SB(1, 1), b3 + hstep, voffB); PG8_STAGE(PG8_SA(1, 0), a3, voffA);
            PG8_WAIT_V(8); PG8_WAIT_L(0); PG8_BAR; PG8_MMA(1, 0, At, B0); PG8_MMA(1, 1, At, B1); PG8_BAR; PG8_SCHED;
            } else {
            PG8_LDB(B0, 0, 0); PG8_SCHED; PG8_LDA(At, 0, 0); PG8_STAGE(PG8_SA(1, 1), a1 + hstepA, voffA);
            PG8_WAIT_L(8); PG8_BAR; PG8_WAIT_L(0); PG8_MMA(0, 0, At, B0); PG8_BAR; PG8_SCHED;
            PG8_LDB(B1, 0, 1); PG8_STAGE(PG8_SB(0, 0), b2, voffB);
            PG8_BAR; PG8_WAIT_L(0); PG8_MMA(0, 1, At, B1); PG8_BAR;
            PG8_LDA(At, 0, 1); PG8_STAGE(PG8_SA(0, 0), a2, voffA);
            PG8_BAR; PG8_WAIT_L(0); PG8_MMA(1, 0, At, B0); PG8_BAR; PG8_SCHED;
            PG8_STAGE(PG8_SB(0, 1), b2 + hstep, voffB);
            PG8_WAIT_V(6); PG8_BAR; PG8_MMA(1, 1, At, B1); PG8_BAR;
            PG8_LDB(B0, 1, 0); PG8_SCHED; PG8_LDA(At, 1, 0); PG8_STAGE(PG8_SA(0, 1), a2 + hstepA, voffA);
            PG8_WAIT_L(8); PG8_BAR; PG8_WAIT_L(0); PG8_MMA(0, 0, At, B0); PG8_BAR; PG8_SCHED;
            PG8_LDB(B1, 1, 1); PG8_STAGE(PG8_SB(1, 0), b3, voffB);
            PG8_BAR; PG8_WAIT_L(0); PG8_MMA(0, 1, At, B1); PG8_BAR;
            PG8_LDA(At, 1, 1); PG8_STAGE(PG8_SA(1, 0), a3, voffA);
            PG8_BAR; PG8_WAIT_L(0); PG8_MMA(1, 0, At, B0); PG8_BAR; PG8_SCHED;
            PG8_STAGE(PG8_SB(1, 1), b3 + hstep, voffB);
            PG8_WAIT_V(6); PG8_BAR; PG8_MMA(1, 1, At, B1); PG8_BAR;
            }
        }
        if constexpr (ALIGN_EPI) { if (wr == 0) PG8_BAR; }
        if constexpr (!Epi::AFTER_DRAIN) { int l_; asm volatile("v_mbcnt_lo_u32_b32 %0, -1, 0\n\tv_mbcnt_hi_u32_b32 %0, -1, %0" : "=v"(l_)); E(acc, cur, wr, wc, l_ & 15, l_ >> 4); S.done(cur); }
        if (!has_next) break;
#pragma unroll
        for (int a = 0; a < 2; ++a)
#pragma unroll
            for (int b = 0; b < 2; ++b)
#pragma unroll
                for (int m = 0; m < 4; ++m)
#pragma unroll
                    for (int n = 0; n < 2; ++n) acc[a][b][m][n] = (f32x4){0.f, 0.f, 0.f, 0.f};
        cur = nxt; cA = nA; cA2 = nA2; cB = nB; ++ui;
        if constexpr (ALIGN_EPI) { if (wr == 1) PG8_BAR; }
    }
    PG8_WAIT_V(0);
    if constexpr (!ALIGN_EPI) { if (wr == 0) PG8_BAR; }
    PG8_BAR;
    if constexpr (Epi::AFTER_DRAIN) { E.fused(acc, cur, wr, wc, fr, fq, lds, wid, lane); S.done(cur); }
#undef PG8_SA
#undef PG8_SB
#undef PG8_STAGE
#undef PG8_LDA
#undef PG8_LDB
#undef PG8_MMA
#undef PG8_WAIT_V
#undef PG8_WAIT_L
#undef PG8_BAR
#undef PG8_SCHED
}
}

#ifndef PG8_SP2
#define PG8_SP2 true
#endif
#ifndef PG8_ALIGN
#define PG8_ALIGN true
#endif
#include <hip/hip_bf16.h>
#include <cmath>
namespace attn_body {
using bf16=__hip_bfloat16;
using bf16x8=__attribute__((ext_vector_type(8)))short;
using s16x4=__attribute__((ext_vector_type(4)))short;
using f32x16=__attribute__((ext_vector_type(16)))float;
using u32x4=__attribute__((ext_vector_type(4)))unsigned;
using f32x4v=__attribute__((ext_vector_type(4)))float;
constexpr int BATCH=2,NHEAD=8,SEQ=8192,D=64,DM=NHEAD*D;
constexpr int NW=8,QBLK=32,QB=QBLK*NW,KVBLK=64,NQB=SEQ/QB;
constexpr int ATTN_PITCH=DM, ATTN_UNIT_ROWS=QB;
__device__ __forceinline__ int crow(int r,int hi){return (r&3)+8*(r>>2)+4*hi;}
#define SBAR() __builtin_amdgcn_sched_barrier(0)
__device__ __forceinline__ void cmask(f32x16&p0,f32x16&p1,int jb,int qrel,int hi){
  const float NEG=-INFINITY; int kb=64*jb+4*hi;
  #pragma unroll
  for(int r=0;r<16;++r){int kv=kb+(r&3)+8*(r>>2); if(kv>qrel)p0[r]=NEG; if(kv+32>qrel)p1[r]=NEG;}
}

constexpr int NSLOT=3, SLOTB=8192;
constexpr int LDS_K=0, LDS_V=NSLOT*SLOTB, LDS_WS=2*NSLOT*SLOTB, LDS_OST=LDS_WS+NW*64*4, LDS_BIAS=LDS_OST+NW*4096, LDS_WT=LDS_BIAS+SEQ*4, LDS_BYTES=LDS_WT+64;
constexpr float C2=0.125f*1.4426950408889634f;
__device__ __forceinline__ void glds16(const void*gsrc,unsigned lds_dst){unsigned keep;
  asm volatile("s_mov_b32 %0, m0\n\ts_mov_b32 m0, %2\n\ts_nop 0\n\tglobal_load_lds_dwordx4 %1, off\n\ts_mov_b32 m0, %0":"=&s"(keep):"v"(gsrc),"s"(lds_dst):"memory");}
__device__ __forceinline__ float max3f(float a,float b,float c){float r;asm("v_max3_f32 %0, %1, %2, %3":"=v"(r):"v"(a),"v"(b),"v"(c));return r;}
__device__ __forceinline__ float max2f(float a,float b){float r;asm("v_max_f32_e32 %0, %1, %2":"=v"(r):"v"(a),"v"(b));return r;}
__device__ __forceinline__ float fadd_s(float a,float b){float r;asm("v_add_f32_e32 %0, %1, %2":"=v"(r):"v"(a),"v"(b));return r;}
__device__ __forceinline__ float fsub_s(float a,float b){float r;asm("v_sub_f32_e32 %0, %1, %2":"=v"(r):"v"(a),"v"(b));return r;}
typedef float f32x2_t __attribute__((ext_vector_type(2))); typedef __bf16 bf16x2_t __attribute__((ext_vector_type(2)));
__device__ __forceinline__ unsigned cvtpk_s(float lo,float hi){f32x2_t v={lo,hi};bf16x2_t b=__builtin_convertvector(v,bf16x2_t);return __builtin_bit_cast(unsigned,b);}
#define WAIT_BAR(N) asm volatile("s_waitcnt vmcnt(" #N ") lgkmcnt(0)\n\ts_barrier":::"memory")

__device__ __forceinline__ void qkt(f32x16&p0,f32x16&p1,const char*Kslot,const bf16x8*qr,int r32,int hi){
  const char*kb=Kslot+hi*1024+r32*16;
  #pragma unroll
  for(int d0=0;d0<4;++d0){
    const bf16x8 b0=*reinterpret_cast<const bf16x8*>(kb+d0*2048);
    const bf16x8 b1=*reinterpret_cast<const bf16x8*>(kb+d0*2048+512);
    p0=__builtin_amdgcn_mfma_f32_32x32x16_bf16(b0,qr[d0],p0,0,0,0);p1=__builtin_amdgcn_mfma_f32_32x32x16_bf16(b1,qr[d0],p1,0,0,0);}
}
typedef __attribute__((address_space(3))) const char* lds_cptr;
typedef short v4i16_t __attribute__((ext_vector_type(4)));
__device__ __forceinline__ void kload8(bf16x8*kf,lds_cptr kp){
  kf[0]=*(const __attribute__((address_space(3))) bf16x8*)(kp);      kf[1]=*(const __attribute__((address_space(3))) bf16x8*)(kp+512);
  kf[2]=*(const __attribute__((address_space(3))) bf16x8*)(kp+2048); kf[3]=*(const __attribute__((address_space(3))) bf16x8*)(kp+2560);
  kf[4]=*(const __attribute__((address_space(3))) bf16x8*)(kp+4096); kf[5]=*(const __attribute__((address_space(3))) bf16x8*)(kp+4608);
  kf[6]=*(const __attribute__((address_space(3))) bf16x8*)(kp+6144); kf[7]=*(const __attribute__((address_space(3))) bf16x8*)(kp+6656);
}
__device__ __forceinline__ void kload2(bf16x8*kf,lds_cptr kp,int j){ kf[2*j]=*(const __attribute__((address_space(3))) bf16x8*)(kp+j*2048); kf[2*j+1]=*(const __attribute__((address_space(3))) bf16x8*)(kp+j*2048+512); }
__device__ __forceinline__ s16x4 vtr(lds_cptr p){ return __builtin_bit_cast(s16x4,__builtin_amdgcn_ds_read_tr16_b64_v4i16((__attribute__((address_space(3))) v4i16_t*)p)); }
__device__ __forceinline__ float rowmax(const f32x16&p0,const f32x16&p1){
  float a=max3f(p0[0],p0[1],p1[0]),b=max3f(p0[2],p0[3],p1[1]);a=max3f(a,p1[2],p1[3]);
  #pragma unroll
  for(int r=4;r<16;r+=4){a=max3f(a,p0[r],p0[r+1]);b=max3f(b,p0[r+2],p0[r+3]);a=max3f(a,p1[r],p1[r+1]);b=max3f(b,p1[r+2],p1[r+3]);}
  const float m=max2f(a,b);
  auto rr=__builtin_amdgcn_permlane32_swap(__float_as_uint(m),__float_as_uint(m),false,false);
  return max2f(__uint_as_float(rr[0]),__uint_as_float(rr[1]));
}
__device__ __forceinline__ void pv(f32x16*o,int vb,bf16x8 pa0,bf16x8 pa1,bf16x8 pa2,bf16x8 pa3){
  #pragma unroll
  for(int d0=0;d0<2;++d0){s16x4 lo[4],hi[4];
    #pragma unroll
    for(int ks=0;ks<4;++ks){
      asm volatile("ds_read_b64_tr_b16 %0,%1 offset:%c2":"=&v"(lo[ks]):"v"(vb),"i"(d0*4096+ks*1024):"memory");
      asm volatile("ds_read_b64_tr_b16 %0,%1 offset:%c2":"=&v"(hi[ks]):"v"(vb),"i"(d0*4096+ks*1024+512):"memory");}
    asm volatile("s_waitcnt lgkmcnt(0)":::"memory");SBAR();
    #define PK(k) (bf16x8){lo[k][0],lo[k][1],lo[k][2],lo[k][3],hi[k][0],hi[k][1],hi[k][2],hi[k][3]}
    o[d0]=__builtin_amdgcn_mfma_f32_32x32x16_bf16(pa0,PK(0),o[d0],0,0,0);
    o[d0]=__builtin_amdgcn_mfma_f32_32x32x16_bf16(pa1,PK(1),o[d0],0,0,0);
    o[d0]=__builtin_amdgcn_mfma_f32_32x32x16_bf16(pa2,PK(2),o[d0],0,0,0);
    o[d0]=__builtin_amdgcn_mfma_f32_32x32x16_bf16(pa3,PK(3),o[d0],0,0,0);
    #undef PK
  }
}

#ifndef ATTN_STORE16
#define ATTN_STORE16(p,v) (*(u32x4*)(p)=(v))
#endif
template<int THRL> __device__ __forceinline__ void attn_unit(int b,int h,int qb,int tb_in,int te,int mode,float*__restrict__ part,unsigned*pcnt,const unsigned*kmaxp,const bf16*Q,const bf16*__restrict__ K,const bf16*__restrict__ V,bf16*O,const float*__restrict__ logf,float*__restrict__ ssqA,char*shm,int tid_in){
  int tid_=tid_in; asm volatile("":"+v"(tid_)); const int tid=tid_,lane=tid&63,r32=lane&31,hi=lane>>5; const int wid=__builtin_amdgcn_readfirstlane(tid>>6);
  const long rowbase=(long)b*SEQ; const int q0=qb*QB;
  const bf16*Qw=Q+(rowbase+q0+wid*QBLK)*DM+h*D;
  const lds_cptr shm3=(lds_cptr)shm;
  typedef __attribute__((address_space(3))) float* lds_fptr; typedef __attribute__((address_space(3))) f32x4v* lds_f4ptr;
  const lds_fptr biasL=(lds_fptr)(shm3+LDS_BIAS); const lds_fptr wtot=(lds_fptr)(shm3+LDS_WT);
  bf16x8 qr[4];
  #pragma unroll
  for(int d0=0;d0<4;++d0)qr[d0]=*reinterpret_cast<const bf16x8*>(&Qw[(long)r32*DM+d0*16+hi*8]);
  float qn=0.f;
  #pragma unroll
  for(int d0=0;d0<4;++d0){
    #pragma unroll
    for(int e=0;e<8;++e){const float qv=__uint_as_float(((unsigned)(unsigned short)qr[d0][e])<<16);qn+=qv*qv;}}
  qn=sum32(qn);
  qn=__builtin_fmaxf(qn,sx<1>(qn));qn=__builtin_fmaxf(qn,sx<2>(qn));qn=__builtin_fmaxf(qn,sx<4>(qn));qn=__builtin_fmaxf(qn,sx<8>(qn));qn=__builtin_fmaxf(qn,sx<16>(qn));
  { const int nkeys=q0+QB; const int k0=tid*16; const float*lf=logf+(long)(b*NHEAD+h)*SEQ+k0;
    f32x4v v0={0.f,0.f,0.f,0.f},v1=v0,v2=v0,v3=v0;
    if(k0<nkeys){v0=*(const f32x4v*)(lf);v1=*(const f32x4v*)(lf+4);v2=*(const f32x4v*)(lf+8);v3=*(const f32x4v*)(lf+12);}
    const float tot=((v0[0]+v0[1])+(v0[2]+v0[3]))+((v1[0]+v1[1])+(v1[2]+v1[3]))+((v2[0]+v2[1])+(v2[2]+v2[3]))+((v3[0]+v3[1])+(v3[2]+v3[3]));
    float x=tot;
    #pragma unroll
    for(int off=1;off<64;off<<=1){const float y=__builtin_bit_cast(float,__builtin_amdgcn_ds_bpermute(((lane+off)&63)<<2,__builtin_bit_cast(int,x)));if(lane+off<64)x+=y;}
    if(lane==0){wtot[wid]=x;wtot[8+wid]=qn;}
    __syncthreads();
    float wsum=0.f;
    #pragma unroll
    for(int w=1;w<NW;++w){const float t_=wtot[w];if(w>wid)wsum+=t_;}
    float run=(x-tot)+wsum;
    if(k0<nkeys){ const float L2E=1.4426950408889634f; f32x4v o0,o1,o2,o3;
      o3[3]=run*L2E;run+=v3[3];o3[2]=run*L2E;run+=v3[2];o3[1]=run*L2E;run+=v3[1];o3[0]=run*L2E;run+=v3[0];
      o2[3]=run*L2E;run+=v2[3];o2[2]=run*L2E;run+=v2[2];o2[1]=run*L2E;run+=v2[1];o2[0]=run*L2E;run+=v2[0];
      o1[3]=run*L2E;run+=v1[3];o1[2]=run*L2E;run+=v1[2];o1[1]=run*L2E;run+=v1[1];o1[0]=run*L2E;run+=v1[0];
      o0[3]=run*L2E;run+=v0[3];o0[2]=run*L2E;run+=v0[2];o0[1]=run*L2E;run+=v0[1];o0[0]=run*L2E;
      lds_f4ptr bo=(lds_f4ptr)(biasL+k0); bo[0]=o0;bo[1]=o1;bo[2]=o2;bo[3]=o3; }
    __syncthreads(); }
  int tb=tb_in; bool emptyA=false;
  { float qmx=wtot[8];
    #pragma unroll
    for(int w=1;w<NW;++w)qmx=__builtin_fmaxf(qmx,wtot[8+w]);
    const float kmx=__uint_as_float(__hip_atomic_load(kmaxp,__ATOMIC_RELAXED,__HIP_MEMORY_SCOPE_AGENT))+__uint_as_float(__hip_atomic_load(kmaxp+1,__ATOMIC_RELAXED,__HIP_MEMORY_SCOPE_AGENT));
    const float Bq=__builtin_sqrtf(qmx*kmx)*1.02f;   const float thr=biasL[q0]-150.f-2.f*Bq;
    const int ntf=(q0+QB)/KVBLK; const int skipf=(tid<ntf)?(biasL[KVBLK*tid+KVBLK-1]<thr?1:0):0;
    const unsigned long long bal=__ballot(skipf);
    __syncthreads();
    if(lane==0&&wid<2)wtot[wid]=(float)__popcll(bal);
    __syncthreads();
    int t0=((int)wtot[0]+(int)wtot[1])&~1; emptyA=(mode==1&&t0>=te); if(t0>te-4)t0=te-4; if(t0>tb)tb=t0;
    __syncthreads(); }
  if(!emptyA){
  const bf16*Kh=K+(rowbase+(long)tb*KVBLK)*DM+h*D,*Vh=V+(rowbase+(long)tb*KVBLK)*DM+h*D;
  const unsigned lds0=(unsigned)(uintptr_t)shm;
  float*wsf=(float*)(shm+LDS_WS)+wid*64;
  const bf16*ksrc=Kh+(long)lane*DM+wid*8;
  const bf16*vsrc=Vh+(long)(16*(wid&3)+(lane>>2))*DM+(wid>>2)*32+(lane&3)*8;
  const unsigned kdst=lds0+LDS_K+wid*1024, vdst=lds0+LDS_V+wid*1024;
  #define DMA_K(t,slot) glds16(ksrc+(long)(t)*KVBLK*DM,(unsigned)__builtin_amdgcn_readfirstlane(kdst+(slot)))
  #define DMA_V(t,slot) glds16(vsrc+(long)(t)*KVBLK*DM,(unsigned)__builtin_amdgcn_readfirstlane(vdst+(slot)))
  const int vb0=(int)(lds0+LDS_V)+((lane>>4)&1)*32+(lane&3)*8+(4*hi+((lane&15)>>2))*64;
  const char*Kbase=shm+LDS_K; bf16x8 kf[8];
  const lds_cptr kp0=shm3+LDS_K+hi*1024+r32*16; const lds_cptr vp0=shm3+LDS_V+((lane>>4)&1)*32+(lane&3)*8+(4*hi+((lane&15)>>2))*64;
  const int NT=te-tb;
  const lds_fptr biasp=biasL+4*hi+tb*KVBLK;
  #define BLD(X0,X1,tt) do{ const lds_fptr bp_=biasp+(tt)*KVBLK; \
    _Pragma("unroll") for(int j_=0;j_<4;++j_){ const f32x4v a_=*(const lds_f4ptr)(bp_+8*j_); const f32x4v b_=*(const lds_f4ptr)(bp_+32+8*j_); \
      X0[4*j_]=a_[0];X0[4*j_+1]=a_[1];X0[4*j_+2]=a_[2];X0[4*j_+3]=a_[3]; X1[4*j_]=b_[0];X1[4*j_+1]=b_[1];X1[4*j_+2]=b_[2];X1[4*j_+3]=b_[3]; } }while(0)
  #define BSUB(X,B) do{ const f32x2_t mh2_={mhat,mhat}; _Pragma("unroll") for(int r_=(B);r_<(B)+8;r_+=2){ f32x2_t t_={X[r_],X[r_+1]}; t_=t_-mh2_; X[r_]=t_.x; X[r_+1]=t_.y; } }while(0)
  DMA_K(0,0);DMA_V(0,0);DMA_K(1,SLOTB);
  float mhat=0.f,l_reg=0.f;f32x16 o[2];o[0]=f32x16{};o[1]=f32x16{};
  const int qrel=wid*QBLK+r32;
  #define CMASK(P0,P1,t) do{int jb_=(t)-(NT-4); if(jb_>=0&&mode!=1)cmask(P0,P1,jb_,qrel,hi);}while(0)
  bool resc=false;
  #define START(P0,P1) do{ const float rm=rowmax(P0,P1); resc=false; \
    { const float dl=rm; mhat=fadd_s(mhat,dl); \
      _Pragma("unroll") for(int r=0;r<16;++r){P0[r]=fsub_s(P0[r],dl);P1[r]=fsub_s(P1[r],dl);} } \
    _Pragma("unroll") for(int r=0;r<16;++r)P0[r]=__builtin_amdgcn_exp2f(P0[r]); }while(0)
  #define RESC() do{ if(resc){ asm volatile("s_waitcnt lgkmcnt(0)":::"memory"); \
      _Pragma("unroll") for(int d_=0;d_<2;++d_) _Pragma("unroll") for(int r=0;r<16;++r)o[d_][r]*=wsf[crow(r,hi)]; } }while(0)
  f32x16 pA0,pA1,pB0,pB1;
  int sl_prev=0,sl_cur=0,sl_next=SLOTB;
  #define ROT() do{sl_prev=sl_cur;sl_cur=sl_next;sl_next=(sl_next==(NSLOT-1)*SLOTB)?0:sl_next+SLOTB;}while(0)
  DMA_K(2,2*SLOTB);
  WAIT_BAR(3);
  BLD(pA0,pA1,0);
  qkt(pA0,pA1,Kbase,qr,r32,hi);asm volatile("s_nop 15\n\ts_nop 7":"+v"(pA0),"+v"(pA1));CMASK(pA0,pA1,0);
  START(pA0,pA1);
  _Pragma("unroll") for(int r=0;r<16;++r)pA1[r]=__builtin_amdgcn_exp2f(pA1[r]);
  BLD(pB0,pB1,1); BSUB(pB0,0); BSUB(pB0,8); BSUB(pB1,0); BSUB(pB1,8);
  WAIT_BAR(0);
  DMA_K(3,0);DMA_V(1,SLOTB);
  ROT();
  kload8(kf,kp0+sl_cur);
  WAIT_BAR(2);
  s16x4 vlo[8],vhi[8]; u32x4 pw0,pw1,pw2,pw3;
  #define PKW(P,B) cvtpk_s(P[B],P[B+1])
  #define PAF(k) __builtin_bit_cast(bf16x8,pw##k)
  #define VFR(i) (bf16x8){vlo[i][0],vlo[i][1],vlo[i][2],vlo[i][3],vhi[i][0],vhi[i][1],vhi[i][2],vhi[i][3]}
  #define PIN(x) asm volatile("":"+v"(x))
  #define MX3(a,b,c) __builtin_fmaxf(__builtin_fmaxf((a),(b)),(c))
  #define GAPA(MF,A0,A1,A2,A3,W0,W1,PW) do{ MF; sacc+=A0; sacc+=A1; sacc+=A2; sacc+=A3; PIN(sacc); W0; W1; PIN(PW); SBAR(); }while(0)
  #define EX(v) __builtin_amdgcn_exp2f(v)
  #define GAPB(MF,X,B) do{ MF; X[B]=EX(X[B]); X[B+1]=EX(X[B+1]); X[B+2]=EX(X[B+2]); X[B+3]=EX(X[B+3]); PIN(X); SBAR(); }while(0)
  #define VRD(i) do{ vlo[i]=vtr(vp_+(((i)>>2)*4096+((i)&3)*1024)); vhi[i]=vtr(vp_+(((i)>>2)*4096+((i)&3)*1024+512)); }while(0)
  #define KRD(G,j) do{ if(G){ kload2(kf,kp0+sl_next,j); SBAR(); } }while(0)
  #define STEP(C0,C1,P0,P1,t,GK,GV,GL) do{ SBAR(); \
    const lds_cptr vp_=vp0+sl_prev; \
    VRD(0); SBAR(); float sacc=(P0[0]+P0[1]); \
    GAPA(C0=__builtin_amdgcn_mfma_f32_32x32x16_bf16(kf[0],qr[0],C0,0,0,0), P0[2],P0[3],P0[4],P0[5],     pw0[0]=PKW(P0,0), pw0[1]=PKW(P0,2), pw0); \
    VRD(4); SBAR(); GAPA(C1=__builtin_amdgcn_mfma_f32_32x32x16_bf16(kf[1],qr[0],C1,0,0,0), P0[6],P0[7],P0[8],P0[9],     pw0[2]=PKW(P0,4), pw0[3]=PKW(P0,6), pw0); \
    VRD(1); SBAR(); GAPA(C0=__builtin_amdgcn_mfma_f32_32x32x16_bf16(kf[2],qr[1],C0,0,0,0),   P0[10],P0[11],P0[12],P0[13], pw1[0]=PKW(P0,8), pw1[1]=PKW(P0,10), pw1); \
    VRD(5); SBAR(); GAPA(C1=__builtin_amdgcn_mfma_f32_32x32x16_bf16(kf[3],qr[1],C1,0,0,0),   P0[14],P0[15],P1[0],P1[1],   pw1[2]=PKW(P0,12),pw1[3]=PKW(P0,14), pw1); \
    VRD(2); SBAR(); GAPA(C0=__builtin_amdgcn_mfma_f32_32x32x16_bf16(kf[4],qr[2],C0,0,0,0),   P1[2],P1[3],P1[4],P1[5],     pw2[0]=PKW(P1,0), pw2[1]=PKW(P1,2), pw2); \
    VRD(6); SBAR(); GAPA(C1=__builtin_amdgcn_mfma_f32_32x32x16_bf16(kf[5],qr[2],C1,0,0,0),   P1[6],P1[7],P1[8],P1[9],     pw2[2]=PKW(P1,4), pw2[3]=PKW(P1,6), pw2); \
    VRD(3); SBAR(); GAPA(C0=__builtin_amdgcn_mfma_f32_32x32x16_bf16(kf[6],qr[3],C0,0,0,0),   P1[10],P1[11],P1[12],P1[13], pw3[0]=PKW(P1,8), pw3[1]=PKW(P1,10), pw3); \
    VRD(7); SBAR(); GAPA(C1=__builtin_amdgcn_mfma_f32_32x32x16_bf16(kf[7],qr[3],C1,0,0,0),   P1[14],P1[15],0.f,0.f,       pw3[2]=PKW(P1,12),pw3[3]=PKW(P1,14), pw3); \
    l_reg+=sacc; \
    if(GK){DMA_K((t)+3,sl_cur);} if(GV){DMA_V((t)+1,sl_next);} \
    CMASK(C0,C1,t); \
    { float a=MX3(C0[0],C0[1],C1[0]),b=MX3(C0[2],C0[3],C1[1]); a=MX3(a,C1[2],C1[3]); \
      _Pragma("unroll") for(int r=4;r<16;r+=4){a=MX3(a,C0[r],C0[r+1]);b=MX3(b,C0[r+2],C0[r+3]);a=MX3(a,C1[r],C1[r+1]);b=MX3(b,C1[r+2],C1[r+3]);} \
      float rm=__builtin_fmaxf(a,b); { auto rr=__builtin_amdgcn_permlane32_swap(__float_as_uint(rm),__float_as_uint(rm),false,false); rm=__builtin_fmaxf(__uint_as_float(rr[0]),__uint_as_float(rr[1])); } \
      resc=false; \
      if(__builtin_expect(__any(rm>(float)THRL),0)){ const float dl=__builtin_fmaxf(rm,0.f); mhat+=dl; \
        _Pragma("unroll") for(int r=0;r<16;++r){C0[r]-=dl;C1[r]-=dl;} \
        const float f=__builtin_amdgcn_exp2f(-dl); l_reg*=f; if(hi==0)wsf[r32]=f; resc=true; } } \
    SBAR(); \
    if(GL){ BLD(P0,P1,(t)+1); SBAR(); } \
    GAPB(o[0]=__builtin_amdgcn_mfma_f32_32x32x16_bf16(PAF(0),VFR(0),o[0],0,0,0), C0,0); \
    GAPB(o[1]=__builtin_amdgcn_mfma_f32_32x32x16_bf16(PAF(0),VFR(4),o[1],0,0,0), C0,4); \
    KRD(GL,0); GAPB(o[0]=__builtin_amdgcn_mfma_f32_32x32x16_bf16(PAF(1),VFR(1),o[0],0,0,0), C0,8); \
    KRD(GL,1); GAPB(o[1]=__builtin_amdgcn_mfma_f32_32x32x16_bf16(PAF(1),VFR(5),o[1],0,0,0), C0,12); \
    KRD(GL,2); if(GL){BSUB(P0,0);} GAPB(o[0]=__builtin_amdgcn_mfma_f32_32x32x16_bf16(PAF(2),VFR(2),o[0],0,0,0), C1,0); \
    KRD(GL,3); if(GL){BSUB(P0,8);} GAPB(o[1]=__builtin_amdgcn_mfma_f32_32x32x16_bf16(PAF(2),VFR(6),o[1],0,0,0), C1,4); \
    if(GL){BSUB(P1,0);} GAPB(o[0]=__builtin_amdgcn_mfma_f32_32x32x16_bf16(PAF(3),VFR(3),o[0],0,0,0), C1,8); \
    if(GL){BSUB(P1,8);} GAPB(o[1]=__builtin_amdgcn_mfma_f32_32x32x16_bf16(PAF(3),VFR(7),o[1],0,0,0), C1,12); \
    }while(0)
  int t=1;
  #undef CMASK
  #define CMASK(P0,P1,t) do{}while(0)
  for(;t+5<NT;t+=2){
    STEP(pB0,pB1,pA0,pA1,t,true,true,true);     WAIT_BAR(2); RESC(); ROT();
    STEP(pA0,pA1,pB0,pB1,t+1,true,true,true);   WAIT_BAR(2); RESC(); ROT();
  }
  #undef CMASK
  #define CMASK(P0,P1,t) do{int jb_=(t)-(NT-4); if(jb_>=0&&mode!=1)cmask(P0,P1,jb_,qrel,hi);}while(0)
  #define ENDW(tt) do{ if((tt)+3<NT){WAIT_BAR(2);} else if((tt)+2<NT){WAIT_BAR(1);} else {WAIT_BAR(0);} }while(0)
  for(;t+1<NT;t+=2){
    STEP(pB0,pB1,pA0,pA1,t,(t+3<NT),(t+1<NT),(t+1<NT));       ENDW(t);   RESC(); ROT();
    STEP(pA0,pA1,pB0,pB1,t+1,(t+4<NT),(t+2<NT),(t+2<NT));     ENDW(t+1); RESC(); ROT();
  }
  STEP(pB0,pB1,pA0,pA1,NT-1,false,false,false); RESC();
  { float sacc=pB0[0]+pB0[1]; _Pragma("unroll") for(int r=2;r<16;++r)sacc+=pB0[r]; _Pragma("unroll") for(int r=0;r<16;++r)sacc+=pB1[r]; l_reg+=sacc;
    pw0=(u32x4){PKW(pB0,0),PKW(pB0,2),PKW(pB0,4),PKW(pB0,6)};pw1=(u32x4){PKW(pB0,8),PKW(pB0,10),PKW(pB0,12),PKW(pB0,14)};pw2=(u32x4){PKW(pB1,0),PKW(pB1,2),PKW(pB1,4),PKW(pB1,6)};pw3=(u32x4){PKW(pB1,8),PKW(pB1,10),PKW(pB1,12),PKW(pB1,14)};
    SBAR(); pv(o,vb0+sl_cur,PAF(0),PAF(1),PAF(2),PAF(3)); }
  #undef PKW
  #undef PAF
  #undef VFR
  #undef PIN
  #undef MX3
  #undef GAPA
  #undef GAPB
  #undef EX
  #undef VRD
  #undef KRD
  #undef STEP
  #undef ENDW
  {auto rr=__builtin_amdgcn_permlane32_swap(__float_as_uint(l_reg),__float_as_uint(l_reg),false,false);l_reg=__uint_as_float(rr[0])+__uint_as_float(rr[1]);}
  if(mode==0){
  if(hi==0)wsf[32+r32]=l_reg;asm volatile("s_waitcnt lgkmcnt(0)":::"memory");
  float rli[16];
  #pragma unroll
  for(int r=0;r<16;++r)rli[r]=__builtin_amdgcn_rcpf(wsf[32+crow(r,hi)]);
  bf16*Ow=O+(rowbase+q0+wid*QBLK)*DM+h*D;
  { bf16*stg=(bf16*)(shm+LDS_OST)+wid*2048;
    #pragma unroll
    for(int r=0;r<16;++r){const int orow=crow(r,hi);
      #pragma unroll
      for(int d0=0;d0<2;++d0)stg[orow*64+d0*32+r32]=__float2bfloat16(o[d0][r]*rli[r]);}
    asm volatile("s_waitcnt lgkmcnt(0)":::"memory");
    #pragma unroll
    for(int i=0;i<4;++i){const int row=i*8+(lane>>3),ch=lane&7; const u32x4 v=*(const u32x4*)(stg+row*64+ch*8); ATTN_STORE16(Ow+(long)row*DM+ch*8,v);
      float ss=0.f;
      #pragma unroll
      for(int e=0;e<4;++e){const float lo_=__uint_as_float(v[e]<<16),hi_=__uint_as_float(v[e]&0xffff0000u);ss+=lo_*lo_+hi_*hi_;}
      ss+=sx<1>(ss);ss+=sx<2>(ss);ss+=sx<4>(ss);
      if(ch==0)ssqA[(rowbase+q0+wid*QBLK+row)*NHEAD+h]=ss;} }
  } else {
    float*PO=part+(long)(mode-1)*QB*D+(long)(wid*QBLK)*D;
    #pragma unroll
    for(int r=0;r<16;++r){const int orow=crow(r,hi);
      #pragma unroll
      for(int d0=0;d0<2;++d0)__hip_atomic_store(PO+orow*D+d0*32+r32,o[d0][r],__ATOMIC_RELAXED,__HIP_MEMORY_SCOPE_AGENT);}
    if(hi==0){ float*PM=part+2*QB*D+(mode-1)*QB+wid*QBLK; __hip_atomic_store(PM+r32,mhat,__ATOMIC_RELAXED,__HIP_MEMORY_SCOPE_AGENT); __hip_atomic_store(PM+2*QB+r32,l_reg,__ATOMIC_RELAXED,__HIP_MEMORY_SCOPE_AGENT); }
  }
  asm volatile("s_waitcnt lgkmcnt(0)\n\ts_barrier":::"memory");
  } else if(tid<QB){ float*PM=part+2*QB*D; __hip_atomic_store(PM+tid,-1e30f,__ATOMIC_RELAXED,__HIP_MEMORY_SCOPE_AGENT); __hip_atomic_store(PM+2*QB+tid,0.f,__ATOMIC_RELAXED,__HIP_MEMORY_SCOPE_AGENT); }
  if(mode!=0){
    asm volatile("s_waitcnt vmcnt(0)":::"memory"); __syncthreads();
    if(tid==0){
      const unsigned old=__hip_atomic_fetch_add(pcnt,1u,__ATOMIC_RELAXED,__HIP_MEMORY_SCOPE_AGENT);
      if(old==1u){ __builtin_amdgcn_fence(__ATOMIC_ACQUIRE,"agent"); asm volatile("s_waitcnt vmcnt(0)":::"memory"); }
      wtot[0]=(old==1u)?1.f:0.f; }
    __syncthreads();
    const bool merger=wtot[0]!=0.f;
    __syncthreads();
    if(merger){ const int row=tid>>1,ch=tid&1; const float*PA=part+(long)row*D+ch*32,*PB=PA+(long)QB*D; const float*PM=part+2*QB*D;
      const float MA=PM[row],MB=PM[QB+row],LA=PM[2*QB+row],LB=PM[3*QB+row]; const float m=__builtin_fmaxf(MA,MB);
      const bool ua=LA>0.f,ub=LB>0.f; const float wA=ua?__builtin_amdgcn_exp2f(MA-m):0.f,wB=ub?__builtin_amdgcn_exp2f(MB-m):0.f; const float inv=__builtin_amdgcn_rcpf(LA*wA+LB*wB); const float cA=wA*inv,cB=wB*inv;
      bf16*Om=O+(rowbase+q0+row)*DM+h*D+ch*32; float ss=0.f;
      #pragma unroll
      for(int i=0;i<4;++i){ const f32x4v z4={0.f,0.f,0.f,0.f}; const f32x4v a0=ua?*(const f32x4v*)(PA+8*i):z4,a1=ua?*(const f32x4v*)(PA+8*i+4):z4,b0=ub?*(const f32x4v*)(PB+8*i):z4,b1=ub?*(const f32x4v*)(PB+8*i+4):z4;
        u32x4 w; w[0]=cvtpk_s(a0[0]*cA+b0[0]*cB,a0[1]*cA+b0[1]*cB); w[1]=cvtpk_s(a0[2]*cA+b0[2]*cB,a0[3]*cA+b0[3]*cB); w[2]=cvtpk_s(a1[0]*cA+b1[0]*cB,a1[1]*cA+b1[1]*cB); w[3]=cvtpk_s(a1[2]*cA+b1[2]*cB,a1[3]*cA+b1[3]*cB);
        ATTN_STORE16(Om+8*i,w);
        #pragma unroll
        for(int e=0;e<4;++e){const float lo_=__uint_as_float(w[e]<<16),hi_=__uint_as_float(w[e]&0xffff0000u);ss+=lo_*lo_+hi_*hi_;} }
      ss+=sx<1>(ss);
      if(ch==0)ssqA[(rowbase+q0+row)*NHEAD+h]=ss; }
  }
  #undef DMA_K
  #undef DMA_V
  #undef BLD
  #undef BSUB
  #undef CMASK
  #undef START
  #undef RESC
  #undef ROT
}
constexpr int ATTN_LDS_BYTES=LDS_BYTES;
#undef SBAR
#undef WAIT_BAR
}
#define LAS __attribute__((address_space(3)))
#define GAS __attribute__((address_space(1)))
using pg8::f32x4; using pg8::u32x4; using pg8::bf16_t; using pg8::bf16x8; using pg8::Unit; using pg8::BM; using pg8::HALF;
typedef unsigned u32x2 __attribute__((ext_vector_type(2)));
constexpr int TOK = 16384, DMODEL = 1024, DFF = 2816, HW = 512, SEQL = 8192, PLE = 256, NGRP = 32;
constexpr float L2E = 1.4426950408889634f;
constexpr float QSCALE = 0.125f * L2E;
constexpr size_t MiB = 1u << 20;
constexpr size_t WS_CTL = 0, WS_AP = 1 * MiB, WS_BB = WS_AP + 512 * 1024, WS_KTAB = 2 * MiB, WS_PEND = 3 * MiB, WS_CC = 5 * MiB, WS_WF = 7 * MiB, WS_LOGF = 8 * MiB;
constexpr size_t WS_SSQ0 = 9 * MiB, WS_SSQ1 = 10 * MiB, WS_SSQ2 = 11 * MiB, WS_SSQ3 = 12 * MiB, WS_SSQ4 = 13 * MiB, WS_SSQA = 14 * MiB, WS_SSQS = 14 * MiB + 512 * 1024;
constexpr size_t WS_W13A = 16 * MiB, WS_W2A = 27 * MiB, WS_WIN = 33 * MiB, WS_WGLU = 37 * MiB, WS_WOA = 38 * MiB, WS_WOS = 39 * MiB, WS_W13B = 40 * MiB, WS_W2B = 51 * MiB, WS_WG = 57 * MiB, WS_WP = 59 * MiB;
constexpr size_t PARTF = 2 * 256 * 64 + 4 * 256;
static_assert(60 * PARTF * 4 <= 8 * MiB && 45 * PARTF * 4 <= 6 * MiB && 151 * PARTF * 4 <= 20 * MiB, "partial record chunks");
constexpr size_t WS_PART_UNUSED = 188 * MiB;
constexpr size_t WS_PB = 60 * MiB, WS_XB = 68 * MiB, WS_H1 = 100 * MiB;
constexpr size_t WS_Q = 100 * MiB, WS_K = 116 * MiB, WS_V = 132 * MiB, WS_U = 148 * MiB, WS_Y = 164 * MiB, WS_SSMO = 188 * MiB, WS_PP = 204 * MiB, WS_END = 256 * MiB;
static_assert(WS_K == WS_Q + 16 * MiB && WS_V == WS_Q + 32 * MiB, "EpiQKVU pointer arithmetic");
constexpr int RING_BYTES = 131072, LDS_BYTES = 147456, MISC_OFF = LDS_BYTES - 256;

__device__ __forceinline__ float sigm(float w) { return __builtin_amdgcn_rcpf(1.f + __builtin_amdgcn_exp2f(-L2E * w)); }
__device__ __forceinline__ unsigned pkbf(float lo, float hi) { return pg8::cvt_pk_bf16(lo, hi); }
__device__ __forceinline__ float bflo(unsigned w) { return __uint_as_float(w << 16); }
__device__ __forceinline__ float bfhi(unsigned w) { return __uint_as_float(w & 0xffff0000u); }
template <int NP> __device__ __forceinline__ float rstd_row(const float* ssq, int row, float invn) {
    const f32x4* p = (const f32x4*)(ssq + (size_t)row * NP); float s = 0.f;
#pragma unroll
    for (int i = 0; i < NP / 4; ++i) { const f32x4 v = p[i]; s += (v[0] + v[1]) + (v[2] + v[3]); }
    return __builtin_amdgcn_rsqf(s * invn + 1e-6f);
}
template <int NP> __device__ __forceinline__ void rstd8(const float* ssq, int pm, int wr, int fr, int fq, float invn, float (&rs)[2][4]) {
    int lrow = pm * BM + wr * 64 + fq * 16 + fr; asm volatile("" : "+v"(lrow));
    const float r0 = rstd_row<NP>(ssq, lrow, invn), r1 = rstd_row<NP>(ssq, lrow + HALF, invn);
#pragma unroll
    for (int m = 0; m < 4; ++m) { rs[0][m] = __builtin_bit_cast(float, __builtin_amdgcn_ds_bpermute((16 * m + fr) << 2, __builtin_bit_cast(int, r0))); rs[1][m] = __builtin_bit_cast(float, __builtin_amdgcn_ds_bpermute((16 * m + fr) << 2, __builtin_bit_cast(int, r1))); }
}
__device__ __forceinline__ float wave_sum(float v) {
    v += sx<1>(v); v += sx<2>(v); v += sx<4>(v); v += sx<8>(v); v += sx<16>(v); v = sum32(v);
    return v;
}

struct EpiSwiglu {
    static constexpr bool PERM = true, AFTER_DRAIN = false, MIDK = false;
    bf16_t* O; const float* ssq;
    __device__ __forceinline__ void operator()(const f32x4 (&acc)[2][2][4][2], const Unit& u, int wr, int wc, int fr, int fq) const {
        int row0 = u.pm * BM + wr * 64 + fr, col0 = u.pn * 128 + wc * 32 + 8 * fq; asm volatile("" : "+v"(row0));
        float rs8[2][4]; rstd8<16>(ssq, u.pm, wr, fr, fq, 1.f / 1024.f, rs8);
#pragma unroll
        for (int ai = 0; ai < 2; ++ai)
#pragma unroll
            for (int m = 0; m < 4; ++m) { asm volatile("" ::: "memory"); const int row = row0 + ai * HALF + m * 16; const float rs = rs8[ai][m];
                const f32x4 a0 = acc[ai][0][m][0] * rs, a1 = acc[ai][0][m][1] * rs, b0 = acc[ai][1][m][0] * rs, b1 = acc[ai][1][m][1] * rs; f32x4 h0, h1;
#pragma unroll
                for (int e = 0; e < 4; ++e) { h0[e] = a0[e] * sigm(a0[e]) * b0[e]; h1[e] = a1[e] * sigm(a1[e]) * b1[e]; }
                u32x4 w; w.x = pkbf(h0[0], h0[1]); w.y = pkbf(h0[2], h0[3]); w.z = pkbf(h1[0], h1[1]); w.w = pkbf(h1[2], h1[3]);
                *(u32x4*)(O + (size_t)row * DFF + col0) = w; }
    }
};
template <bool NORM, bool BASEB> struct EpiRes {
    static constexpr bool PERM = true, AFTER_DRAIN = false, MIDK = false;
    const float* basef; bf16_t* xb; float* ssqo; const float* ssqi; float coef;
    __device__ __forceinline__ void operator()(const f32x4 (&acc)[2][2][4][2], const Unit& u, int wr, int wc, int fr, int fq) const {
        int row0 = u.pm * BM + wr * 64 + fr, col0 = u.pn * BM + wc * 32 + 8 * fq; asm volatile("" : "+v"(row0));
        float rs8[2][4]; if (NORM) rstd8<8>(ssqi, u.pm, wr, fr, fq, 1.f / 512.f, rs8);
#pragma unroll
        for (int ai = 0; ai < 2; ++ai) { asm volatile("" ::: "memory");
            f32x4 xv[4][2][2];
#pragma unroll
            for (int m = 0; m < 4; ++m)
#pragma unroll
                for (int bj = 0; bj < 2; ++bj) { const size_t off = (size_t)(row0 + ai * HALF + m * 16) * DMODEL + col0 + bj * HALF;
                    if (BASEB) { const u32x4 bv = *(const u32x4*)(xb + off); xv[m][bj][0] = (f32x4){bflo(bv.x), bfhi(bv.x), bflo(bv.y), bfhi(bv.y)}; xv[m][bj][1] = (f32x4){bflo(bv.z), bfhi(bv.z), bflo(bv.w), bfhi(bv.w)}; }
                    else { xv[m][bj][0] = __builtin_nontemporal_load((const f32x4*)(basef + off)); xv[m][bj][1] = __builtin_nontemporal_load((const f32x4*)(basef + off + 4)); } }
#pragma unroll
            for (int m = 0; m < 4; ++m) { const int row = row0 + ai * HALF + m * 16; float alpha = coef; if (NORM) alpha *= rs8[ai][m]; float ss = 0.f;
#pragma unroll
                for (int bj = 0; bj < 2; ++bj) { const size_t off = (size_t)row * DMODEL + col0 + bj * HALF;
                    const f32x4 v0 = xv[m][bj][0] + acc[ai][bj][m][0] * alpha, v1 = xv[m][bj][1] + acc[ai][bj][m][1] * alpha;
                    u32x4 w; w.x = pkbf(v0[0], v0[1]); w.y = pkbf(v0[2], v0[3]); w.z = pkbf(v1[0], v1[1]); w.w = pkbf(v1[2], v1[3]); *(u32x4*)(xb + off) = w;
                    ss += (v0[0] * v0[0] + v0[1] * v0[1]) + (v0[2] * v0[2] + v0[3] * v0[3]) + (v1[0] * v1[0] + v1[1] * v1[1]) + (v1[2] * v1[2] + v1[3] * v1[3]); }
                ss += sx<16>(ss); ss = sum32(ss); if (fq == 0) ssqo[(size_t)row * 16 + u.pn * 4 + wc] = ss; } }
    }
};
struct EpiOut {
    static constexpr bool PERM = true, AFTER_DRAIN = false, MIDK = true;
    bf16_t* xb; float* ssqo; const float* ssqA; const float* ssqS;
    __device__ __forceinline__ void mid(f32x4 (&acc)[2][2][4][2], const Unit& u, int wr, int wc, int fr, int fq) const {
        float ra8[2][4], rb8[2][4]; rstd8<8>(ssqA, u.pm, wr, fr, fq, 1.f / 512.f, ra8); rstd8<8>(ssqS, u.pm, wr, fr, fq, 1.f / 512.f, rb8);
#pragma unroll
        for (int ai = 0; ai < 2; ++ai)
#pragma unroll
            for (int m = 0; m < 4; ++m) { const float ratio = ra8[ai][m] * __builtin_amdgcn_rcpf(rb8[ai][m]);
#pragma unroll
                for (int bj = 0; bj < 2; ++bj) { acc[ai][bj][m][0] *= ratio; acc[ai][bj][m][1] *= ratio; } }
    }
    __device__ __forceinline__ void operator()(const f32x4 (&acc)[2][2][4][2], const Unit& u, int wr, int wc, int fr, int fq) const {
        EpiRes<true, true> E{nullptr, xb, ssqo, ssqS, 1.f}; E(acc, u, wr, wc, fr, fq);
    }
};
struct StrideOrder {
    int first, stride, total, nN;
    __device__ __forceinline__ bool next(int i, Unit& u) const { const int id = first + i * stride; if (id >= total) return false; u.pm = id / nN; u.pn = id % nN; return true; }
    __device__ __forceinline__ void a_ready(const Unit&) const {}
    __device__ __forceinline__ void done(const Unit&) const {}
};
struct EpiQKVU {
    static constexpr bool PERM = true, AFTER_DRAIN = false, MIDK = false;
    bf16_t *Q, *U; const float* ssq; unsigned* kmax;
    __device__ __forceinline__ void operator()(const f32x4 (&acc)[2][2][4][2], const Unit& u, int wr, int wc, int fr, int fq) const {
        int row0 = u.pm * BM + wr * 64 + fr, part = u.pn >> 1, c0 = (u.pn & 1) * 256 + wc * 32 + 8 * fq; asm volatile("" : "+v"(row0));
        bf16_t* dstb = Q + (size_t)part * (size_t)(8 * MiB); const float sc = part == 0 ? QSCALE : 1.f;
        float rs8[2][4]; rstd8<16>(ssq, u.pm, wr, fr, fq, 1.f / 1024.f, rs8); float mxb[2] = {0.f, 0.f};
#pragma unroll
        for (int ai = 0; ai < 2; ++ai)
#pragma unroll
            for (int m = 0; m < 4; ++m) { asm volatile("" ::: "memory"); const int row = row0 + ai * HALF + m * 16; const float rs = rs8[ai][m] * sc;
#pragma unroll
                for (int bj = 0; bj < 2; ++bj) { const int c = c0 + bj * HALF; const f32x4 v0 = acc[ai][bj][m][0] * rs, v1 = acc[ai][bj][m][1] * rs;
                    if (part == 1) { float p2 = ((v0[0] * v0[0] + v0[1] * v0[1]) + (v0[2] * v0[2] + v0[3] * v0[3])) + ((v1[0] * v1[0] + v1[1] * v1[1]) + (v1[2] * v1[2] + v1[3] * v1[3])); p2 += sx<16>(p2); p2 = sum32(p2); mxb[bj] = __builtin_fmaxf(mxb[bj], p2); }
                    u32x4 w; w.x = pkbf(v0[0], v0[1]); w.y = pkbf(v0[2], v0[3]); w.z = pkbf(v1[0], v1[1]); w.w = pkbf(v1[2], v1[3]);
                    if (part < 3) *(u32x4*)(dstb + (size_t)row * HW + c) = w;
                    else { const int g = c >> 4, half = (c >> 3) & 1, b = row >> 13, t = row & 8191; *(u32x4*)(U + ((size_t)((b * NGRP + g) * SEQL + t)) * 16 + half * 8) = w; } } }
        if (part == 1) {
#pragma unroll
            for (int bj = 0; bj < 2; ++bj) { float mx = mxb[bj];
                mx = __builtin_fmaxf(mx, sx<1>(mx)); mx = __builtin_fmaxf(mx, sx<2>(mx)); mx = __builtin_fmaxf(mx, sx<4>(mx)); mx = __builtin_fmaxf(mx, sx<8>(mx));
                if (fr == 0 && fq == 0) __hip_atomic_fetch_max(kmax + (((u.pm >> 5) * 8 + (u.pn & 1) * 4 + bj * 2 + (wc >> 1)) << 1) + (wc & 1), __float_as_uint(mx), __ATOMIC_RELAXED, __HIP_MEMORY_SCOPE_AGENT); } }
    }
};
struct EpiGlu {
    static constexpr bool PERM = true, AFTER_DRAIN = false, MIDK = false;
    const bf16_t* Y; const float* bglu; bf16_t* O; float* ssqo;
    __device__ __forceinline__ void operator()(const f32x4 (&acc)[2][2][4][2], const Unit& u, int wr, int wc, int fr, int fq) const {
        int row0 = u.pm * BM + wr * 64 + fr, c0 = u.pn * BM + wc * 32 + 8 * fq; asm volatile("" : "+v"(row0));
#pragma unroll
        for (int ai = 0; ai < 2; ++ai)
#pragma unroll
            for (int m = 0; m < 4; ++m) { asm volatile("" ::: "memory"); const int row = row0 + ai * HALF + m * 16; float ss = 0.f;
#pragma unroll
                for (int bj = 0; bj < 2; ++bj) { const int c = c0 + bj * HALF; const u32x4 yv = *(const u32x4*)(Y + (size_t)row * HW + c);
                    const f32x4 b0 = *(const f32x4*)(bglu + c), b1 = *(const f32x4*)(bglu + c + 4); const f32x4 a0 = acc[ai][bj][m][0] + b0, a1 = acc[ai][bj][m][1] + b1;
                    float o[8]; o[0] = bflo(yv.x) * sigm(a0[0]); o[1] = bfhi(yv.x) * sigm(a0[1]); o[2] = bflo(yv.y) * sigm(a0[2]); o[3] = bfhi(yv.y) * sigm(a0[3]);
                    o[4] = bflo(yv.z) * sigm(a1[0]); o[5] = bfhi(yv.z) * sigm(a1[1]); o[6] = bflo(yv.w) * sigm(a1[2]); o[7] = bfhi(yv.w) * sigm(a1[3]);
                    u32x4 w; w.x = pkbf(o[0], o[1]); w.y = pkbf(o[2], o[3]); w.z = pkbf(o[4], o[5]); w.w = pkbf(o[6], o[7]); *(u32x4*)(O + (size_t)row * HW + c) = w;
#pragma unroll
                    for (int e = 0; e < 8; ++e) ss += o[e] * o[e]; }
                ss += sx<16>(ss); ss = sum32(ss); if (fq == 0) ssqo[(size_t)row * 8 + u.pn * 4 + wc] = ss; }
    }
};
struct EpiBf16P {
    static constexpr bool PERM = true, AFTER_DRAIN = false, MIDK = false;
    bf16_t* O;
    __device__ __forceinline__ void operator()(const f32x4 (&acc)[2][2][4][2], const Unit& u, int wr, int wc, int fr, int fq) const {
        int row0 = u.pm * BM + wr * 64 + fr, c0 = u.pn * BM + wc * 32 + 8 * fq; asm volatile("" : "+v"(row0));
#pragma unroll
        for (int ai = 0; ai < 2; ++ai)
#pragma unroll
            for (int m = 0; m < 4; ++m) { asm volatile("" ::: "memory"); const int row = row0 + ai * HALF + m * 16;
#pragma unroll
                for (int bj = 0; bj < 2; ++bj) { const f32x4 v0 = acc[ai][bj][m][0], v1 = acc[ai][bj][m][1];
                    u32x4 w; w.x = pkbf(v0[0], v0[1]); w.y = pkbf(v0[2], v0[3]); w.z = pkbf(v1[0], v1[1]); w.w = pkbf(v1[2], v1[3]); *(u32x4*)(O + (size_t)row * DMODEL + c0 + bj * HALF) = w; } }
    }
};
struct EpiGate {
    static constexpr bool PERM = true, AFTER_DRAIN = false, MIDK = false;
    const bf16_t* base; float* out; const bf16_t* pp; const float* ssqi; float* ssqo;
    __device__ __forceinline__ void operator()(const f32x4 (&acc)[2][2][4][2], const Unit& u, int wr, int wc, int fr, int fq) const {
        int row0 = u.pm * BM + wr * 64 + fr, c0 = u.pn * BM + wc * 32 + 8 * fq; asm volatile("" : "+v"(row0));
        float rs8[2][4]; rstd8<16>(ssqi, u.pm, wr, fr, fq, 1.f / 1024.f, rs8);
#pragma unroll
        for (int ai = 0; ai < 2; ++ai)
#pragma unroll
            for (int m = 0; m < 4; ++m) { asm volatile("" ::: "memory"); const int row = row0 + ai * HALF + m * 16; const float rs = rs8[ai][m]; float ss = 0.f;
#pragma unroll
                for (int bj = 0; bj < 2; ++bj) { const size_t off = (size_t)row * DMODEL + c0 + bj * HALF; const u32x4 pv = *(const u32x4*)(pp + off);
                    const u32x4 bv = *(const u32x4*)(base + off); const f32x4 x0 = (f32x4){bflo(bv.x), bfhi(bv.x), bflo(bv.y), bfhi(bv.y)}, x1 = (f32x4){bflo(bv.z), bfhi(bv.z), bflo(bv.w), bfhi(bv.w)}; const f32x4 a0 = acc[ai][bj][m][0] * rs, a1 = acc[ai][bj][m][1] * rs; f32x4 v0, v1;
                    v0[0] = x0[0] + sigm(a0[0]) * bflo(pv.x); v0[1] = x0[1] + sigm(a0[1]) * bfhi(pv.x); v0[2] = x0[2] + sigm(a0[2]) * bflo(pv.y); v0[3] = x0[3] + sigm(a0[3]) * bfhi(pv.y);
                    v1[0] = x1[0] + sigm(a1[0]) * bflo(pv.z); v1[1] = x1[1] + sigm(a1[1]) * bfhi(pv.z); v1[2] = x1[2] + sigm(a1[2]) * bflo(pv.w); v1[3] = x1[3] + sigm(a1[3]) * bfhi(pv.w);
                    *(f32x4*)(out + off) = v0; *(f32x4*)(out + off + 4) = v1;
                    ss += (v0[0] * v0[0] + v0[1] * v0[1]) + (v0[2] * v0[2] + v0[3] * v0[3]) + (v1[0] * v1[0] + v1[1] * v1[1]) + (v1[2] * v1[2] + v1[3] * v1[3]); }
                ss += sx<16>(ss); ss = sum32(ss); if (fq == 0) ssqo[(size_t)row * 16 + u.pn * 4 + wc] = ss; }
    }
};

struct EpiGateFinal {
    static constexpr bool PERM = true, AFTER_DRAIN = false, MIDK = false;
    const bf16_t* base; float* out; const bf16_t* pp; const float* ssqi; float* ssqo; unsigned* cnt; const float* gfin;
    __device__ __forceinline__ void operator()(const f32x4 (&acc)[2][2][4][2], const Unit& u, int wr, int wc, int fr, int fq) const {
        int row0 = u.pm * BM + wr * 64 + fr, c0 = u.pn * BM + wc * 32 + 8 * fq; asm volatile("" : "+v"(row0));
        float rs8[2][4]; rstd8<16>(ssqi, u.pm, wr, fr, fq, 1.f / 1024.f, rs8);
        f32x4 v[2][4][2][2];
#pragma unroll
        for (int am = 0; am < 4; ++am) { asm volatile("" ::: "memory"); const int ai = am >> 1;
            u32x4 pvv[2][2], bvv[2][2];
#pragma unroll
            for (int mm = 0; mm < 2; ++mm)
#pragma unroll
                for (int bj = 0; bj < 2; ++bj) { const size_t off = (size_t)(row0 + ai * HALF + ((am & 1) * 2 + mm) * 16) * DMODEL + c0 + bj * HALF; pvv[mm][bj] = *(const u32x4*)(pp + off); bvv[mm][bj] = *(const u32x4*)(base + off); }
#pragma unroll
            for (int mm = 0; mm < 2; ++mm) { const int m = (am & 1) * 2 + mm; const int row = row0 + ai * HALF + m * 16; const float rs = rs8[ai][m]; float ss = 0.f;
#pragma unroll
                for (int bj = 0; bj < 2; ++bj) { const u32x4 pv = pvv[mm][bj];
                    const u32x4 bv = bvv[mm][bj]; const f32x4 x0 = (f32x4){bflo(bv.x), bfhi(bv.x), bflo(bv.y), bfhi(bv.y)}, x1 = (f32x4){bflo(bv.z), bfhi(bv.z), bflo(bv.w), bfhi(bv.w)}; const f32x4 a0 = acc[ai][bj][m][0] * rs, a1 = acc[ai][bj][m][1] * rs; f32x4 v0, v1;
                    v0[0] = x0[0] + sigm(a0[0]) * bflo(pv.x); v0[1] = x0[1] + sigm(a0[1]) * bfhi(pv.x); v0[2] = x0[2] + sigm(a0[2]) * bflo(pv.y); v0[3] = x0[3] + sigm(a0[3]) * bfhi(pv.y);
                    v1[0] = x1[0] + sigm(a1[0]) * bflo(pv.z); v1[1] = x1[1] + sigm(a1[1]) * bfhi(pv.z); v1[2] = x1[2] + sigm(a1[2]) * bflo(pv.w); v1[3] = x1[3] + sigm(a1[3]) * bfhi(pv.w);
                    v[ai][m][bj][0] = v0; v[ai][m][bj][1] = v1;
                    ss += (v0[0] * v0[0] + v0[1] * v0[1]) + (v0[2] * v0[2] + v0[3] * v0[3]) + (v1[0] * v1[0] + v1[1] * v1[1]) + (v1[2] * v1[2] + v1[3] * v1[3]); }
                ss += sx<16>(ss); ss = sum32(ss);
                if (fq == 0) __hip_atomic_store(ssqo + (size_t)row * 16 + u.pn * 4 + wc, ss, __ATOMIC_RELAXED, __HIP_MEMORY_SCOPE_AGENT); } }
        asm volatile("s_waitcnt vmcnt(0)" ::: "memory");
        unsigned* c = cnt + 64 * u.pm;
        if (fr == 0 && fq == 0) __hip_atomic_fetch_add(c, 1u, __ATOMIC_RELAXED, __HIP_MEMORY_SCOPE_AGENT);
        for (unsigned sp = 0; sp < (1u << 22); ++sp) {
            if ((unsigned)__builtin_amdgcn_readfirstlane(__hip_atomic_load(c, __ATOMIC_RELAXED, __HIP_MEMORY_SCOPE_AGENT)) >= 32u) break;
            __builtin_amdgcn_s_sleep(2); }
        __builtin_amdgcn_fence(__ATOMIC_ACQUIRE, "agent");
#pragma unroll
        for (int ai = 0; ai < 2; ++ai)
#pragma unroll
            for (int m = 0; m < 4; ++m) { asm volatile("" ::: "memory"); const int row = row0 + ai * HALF + m * 16; const float* ps = ssqo + (size_t)row * 16 + 4 * fq;
                float s4 = (__hip_atomic_load(ps, __ATOMIC_RELAXED, __HIP_MEMORY_SCOPE_AGENT) + __hip_atomic_load(ps + 1, __ATOMIC_RELAXED, __HIP_MEMORY_SCOPE_AGENT))
                         + (__hip_atomic_load(ps + 2, __ATOMIC_RELAXED, __HIP_MEMORY_SCOPE_AGENT) + __hip_atomic_load(ps + 3, __ATOMIC_RELAXED, __HIP_MEMORY_SCOPE_AGENT));
                s4 += sx<16>(s4); s4 = sum32(s4);
                const float rstd = __builtin_amdgcn_rsqf(s4 * (1.f / 1024.f) + 1e-6f);
#pragma unroll
                for (int bj = 0; bj < 2; ++bj) { const size_t off = (size_t)row * DMODEL + c0 + bj * HALF; const f32x4 g0 = *(const f32x4*)(gfin + c0 + bj * HALF), g1 = *(const f32x4*)(gfin + c0 + bj * HALF + 4);
                    __builtin_nontemporal_store(v[ai][m][bj][0] * rstd * g0, (f32x4*)(out + off)); __builtin_nontemporal_store(v[ai][m][bj][1] * rstd * g1, (f32x4*)(out + off + 4)); } }
    }
};

__device__ __forceinline__ void tr_item(const float* src, int srcN, int k0, int c0, const float* gain, bf16_t* dst, int dstPitch, int dstRow0, LAS float* scr, int lane) {
    float tv[32];
#pragma unroll
    for (int i = 0; i < 32; ++i) { const int kk = 2 * i + (lane >> 5); tv[i] = __builtin_nontemporal_load(src + (size_t)(k0 + kk) * srcN + c0 + (lane & 31)); }
    if (gain) {
#pragma unroll
        for (int i = 0; i < 32; ++i) tv[i] *= gain[k0 + 2 * i + (lane >> 5)]; }
#pragma unroll
    for (int i = 0; i < 32; ++i) scr[(2 * i + (lane >> 5)) * 33 + (lane & 31)] = tv[i];
    asm volatile("s_waitcnt lgkmcnt(0)" ::: "memory");
    const int c = lane & 7;
#pragma unroll
    for (int j = 0; j < 4; ++j) { const int n = (lane >> 3) + 8 * j; const LAS float* s = scr + (8 * c) * 33 + n;
        u32x4 o; o.x = pkbf(s[0 * 33], s[1 * 33]); o.y = pkbf(s[2 * 33], s[3 * 33]); o.z = pkbf(s[4 * 33], s[5 * 33]); o.w = pkbf(s[6 * 33], s[7 * 33]);
        *(u32x4*)(dst + (size_t)(dstRow0 + n) * dstPitch + k0 + 8 * c) = o; }
    asm volatile("s_waitcnt lgkmcnt(0)" ::: "memory");
}
__device__ __forceinline__ void tr_w13(const float* w1, const float* w3, const float* gain, bf16_t* dst, int item, LAS float* scr, int lane) {
    const int nblk = 5632 / 32, kb = item / nblk, nb = item % nblk, R0 = 32 * nb, tile = R0 >> 8, r = R0 & 255;
    tr_item(r < 128 ? w1 : w3, DFF, 64 * kb, 128 * tile + (r & 127), gain, dst, DMODEL, R0, scr, lane);
}
__device__ __forceinline__ void cis_d(double a, double& c, double& s) {
    const double k = rint(a * 0.63661977236758134);
    const double r = fma(-k, 6.123233995736766e-17, fma(-k, 1.5707963267948966, a)), r2 = r * r;
    const double sp = r * (1.0 + r2 * (-1.0 / 6 + r2 * (1.0 / 120 + r2 * (-1.0 / 5040 + r2 * (1.0 / 362880 + r2 * (-1.0 / 39916800 + r2 * (1.0 / 6227020800.0)))))));
    const double cp = 1.0 + r2 * (-0.5 + r2 * (1.0 / 24 + r2 * (-1.0 / 720 + r2 * (1.0 / 40320 + r2 * (-1.0 / 3628800 + r2 * (1.0 / 479001600.0 + r2 * (-1.0 / 87178291200.0)))))));
    const int q = ((int)k) & 3;
    c = (q == 0) ? cp : (q == 1) ? -sp : (q == 2) ? -cp : sp;
    s = (q == 0) ? sp : (q == 1) ? cp : (q == 2) ? -sp : -cp;
}
__device__ __forceinline__ float gelu_tanh(float y) { return y * sigm(1.5957691216057308f * (y + 0.044715f * y * y * y)); }

__device__ __forceinline__ void ssm_item(int bg, const bf16_t* U, const bf16_t* Ktab, const bf16_t* Pend, const bf16_t* Cc, const float* AP, bf16_t* Yout, LAS unsigned char* lds, int tid, unsigned* done) {
    asm volatile("" : "+v"(tid));
    const int lane = tid & 63, wid = __builtin_amdgcn_readfirstlane(tid >> 6), fr = lane & 15, fq = lane >> 4;
    const int b = bg >> 5, g = bg & 31;
    const bf16_t* Ub = U + (size_t)bg * SEQL * 16; const bf16_t* Kt = Ktab + g * 4096; const bf16_t* Pe = Pend + g * 32768; const bf16_t* Cg = Cc + g * 32768; const float* APg = AP + g * 64 * 36;
    float a16r[4], a16i[4];
#pragma unroll
    for (int pt = 0; pt < 4; ++pt) { a16r[pt] = APg[(16 * pt + fr) * 36 + 32]; a16i[pt] = APg[(16 * pt + fr) * 36 + 33]; }
    const float a64r = APg[lane * 36 + 34], a64i = APg[lane * 36 + 35];
    float cr = 0.f, ci = 0.f;
    LAS float* Ebuf = (LAS float*)lds; LAS float* Cbuf = (LAS float*)(lds + 16384); LAS unsigned short* XP = (LAS unsigned short*)(lds + 32768) + wid * (16 * 136);
    const int slot = wid * 4 + fq;
    LAS unsigned short* PendL = (LAS unsigned short*)(lds + 67584); LAS unsigned short* KtL = (LAS unsigned short*)(lds + 135168);
    { const GAS u32x4* ps = (const GAS u32x4*)Pe; u32x4 tv[8];
#pragma unroll
      for (int i = 0; i < 8; ++i) tv[i] = ps[tid + 512 * i];
      const u32x4 kv = ((const GAS u32x4*)Kt)[tid];
#pragma unroll
      for (int i = 0; i < 8; ++i) { const int c = tid + 512 * i; *(LAS u32x4*)(PendL + (c >> 5) * 264 + (c & 31) * 8) = tv[i]; }
      *(LAS u32x4*)(KtL + tid * 8) = kv; }
    __syncthreads();
    for (int seg = 0; seg < 4; ++seg) {
        const int c0 = seg * 128 + wid * 16;
        bf16x8 uf[8];
        { const bf16_t* ub = Ub + ((size_t)(c0 + fr) * 16 + (fq >> 1)) * 16 + 8 * (fq & 1); asm volatile("" : "+v"(ub));
#pragma unroll
        for (int ks = 0; ks < 8; ++ks) uf[ks] = *(const GAS bf16x8*)(ub + 32 * ks); }
        f32x4 S[8];
#pragma unroll
        for (int nt = 0; nt < 8; ++nt) { const LAS unsigned short* pn = PendL + (16 * nt + fr) * 264 + 8 * fq; S[nt] = (f32x4){0.f, 0.f, 0.f, 0.f};
#pragma unroll
            for (int ks = 0; ks < 8; ++ks) { const bf16x8 pf = *(const LAS bf16x8*)(pn + 32 * ks); S[nt] = __builtin_amdgcn_mfma_f32_16x16x32_bf16(uf[ks], pf, S[nt], 0, 0, 0); } }
        f32x4 Y[16];
#pragma unroll
        for (int tl = 0; tl < 16; ++tl) Y[tl] = (f32x4){0.f, 0.f, 0.f, 0.f};
#pragma unroll
        for (int d = 0; d < 16; ++d) { const int j = d - (fq >> 1); bf16x8 kfv = *(const LAS bf16x8*)(KtL + ((j < 0 ? 0 : j) * 16 + fr) * 16 + 8 * (fq & 1)); if (j < 0) kfv = (bf16x8){0, 0, 0, 0, 0, 0, 0, 0};
#pragma unroll
            for (int ks = 0; ks < 8; ++ks) if (d + 2 * ks < 16) Y[d + 2 * ks] = __builtin_amdgcn_mfma_f32_16x16x32_bf16(kfv, uf[ks], Y[d + 2 * ks], 0, 0, 0); }
#pragma unroll
        for (int pt = 0; pt < 4; ++pt) { float xr = 0.f, xi = 0.f;
#pragma unroll
            for (int i = 0; i < 4; ++i) { const float nr = a16r[pt] * xr - a16i[pt] * xi + S[pt][i], ni = a16r[pt] * xi + a16i[pt] * xr + S[pt + 4][i]; xr = nr; xi = ni; }
            Ebuf[slot * 128 + 16 * pt + fr] = xr; Ebuf[slot * 128 + 64 + 16 * pt + fr] = xi; }
        __syncthreads();
        if (wid == 0) {
            float er[32], ei[32];
#pragma unroll
            for (int sl = 0; sl < 32; ++sl) { er[sl] = Ebuf[sl * 128 + lane]; ei[sl] = Ebuf[sl * 128 + 64 + lane]; }
#pragma unroll
            for (int sl = 0; sl < 32; ++sl) { Cbuf[sl * 128 + lane] = cr; Cbuf[sl * 128 + 64 + lane] = ci;
                const float nr = a64r * cr - a64i * ci + er[sl], ni = a64r * ci + a64i * cr + ei[sl]; cr = nr; ci = ni; }
        }
        __syncthreads();
#pragma unroll
        for (int pt = 0; pt < 4; ++pt) { float xr = Cbuf[slot * 128 + 16 * pt + fr], xi = Cbuf[slot * 128 + 64 + 16 * pt + fr];
#pragma unroll
            for (int i = 0; i < 4; ++i) { const unsigned w = pkbf(xr, xi); XP[(4 * fq + i) * 136 + 16 * pt + fr] = (unsigned short)(w & 0xffffu); XP[(4 * fq + i) * 136 + 64 + 16 * pt + fr] = (unsigned short)(w >> 16);
                const float nr = a16r[pt] * xr - a16i[pt] * xi + S[pt][i], ni = a16r[pt] * xi + a16i[pt] * xr + S[pt + 4][i]; xr = nr; xi = ni; } }
        asm volatile("s_waitcnt lgkmcnt(0)" ::: "memory");
        bf16x8 xf[4];
#pragma unroll
        for (int ks = 0; ks < 4; ++ks) xf[ks] = *(const LAS bf16x8*)(XP + fr * 136 + 32 * ks + 8 * fq);
#pragma unroll
        for (int tl = 0; tl < 16; ++tl) { const bf16_t* cp = Cg + (tl * 16 + fr) * 128 + 8 * fq; if ((tl & 3) == 0) asm volatile("" : "+v"(cp) :: "memory"); else asm volatile("" : "+v"(cp));
#pragma unroll
            for (int ks = 0; ks < 4; ++ks) { const bf16x8 cf = *(const GAS bf16x8*)(cp + 32 * ks); Y[tl] = __builtin_amdgcn_mfma_f32_16x16x32_bf16(cf, xf[ks], Y[tl], 0, 0, 0); } }
        bf16_t* yo = Yout + ((size_t)b * SEQL + (size_t)(c0 + fr) * 16) * HW + g * 16 + 4 * fq; asm volatile("" : "+v"(yo));
#pragma unroll
        for (int tl = 0; tl < 16; ++tl) { u32x2 w; w.x = pkbf(gelu_tanh(Y[tl][0]), gelu_tanh(Y[tl][1])); w.y = pkbf(gelu_tanh(Y[tl][2]), gelu_tanh(Y[tl][3])); *(GAS u32x2*)(yo + (size_t)tl * HW) = w; }
        asm volatile("s_waitcnt lgkmcnt(0)" ::: "memory");
    }
    asm volatile("s_waitcnt vmcnt(0)" ::: "memory");
    __syncthreads();
    if (tid == 0) { __builtin_amdgcn_fence(__ATOMIC_RELEASE, "agent"); asm volatile("s_waitcnt vmcnt(0)" ::: "memory"); __hip_atomic_fetch_add(done, 1u, __ATOMIC_RELAXED, __HIP_MEMORY_SCOPE_AGENT); }
}

#define XB_TMO      128
#define XB_XCNT(j)  (256  + 64 * (j))
#define XB_XSUB(j)  (1280 + 64 * (j))
#define XB_XGEN(j)  (2304 + 64 * (j))
#define XB_TOP      3328
#define XB_TOPGEN   3392
#define XCD_BAR_WORDS 3456
#define XB_SPIN_CAP (1u << 18)

__device__ __forceinline__ unsigned xb_ld(unsigned* p)              { return __hip_atomic_load(p, __ATOMIC_RELAXED, __HIP_MEMORY_SCOPE_AGENT); }
__device__ __forceinline__ unsigned xb_add(unsigned* p, unsigned v) { return __hip_atomic_fetch_add(p, v, __ATOMIC_RELAXED, __HIP_MEMORY_SCOPE_AGENT); }
__device__ __forceinline__ unsigned xb_xcc_id() { return (unsigned)__builtin_amdgcn_s_getreg((3 << 11) | 20) & 0xFu; }
#define XB_SPIN(cond, bar) do { unsigned _sp = 0; while (cond) { __builtin_amdgcn_s_sleep(1); \
    if ((++_sp & 255u) == 0u) { if (xb_ld(&(bar)[XB_TMO])) break; if (_sp > XB_SPIN_CAP) { atomicAdd(&(bar)[XB_TMO], 1u); break; } } } } while (0)

struct XcdBarrier {
    unsigned* bar; unsigned x;
    volatile LAS unsigned* st;
};

__device__ __forceinline__ XcdBarrier xcd_barrier_post(unsigned* bar, volatile LAS unsigned* st) {
    XcdBarrier b; b.bar = bar; b.x = xb_xcc_id(); b.st = st;
    if (threadIdx.x == 0) (void)xb_add(&bar[XB_XCNT(b.x)], 1u);
    return b;
}
__device__ __forceinline__ void xcd_barrier_complete(unsigned* bar, unsigned x, unsigned& nloc, unsigned& nx) {
    const unsigned G = gridDim.x * gridDim.y * gridDim.z;
    unsigned sum, cnt, mine, sp = 0u;
    for (;;) {
        sum = 0u; cnt = 0u; mine = 0u;
#pragma unroll
        for (unsigned j = 0; j < 16; ++j) { const unsigned c = xb_ld(&bar[XB_XCNT(j)]); sum += c; cnt += (c > 0u) ? 1u : 0u; mine = (j == x) ? c : mine; }
        if (sum == G) break;
        __builtin_amdgcn_s_sleep(1);
        if ((++sp & 255u) == 0u) { if (xb_ld(&bar[XB_TMO])) break; if (sp > XB_SPIN_CAP) { atomicAdd(&bar[XB_TMO], 1u); break; } }
    }
    nloc = mine > 0u ? mine : 1u; nx = cnt > 0u ? cnt : 1u;
}

__device__ __forceinline__ void xcd_barrier(const XcdBarrier& b) {
    asm volatile("s_waitcnt vmcnt(0)" ::: "memory");
    __syncthreads();
    if (threadIdx.x == 0) {
        unsigned* bar = b.bar;
        __builtin_amdgcn_s_waitcnt(0);
        unsigned nloc = b.st[0], nx = b.st[1];
        if (nloc == 0u) { xcd_barrier_complete(bar, b.x, nloc, nx); b.st[0] = nloc; b.st[1] = nx; }
        const unsigned old = xb_add(&bar[XB_XSUB(b.x)], 1u);
        const unsigned gen = old / nloc;
        if (old + 1u == (gen + 1u) * nloc) {
            __builtin_amdgcn_fence(__ATOMIC_RELEASE, "agent");
            asm volatile("s_waitcnt vmcnt(0)" ::: "memory");
            const unsigned og = xb_add(&bar[XB_TOP], 1u);
            const unsigned tg = og / nx;
            if (og + 1u == (tg + 1u) * nx) xb_add(&bar[XB_TOPGEN], 1u);
            else XB_SPIN(xb_ld(&bar[XB_TOPGEN]) == tg, bar);
            __builtin_amdgcn_fence(__ATOMIC_ACQUIRE, "agent");
            xb_add(&bar[XB_XGEN(b.x)], 1u);
            asm volatile("s_waitcnt vmcnt(0)" ::: "memory");
        } else {
            XB_SPIN(xb_ld(&bar[XB_XGEN(b.x)]) == gen, bar);
            __builtin_amdgcn_fence(__ATOMIC_ACQUIRE, "agent");
            asm volatile("s_waitcnt vmcnt(0)" ::: "memory");
        }
    }
    __syncthreads();
}

#define BHMAP(r) ((((r) & 1) << 3) | (7 - ((r) >> 1)))
constexpr int NATT = 704;
struct Args { const float* in[30]; float* out; unsigned char* ws; };
#define CAS __attribute__((address_space(4)))
#define GSYNC() do { XcdBarrier b_; b_.bar = (unsigned*)(((const CAS Args*)__builtin_amdgcn_kernarg_segment_ptr())->ws + 4096); b_.x = xb_xcc_id(); b_.st = (volatile LAS unsigned*)(lds + MISC_OFF + 32); xcd_barrier(b_); } while (0)
#ifdef PROBE_SEL1
#define STAMP() do { if (blockIdx.x == 0 && threadIdx.x == 0) { unsigned long long* ts_ = (unsigned long long*)(((const CAS Args*)__builtin_amdgcn_kernarg_segment_ptr())->ws + 1024); ts_[nstamp] = __builtin_amdgcn_s_memrealtime(); } ++nstamp; } while (0)
#else
#define STAMP() do {} while (0)
#endif

__global__ void __launch_bounds__(512, 2) mk_fwd(Args a) {
    extern __shared__ __attribute__((aligned(16))) unsigned char lds_raw[];
    cg::grid_group grid = cg::this_grid();
    LAS unsigned char* lds = (LAS unsigned char*)lds_raw;
    const int wave_s = __builtin_amdgcn_readfirstlane((int)(threadIdx.x >> 6));
    int nstamp = 0; (void)nstamp;
    if (threadIdx.x < 32) ((LAS unsigned*)(lds + MISC_OFF))[threadIdx.x] = 0u;
    if (blockIdx.x == 0) { unsigned* cz = (unsigned*)(((const CAS Args*)__builtin_amdgcn_kernarg_segment_ptr())->ws);
        for (int i = threadIdx.x; i < 4480; i += 512) if (i < 128 || i >= 1024) __hip_atomic_store(cz + i, 0u, __ATOMIC_RELAXED, __HIP_MEMORY_SCOPE_AGENT);
        if (threadIdx.x < 64) __hip_atomic_store(cz + 4608 + 64 * threadIdx.x, 0u, __ATOMIC_RELAXED, __HIP_MEMORY_SCOPE_AGENT);
        if (threadIdx.x < 256) __hip_atomic_store(cz + 12288 + threadIdx.x, 0u, __ATOMIC_RELAXED, __HIP_MEMORY_SCOPE_AGENT);
        if (threadIdx.x < 96) __hip_atomic_store(cz + 13312 + threadIdx.x, 0u, __ATOMIC_RELAXED, __HIP_MEMORY_SCOPE_AGENT); }
    __syncthreads();
    grid.sync();
    (void)xcd_barrier_post((unsigned*)(((const CAS Args*)__builtin_amdgcn_kernarg_segment_ptr())->ws + 4096), (volatile LAS unsigned*)(lds + MISC_OFF + 32));
    STAMP();
#define IDS() const CAS Args* ap_ = (const CAS Args*)__builtin_amdgcn_kernarg_segment_ptr(); asm volatile("" : "+s"(ap_)); \
    int tid; asm volatile("v_mbcnt_lo_u32_b32 %0, -1, 0\n\tv_mbcnt_hi_u32_b32 %0, -1, %0" : "=v"(tid)); tid += wave_s * 64; const int lane = tid & 63, wave = __builtin_amdgcn_readfirstlane(tid >> 6); \
    const int G = gridDim.x, bx = blockIdx.x, vcu = (G % 8 == 0) ? (bx % 8) * (G / 8) + bx / 8 : bx; \
    const int gw = vcu * 8 + wave, NGW = G * 8, gt = bx * 512 + tid, NGT = G * 512; (void)lane; (void)gw; (void)NGW; (void)gt; (void)NGT; (void)vcu
#define INP(i) (ap_->in[i])
#define WSP(T, off) ((T*)(ap_->ws + (off)))
#define OUTP (ap_->out)
    {
        IDS();
        const float *x = INP(0), *pin = INP(1), *g_ffn1 = INP(2), *w1_a = INP(3), *w3_a = INP(4), *w2_a = INP(5), *g_mix = INP(6), *w_in = INP(7);
        const float *a_re = INP(9), *a_im = INP(10), *log_dt = INP(11), *b_re = INP(12), *b_im = INP(13);
        const float *w_glu = INP(17), *g_attn_out = INP(19), *g_ssm_out = INP(20), *w_out = INP(21), *g_ffn2 = INP(22), *w1_b = INP(23), *w3_b = INP(24), *w2_b = INP(25);
        const float *g_ple = INP(26), *w_ple_gate = INP(27), *w_ple_proj = INP(28);
        float* AP = WSP(float, WS_AP); float* BB = WSP(float, WS_BB); bf16_t* Wf = WSP(bf16_t, WS_WF); float* ssq0 = WSP(float, WS_SSQ0);
        bf16_t *W13a = WSP(bf16_t, WS_W13A), *W2a = WSP(bf16_t, WS_W2A), *Win = WSP(bf16_t, WS_WIN), *Wglu = WSP(bf16_t, WS_WGLU), *WoA = WSP(bf16_t, WS_WOA);
        bf16_t *W13b = WSP(bf16_t, WS_W13B), *W2b = WSP(bf16_t, WS_W2B), *Wg = WSP(bf16_t, WS_WG), *Wp = WSP(bf16_t, WS_WP), *PB = WSP(bf16_t, WS_PB), *XB = WSP(bf16_t, WS_XB);
        LAS float* scr = (LAS float*)(lds + wave * 16384);
        constexpr int I_13 = 16 * 176, I_IN = 16 * 64;
        constexpr int NITEMS = I_13 + I_IN;
        for (int it = gw; it < NITEMS; it += NGW) {
            int r = it;
            if (r < I_13) { tr_w13(w1_a, w3_a, g_ffn1, W13a, r, scr, lane); continue; } r -= I_13;
            { const int R0 = 32 * (r % 64); tr_item(w_in, 2056, 64 * (r / 64), R0 < 1536 ? R0 : R0 + 8, g_mix, Win, DMODEL, R0, scr, lane); }
        }
        for (int m = gw; m < TOK; m += 2 * NGW) {
            const int m2 = m + NGW; const bool has2 = m2 < TOK; const int mb = has2 ? m2 : m;
            const f32x4* xr = (const f32x4*)(x + (size_t)m * DMODEL) + lane; const f32x4* xr2 = (const f32x4*)(x + (size_t)mb * DMODEL) + lane;
            f32x4 va[4], vb[4];
#pragma unroll
            for (int j = 0; j < 4; ++j) { va[j] = __builtin_nontemporal_load(xr + 64 * j); vb[j] = __builtin_nontemporal_load(xr2 + 64 * j); }
            const f32x4 pa = __builtin_nontemporal_load((const f32x4*)(pin + (size_t)m * PLE) + lane), pb = __builtin_nontemporal_load((const f32x4*)(pin + (size_t)mb * PLE) + lane);
            u32x2* o8 = (u32x2*)(XB + (size_t)m * DMODEL) + lane; u32x2* o8b = (u32x2*)(XB + (size_t)mb * DMODEL) + lane; float ss = 0.f, ss2 = 0.f;
#pragma unroll
            for (int j = 0; j < 4; ++j) { const f32x4 v = va[j]; ss += (v[0] * v[0] + v[1] * v[1]) + (v[2] * v[2] + v[3] * v[3]); u32x2 w; w.x = pkbf(v[0], v[1]); w.y = pkbf(v[2], v[3]); o8[64 * j] = w; }
            ss = wave_sum(ss); if (lane < 16) ssq0[(size_t)m * 16 + lane] = lane == 0 ? ss : 0.f;
            { u32x2 w; w.x = pkbf(pa[0], pa[1]); w.y = pkbf(pa[2], pa[3]); *((u32x2*)(PB + (size_t)m * PLE) + lane) = w; }
            if (has2) {
#pragma unroll
                for (int j = 0; j < 4; ++j) { const f32x4 v = vb[j]; ss2 += (v[0] * v[0] + v[1] * v[1]) + (v[2] * v[2] + v[3] * v[3]); u32x2 w; w.x = pkbf(v[0], v[1]); w.y = pkbf(v[2], v[3]); o8b[64 * j] = w; }
                ss2 = wave_sum(ss2); if (lane < 16) ssq0[(size_t)m2 * 16 + lane] = lane == 0 ? ss2 : 0.f;
                u32x2 w; w.x = pkbf(pb[0], pb[1]); w.y = pkbf(pb[2], pb[3]); *((u32x2*)(PB + (size_t)m2 * PLE) + lane) = w; }
        }
        if (gt < 16384) { const int n = gt >> 10, k = gt & 1023; const float v = n < 8 ? g_mix[k] * w_in[(size_t)k * 2056 + 1536 + n] : 0.f; Wf[gt] = (bf16_t)(pkbf(v, 0.f) & 0xffffu); }
        if (gt < 2048) {
            const int g = gt >> 6; const double dt = exp((double)log_dt[g]), ar = a_re[gt], ai = a_im[gt];
            double cs, sn; cis_d(dt * ai, cs, sn); const double dec = exp(dt * ar), Ar = dec * cs, Ai = dec * sn;
            const double nr = Ar - 1.0, ni = Ai, den = ar * ar + ai * ai, f_r = (nr * ar + ni * ai) / den, f_i = (ni * ar - nr * ai) / den;
            float* ap = AP + gt * 36; double pr = 1.0, pi = 0.0;
            for (int n = 0; n <= 16; ++n) { ap[2 * n] = (float)pr; ap[2 * n + 1] = (float)pi; if (n < 16) { const double t_ = pr * Ar - pi * Ai; pi = pr * Ai + pi * Ar; pr = t_; } }
            double qr = pr * pr - pi * pi, qi = 2.0 * pr * pi; const double q2r = qr * qr - qi * qi, q2i = 2.0 * qr * qi; ap[34] = (float)q2r; ap[35] = (float)q2i;
            for (int h = 0; h < 16; ++h) { const double br = b_re[gt * 16 + h], bi = b_im[gt * 16 + h]; BB[gt * 32 + 2 * h] = (float)(f_r * br - f_i * bi); BB[gt * 32 + 2 * h + 1] = (float)(f_r * bi + f_i * br); }
        }
    }
    GSYNC(); STAMP();

    {
        IDS();
        pg8::Gemm gm{WSP(bf16_t, WS_XB), WSP(bf16_t, WS_W13A), TOK, 2 * DFF, DMODEL}; pg8::StaticOrder S; S.init(TOK, 2 * DFF, G, bx);
        EpiSwiglu E{WSP(bf16_t, WS_H1), WSP(float, WS_SSQ0)};
        pg8::gemm_phase<EpiSwiglu, pg8::StaticOrder, true, true>(lds, gm, S, E, tid);
    }
    if ((int)blockIdx.x >= (int)gridDim.x / 2) {
        IDS();
        const float *c_re = INP(14), *c_im = INP(15), *d_skip = INP(16);
        const float* AP = WSP(float, WS_AP); const float* BB = WSP(float, WS_BB); bf16_t* Ktab = WSP(bf16_t, WS_KTAB); bf16_t* Pend = WSP(bf16_t, WS_PEND); bf16_t* Cc = WSP(bf16_t, WS_CC);
        const int gt2 = (bx - G / 2) * 512 + tid, NGT2 = (G - G / 2) * 512;
        { const float *w2_a = INP(5), *w_glu = INP(17), *g_attn_out = INP(19), *g_ssm_out = INP(20), *w_out = INP(21), *w_ple_proj = INP(28);
          bf16_t *W2a = WSP(bf16_t, WS_W2A), *Wglu = WSP(bf16_t, WS_WGLU), *WoA = WSP(bf16_t, WS_WOA), *Wp = WSP(bf16_t, WS_WP);
          LAS float* scr = (LAS float*)(lds + wave * 16384);
          constexpr int I_2 = 44 * 32, I_GLU = 8 * 16, I_O = 8 * 32, I_P = 4 * 32;
          for (int it = (bx - G / 2) * 8 + wave; it < I_2 + I_GLU + 2 * I_O + I_P; it += (G - G / 2) * 8) {
              int r = it;
              if (r < I_2) { tr_item(w2_a, DMODEL, 64 * (r / 32), 32 * (r % 32), nullptr, W2a, DFF, 32 * (r % 32), scr, lane); continue; } r -= I_2;
              if (r < I_GLU) { tr_item(w_glu, HW, 64 * (r / 16), 32 * (r % 16), nullptr, Wglu, HW, 32 * (r % 16), scr, lane); continue; } r -= I_GLU;
              if (r < 2 * I_O) { const int kb = r / 32; tr_item(w_out, DMODEL, 64 * kb, 32 * (r % 32), kb < 8 ? g_attn_out : g_ssm_out - HW, WoA, DMODEL, 32 * (r % 32), scr, lane); continue; } r -= 2 * I_O;
              tr_item(w_ple_proj, DMODEL, 64 * (r / 32), 32 * (r % 32), nullptr, Wp, PLE, 32 * (r % 32), scr, lane);
          } }
        for (int idx = gt2; idx < 131072; idx += NGT2) {
            const int g = idx >> 12, j = (idx >> 8) & 15, h = (idx >> 4) & 15, hp = idx & 15; float s = 0.f;
#pragma unroll 16
            for (int p = 0; p < 64; ++p) { const float Cr = c_re[(g * 16 + h) * 64 + p], Ci = c_im[(g * 16 + h) * 64 + p], Ar = AP[(g * 64 + p) * 36 + 2 * j], Ai = AP[(g * 64 + p) * 36 + 2 * j + 1];
                const float Wr = Cr * Ar - Ci * Ai, Wi = Cr * Ai + Ci * Ar, Br = BB[(g * 64 + p) * 32 + 2 * hp], Bi = BB[(g * 64 + p) * 32 + 2 * hp + 1]; s += Wr * Br - Wi * Bi; }
            if (j == 0 && h == hp) s += d_skip[g * 16 + h];
            Ktab[idx] = (bf16_t)(pkbf(s, 0.f) & 0xffffu);
        }
        for (int idx = gt2; idx < 1048576; idx += NGT2) {
            { const int g = idx >> 15, comp = (idx >> 8) & 127, k = idx & 255, p = comp & 63, im = comp >> 6, sl = k >> 4, hp = k & 15;
              const float Ar = AP[(g * 64 + p) * 36 + 2 * (15 - sl)], Ai = AP[(g * 64 + p) * 36 + 2 * (15 - sl) + 1], Br = BB[(g * 64 + p) * 32 + 2 * hp], Bi = BB[(g * 64 + p) * 32 + 2 * hp + 1];
              const float v = im ? (Ar * Bi + Ai * Br) : (Ar * Br - Ai * Bi); Pend[idx] = (bf16_t)(pkbf(v, 0.f) & 0xffffu); }
            { const int g = idx >> 15, n = (idx >> 7) & 255, tl = n >> 4, h = n & 15, comp = idx & 127, p = comp & 63, im = comp >> 6;
              const float Cr = c_re[(g * 16 + h) * 64 + p], Ci = c_im[(g * 16 + h) * 64 + p], Ar = AP[(g * 64 + p) * 36 + 2 * (tl + 1)], Ai = AP[(g * 64 + p) * 36 + 2 * (tl + 1) + 1];
              const float v = im ? -(Cr * Ai + Ci * Ar) : (Cr * Ar - Ci * Ai); Cc[idx] = (bf16_t)(pkbf(v, 0.f) & 0xffffu); }
        }
    }
    GSYNC(); STAMP();
    {
        IDS();
        pg8::Gemm gm{WSP(bf16_t, WS_H1), WSP(bf16_t, WS_W2A), TOK, DMODEL, DFF}; pg8::StaticOrder S; S.init(TOK, DMODEL, G, bx);
        EpiRes<false, false> E{INP(0), WSP(bf16_t, WS_XB), WSP(float, WS_SSQ1), nullptr, 0.5f};
        pg8::gemm_phase<EpiRes<false, false>, pg8::StaticOrder, true, true>(lds, gm, S, E, tid);
    }
    GSYNC(); STAMP();
    {
        IDS();
        const float* b_f = INP(8); const bf16_t* XB = WSP(bf16_t, WS_XB); const bf16_t* Wf = WSP(bf16_t, WS_WF); const float* ssq1 = WSP(float, WS_SSQ1); float* LOGF = WSP(float, WS_LOGF);
        const int fr = lane & 15, fq = lane >> 4;
        for (int it = gw >> 1; it < TOK / 16; it += NGW >> 1) {
            const int t0 = it * 16, kh = wave & 1; f32x4 acc0 = (f32x4){0.f, 0.f, 0.f, 0.f}, acc1 = acc0;
            const bf16_t* ap = XB + (size_t)(t0 + fr) * DMODEL + 8 * fq + 512 * kh; const bf16_t* bp = Wf + fr * DMODEL + 8 * fq + 512 * kh;
            bf16x8 av[16], bv[16];
#pragma unroll
            for (int ks = 0; ks < 16; ++ks) { av[ks] = *(const bf16x8*)(ap + 32 * ks); bv[ks] = *(const bf16x8*)(bp + 32 * ks); }
#pragma unroll
            for (int ks = 0; ks < 16; ks += 2) { acc0 = __builtin_amdgcn_mfma_f32_16x16x32_bf16(av[ks], bv[ks], acc0, 0, 0, 0); acc1 = __builtin_amdgcn_mfma_f32_16x16x32_bf16(av[ks + 1], bv[ks + 1], acc1, 0, 0, 0); }
            f32x4 acc = acc0 + acc1;
            LAS f32x4* xch = (LAS f32x4*)(lds + (wave >> 1) * 1024) + lane;
            if (kh) *xch = acc;
            __syncthreads();
            if (!kh) { acc = acc + *xch;
                if (fr < 8) { const int r0 = t0 + 4 * fq; const float bf = b_f[fr]; f32x4 o;
#pragma unroll
                    for (int i = 0; i < 4; ++i) { const float z = rstd_row<16>(ssq1, r0 + i, 1.f / 1024.f) * acc[i] + bf; o[i] = fminf(z, 0.f) - log1pf(expf(-fabsf(z))); }
                    *(f32x4*)(LOGF + (size_t)((r0 >> 13) * 8 + fr) * SEQL + (r0 & 8191)) = o; } }
            __syncthreads();
        }
        pg8::Gemm gm{XB, WSP(bf16_t, WS_WIN), TOK, 2048, DMODEL}; pg8::StaticOrder S; S.init(TOK, 2048, G, bx);
        EpiQKVU E{WSP(bf16_t, WS_Q), WSP(bf16_t, WS_U), ssq1, WSP(unsigned, WS_CTL) + 13312};
        pg8::gemm_phase<EpiQKVU, pg8::StaticOrder, true, true>(lds, gm, S, E, tid);
    }
    GSYNC(); STAMP();
    {
        volatile LAS int* qs = (volatile LAS int*)(lds + MISC_OFF);
        int qfirst = 1;
        for (;;) {
            IDS();
            int item;
            if (qfirst) { item = bx; qfirst = 0; }
            else {
                if (tid == 0) qs[0] = G + (int)__hip_atomic_fetch_add(WSP(unsigned, WS_CTL) + 64, 1u, __ATOMIC_RELAXED, __HIP_MEMORY_SCOPE_AGENT);
                __syncthreads();
                item = __builtin_amdgcn_readfirstlane(qs[0]);
                __syncthreads(); }
            if (item >= 64 + NATT + 176 + 256 + 128) break;
            if (item >= 64 + NATT + 176 + 256) {
                const int j_ = item - (64 + NATT + 176 + 256);
                if (tid == 0) { unsigned* dn = WSP(unsigned, WS_CTL) + 13400 + (j_ >> 6);
                    for (unsigned sp = 0; sp < (1u << 22); ++sp) { if (__hip_atomic_load(dn, __ATOMIC_RELAXED, __HIP_MEMORY_SCOPE_AGENT) >= 32u) break; __builtin_amdgcn_s_sleep(8); }
                    __builtin_amdgcn_fence(__ATOMIC_ACQUIRE, "agent"); asm volatile("s_waitcnt vmcnt(0)" ::: "memory"); }
                __syncthreads();
                pg8::Gemm gm{WSP(bf16_t, WS_Y), WSP(bf16_t, WS_WGLU), TOK, HW, HW}; StrideOrder S{j_, 1 << 28, 128, 2};
                EpiGlu E{WSP(bf16_t, WS_Y), INP(18), WSP(bf16_t, WS_SSMO), WSP(float, WS_SSQS)};
                pg8::gemm_phase<EpiGlu, StrideOrder, true, true>(lds, gm, S, E, tid); continue; }
            if (item >= 64 + NATT + 176) {
                pg8::Gemm gm{WSP(bf16_t, WS_PB), WSP(bf16_t, WS_WP), TOK, DMODEL, PLE}; StrideOrder S{item - (64 + NATT + 176), 1 << 28, 256, 4};
                EpiBf16P E{WSP(bf16_t, WS_PP)};
                pg8::gemm_phase<EpiBf16P, StrideOrder, true, true>(lds, gm, S, E, tid); continue; }
            if (item >= 64 + NATT) {
                tr_w13(INP(23), INP(24), INP(22), WSP(bf16_t, WS_W13B), (item - (64 + NATT)) * 16 + wave * 2, (LAS float*)(lds + wave * 16384), lane);
                tr_w13(INP(23), INP(24), INP(22), WSP(bf16_t, WS_W13B), (item - (64 + NATT)) * 16 + wave * 2 + 1, (LAS float*)(lds + wave * 16384), lane);
                __syncthreads(); continue; }
            const bool is_ssm = item < 64;
#ifdef PROBE_SEL1
            const unsigned long long t0_ = __builtin_amdgcn_s_memrealtime();
#endif
            if (is_ssm) ssm_item(item, WSP(bf16_t, WS_U), WSP(bf16_t, WS_KTAB), WSP(bf16_t, WS_PEND), WSP(bf16_t, WS_CC), WSP(float, WS_AP), WSP(bf16_t, WS_Y), lds, tid, WSP(unsigned, WS_CTL) + 13400 + (item >> 5));
            else { const int a_ = item - 64; int kind, bh, qb;
                if (a_ < 64) { kind = 2; bh = BHMAP(a_ & 15); qb = 19 - (a_ >> 4); }
                else if (a_ < 64 + 576) { const int c_ = a_ - 64, lvl = c_ / 48, r_ = c_ % 48; kind = r_ >> 4; bh = BHMAP(r_ & 15); qb = kind < 2 ? 31 - lvl : 15 - lvl; }
                else { const int c_ = a_ - 640; kind = 2; bh = BHMAP(c_ & 15); qb = 3 - (c_ >> 4); }
                const int ntf = 4 * (qb + 1), tm = ntf >> 1, tb = kind == 0 ? tm : 0, te = kind == 1 ? tm : ntf, mode = kind == 2 ? 0 : (kind == 0 ? 2 : 1), sid = kind < 2 ? (qb - 20) * 16 + bh : 0;
                attn_body::attn_unit<96>(bh >> 3, bh & 7, qb, tb, te, mode, (sid < 60 ? WSP(float, 180 * MiB) + (size_t)sid * PARTF : sid < 105 ? WSP(float, WS_W2B) + (size_t)(sid - 60) * PARTF : WSP(float, 236 * MiB) + (size_t)(sid - 105) * PARTF), WSP(unsigned, WS_CTL) + 12288 + sid, WSP(unsigned, WS_CTL) + 13312 + 2 * bh,
                    WSP(attn_body::bf16, WS_Q), WSP(attn_body::bf16, WS_K), WSP(attn_body::bf16, WS_V), WSP(attn_body::bf16, WS_Q), WSP(float, WS_LOGF), WSP(float, WS_SSQA), (char*)lds_raw, tid); }
#ifdef PROBE_SEL1
            if (tid == 0) { const unsigned d_ = (unsigned)(__builtin_amdgcn_s_memrealtime() - t0_); atomicMax(WSP(unsigned, WS_CTL) + (is_ssm ? 128 : 129), d_); if (is_ssm) atomicMin(WSP(unsigned, WS_CTL) + 130, ~d_); }
#endif
        }
    }
    GSYNC(); STAMP();
    {
        { IDS(); pg8::Gemm gm{WSP(bf16_t, WS_Q), WSP(bf16_t, WS_WOA), TOK, DMODEL, DMODEL, WSP(bf16_t, WS_SSMO), HW}; pg8::StaticOrder S; S.init(TOK, DMODEL, G, bx);
          EpiOut E{WSP(bf16_t, WS_XB), WSP(float, WS_SSQ2), WSP(float, WS_SSQA), WSP(float, WS_SSQS)};
          pg8::gemm_phase<EpiOut, pg8::StaticOrder, true, true>(lds, gm, S, E, tid); }
    }
    GSYNC(); STAMP();
    {
        IDS();
        pg8::Gemm gm{WSP(bf16_t, WS_XB), WSP(bf16_t, WS_W13B), TOK, 2 * DFF, DMODEL}; pg8::StaticOrder S; S.init(TOK, 2 * DFF, G, bx);
        EpiSwiglu E{WSP(bf16_t, WS_H1), WSP(float, WS_SSQ2)};
        pg8::gemm_phase<EpiSwiglu, pg8::StaticOrder, true, true>(lds, gm, S, E, tid);
    }
    if ((int)blockIdx.x >= (int)gridDim.x / 2) {
        IDS();
        const float *w2_b = INP(25), *g_ple = INP(26), *w_ple_gate = INP(27); bf16_t *W2b = WSP(bf16_t, WS_W2B), *Wg = WSP(bf16_t, WS_WG);
        LAS float* scr = (LAS float*)(lds + wave * 16384);
        constexpr int I_2 = 44 * 32, I_G = 16 * 32;
        for (int it = (bx - G / 2) * 8 + wave; it < I_2 + I_G; it += (G - G / 2) * 8) {
            int r = it;
            if (r < I_2) { tr_item(w2_b, DMODEL, 64 * (r / 32), 32 * (r % 32), nullptr, W2b, DFF, 32 * (r % 32), scr, lane); continue; } r -= I_2;
            tr_item(w_ple_gate, DMODEL, 64 * (r / 32), 32 * (r % 32), g_ple, Wg, DMODEL, 32 * (r % 32), scr, lane);
        }
    }
    GSYNC(); STAMP();
    {
        IDS();
        pg8::Gemm gm{WSP(bf16_t, WS_H1), WSP(bf16_t, WS_W2B), TOK, DMODEL, DFF}; pg8::StaticOrder S; S.init(TOK, DMODEL, G, bx);
        EpiRes<false, true> E{nullptr, WSP(bf16_t, WS_XB), WSP(float, WS_SSQ3), nullptr, 0.5f};
        pg8::gemm_phase<EpiRes<false, true>, pg8::StaticOrder, true, true>(lds, gm, S, E, tid);
    }
    GSYNC(); STAMP();
    {
        if ((int)gridDim.x == 256) { IDS(); pg8::Gemm gm{WSP(bf16_t, WS_XB), WSP(bf16_t, WS_WG), TOK, DMODEL, DMODEL}; pg8::StaticOrder S; S.init(TOK, DMODEL, G, bx);
          EpiGateFinal E{WSP(bf16_t, WS_XB), OUTP, WSP(bf16_t, WS_PP), WSP(float, WS_SSQ3), WSP(float, WS_SSQ4), WSP(unsigned, WS_CTL) + 4608, INP(29)};
          pg8::gemm_phase<EpiGateFinal, pg8::StaticOrder, true, true>(lds, gm, S, E, tid); }
        else { IDS(); pg8::Gemm gm{WSP(bf16_t, WS_XB), WSP(bf16_t, WS_WG), TOK, DMODEL, DMODEL}; pg8::StaticOrder S; S.init(TOK, DMODEL, G, bx);
          EpiGate E{WSP(bf16_t, WS_XB), OUTP, WSP(bf16_t, WS_PP), WSP(float, WS_SSQ3), WSP(float, WS_SSQ4)};
          pg8::gemm_phase<EpiGate, pg8::StaticOrder, true, true>(lds, gm, S, E, tid); }
    }
    if ((int)gridDim.x != 256) {
    GSYNC(); STAMP();
    { IDS(); const float* ssq4 = WSP(float, WS_SSQ4); float* out = OUTP; const float* g_final = INP(29);
    for (int m = gw; m < TOK; m += NGW) {
        const float rs = rstd_row<16>(ssq4, m, 1.f / 1024.f); f32x4* o = (f32x4*)(out + (size_t)m * DMODEL) + lane; const f32x4* gf = (const f32x4*)g_final + lane;
#pragma unroll
        for (int j = 0; j < 4; ++j) { const f32x4 v = o[64 * j], gg = gf[64 * j]; o[64 * j] = v * rs * gg; }
    } }
    }
#ifdef PROBE_SEL1
    GSYNC(); STAMP();
    if (blockIdx.x == 0) { IDS(); const unsigned long long* ts_ = (const unsigned long long*)(ap_->ws + 1024); const unsigned* cw = WSP(unsigned, WS_CTL);
        float dur[15];
#pragma unroll
        for (int k = 0; k < 11; ++k) dur[k] = (float)(ts_[k + 1] - ts_[k]) * 0.01f;
        dur[11] = (float)cw[128] * 0.01f; dur[12] = (float)cw[129] * 0.01f; dur[13] = (float)(~cw[130]) * 0.01f; dur[14] = (float)(ts_[11] - ts_[0]) * 0.01f;
        float t1 = 0.f, t2 = 0.f;
#pragma unroll
        for (int k = 0; k < 15; ++k) { if (k == PROBE_SEL1) t1 = dur[k]; if (k == PROBE_SEL2) t2 = dur[k]; }
        if (tid == 0) OUTP[0] += t1 * 0.01f;
        for (int r = tid; r < 1024; r += 512) OUTP[(size_t)(r * 16) * DMODEL + 1] += t2 * 0.01f; }
#endif
}

extern "C" void kernel_launch(void* const* d_in, const int* in_sizes, int n_in, void* d_out, int out_size, void* d_ws, size_t ws_size, hipStream_t stream) {
    static int grid = 0;
    if (grid == 0) {
        if (n_in != 30 || out_size != TOK * DMODEL || ws_size < WS_END) { fprintf(stderr, "kernel_launch: unexpected problem (n_in %d out %d ws %zu)\n", n_in, out_size, ws_size); grid = -1; return; }
        int dev = 0, cus = 0, per_cu = 0;
        (void)hipGetDevice(&dev); (void)hipDeviceGetAttribute(&cus, hipDeviceAttributeMultiprocessorCount, dev);
        if (hipFuncSetAttribute((const void*)mk_fwd, hipFuncAttributeMaxDynamicSharedMemorySize, LDS_BYTES) != hipSuccess) { fprintf(stderr, "kernel_launch: hipFuncSetAttribute failed\n"); grid = -1; return; }
        if (hipOccupancyMaxActiveBlocksPerMultiprocessor(&per_cu, (const void*)mk_fwd, 512, LDS_BYTES) != hipSuccess || per_cu < 1) { fprintf(stderr, "kernel_launch: occupancy query gave %d\n", per_cu); per_cu = 1; }
        (void)hipGetLastError();
        grid = cus * per_cu;
    }
    if (grid < 0) return;
    Args a{};
    for (int i = 0; i < 30; ++i) a.in[i] = (const float*)d_in[i];
    a.out = (float*)d_out; a.ws = (unsigned char*)d_ws;
    void* args[] = {&a};
    hipError_t e = hipLaunchCooperativeKernel((const void*)mk_fwd, dim3(grid), dim3(512), args, LDS_BYTES, stream);
    if (e != hipSuccess) fprintf(stderr, "kernel_launch: cooperative launch failed: %s (grid %d)\n", hipGetErrorString(e), grid);
}
```

```cpp
#include <hip/hip_runtime.h>
#include <hip/hip_bf16.h>
#include <cmath>
#include <hip/hip_cooperative_groups.h>
#include <cstdio>
#include <cstdint>
namespace cg = cooperative_groups;
template <int MASK> __device__ __forceinline__ float sx(float v) { return __builtin_bit_cast(float, __builtin_amdgcn_ds_swizzle(__builtin_bit_cast(int, v), (MASK << 10) | 0x1f)); }
__device__ __forceinline__ float sum32(float v) { unsigned a = __builtin_bit_cast(unsigned, v), b = a; asm volatile("v_nop\n\tv_nop\n\tv_permlane32_swap_b32 %0, %1" : "+v"(a), "+v"(b)); return __builtin_bit_cast(float, a) + __builtin_bit_cast(float, b); }
__device__ __forceinline__ float max32(float v) { unsigned a = __builtin_bit_cast(unsigned, v), b = a; asm volatile("v_nop\n\tv_nop\n\tv_permlane32_swap_b32 %0, %1" : "+v"(a), "+v"(b)); return __builtin_fmaxf(__builtin_bit_cast(float, a), __builtin_bit_cast(float, b)); }
namespace pg8 {
#define PG8_LAS __attribute__((address_space(3)))
typedef unsigned short bf16_t;
typedef short bf16x8 __attribute__((ext_vector_type(8)));
typedef float f32x4 __attribute__((ext_vector_type(4)));
typedef unsigned u32x4 __attribute__((ext_vector_type(4)));
constexpr int BM = 256, BK = 64, HALF = 128, HTB = HALF * BK * 2  , STAGE_BYTES = 8 * HTB, NXCD = 8, WGM = 8;

__host__ __device__ __forceinline__ int lds_byte(int r, int c) { const int st = (r >> 4) * 2 + (c >> 5), rr = r & 15, cc = c & 31, ob = rr * 64 + cc * 2; return st * 1024 + (ob ^ (((ob >> 9) & 1) << 5)); }
__host__ __device__ __forceinline__ void stage_rc(int b, int& R, int& C) { const int st = b / 1024, sb = b % 1024, swz = sb ^ (((sb >> 9) & 1) << 5); R = (st >> 1) * 16 + swz / 64; C = (st & 1) * 32 + (swz % 64) / 2; }
__host__ __device__ __forceinline__ int perm32(int rho) { const int n = rho >> 4, i = rho & 15; return 8 * (i >> 2) + 4 * n + (i & 3); }

struct Unit { int pm, pn; };
struct Gemm { const bf16_t* A; const bf16_t* Bt; int M, N, K; const bf16_t* A2 = nullptr; int lda = 0; };

struct StaticOrder {
    int nM, nN, nwg, G, c;
    __host__ __device__ void init(int M, int N, int G_, int c_) { nM = M / BM; nN = N / BM; nwg = nM * nN; G = G_; c = c_; }
    __host__ __device__ bool next(int i, Unit& u) const {
        const long L = (long)i * G + c; if (L >= nwg) return false;
        int wgid = (int)L; { const int q = nwg / NXCD, r = nwg % NXCD, xcd = wgid % NXCD, off = wgid / NXCD; wgid = (xcd < r ? xcd * (q + 1) : r * (q + 1) + (xcd - r) * q) + off; }
        const int nig = WGM * nN, gid = wgid / nig, fm = gid * WGM, gsz = (nM - fm) < WGM ? (nM - fm) : WGM;
        u.pm = fm + ((wgid % nig) % gsz); u.pn = (wgid % nig) / gsz; return true;
    }
    __device__ __forceinline__ void a_ready(const Unit&) const {}
    __device__ __forceinline__ void done(const Unit&) const {}
};

__device__ __forceinline__ unsigned cvt_pk_bf16(float lo, float hi) { unsigned r; asm volatile("v_cvt_pk_bf16_f32 %0, %1, %2" : "=v"(r) : "v"(lo), "v"(hi)); return r; }
typedef float f32x2 __attribute__((ext_vector_type(2)));
template <class Epi, class Sched, bool ALIGN_EPI = false, bool SP2 = false>
__device__ __forceinline__ void gemm_phase(PG8_LAS unsigned char* lds, const Gemm g, const Sched& S, const Epi& E, int tid_in) {
    int tid_ = tid_in; asm volatile("" : "+v"(tid_)); const int tid = tid_, wid = __builtin_amdgcn_readfirstlane(tid >> 6), lane = tid & 63, wr = wid >> 2, wc = wid & 3, fr = lane & 15, fq = lane >> 4;
    const int K = g.K, nt = K / BK, lda = g.lda ? g.lda : K, ksplit = g.A2 ? nt / 2 : nt;
    unsigned voffA[2], voffB[2];
#pragma unroll
    for (int i = 0; i < 2; ++i) { int R, C; stage_rc(tid * 16 + i * 8192, R, C); const int Rb = Epi::PERM ? ((R & ~31) + perm32(R & 31)) : R;
        voffA[i] = (unsigned)(R * lda + C) * 2u; voffB[i] = (unsigned)(Rb * K + C) * 2u; }
    const size_t kstep = (size_t)(BK * 2);
    const size_t hstep = (size_t)HALF * K * 2;
    const size_t tstep = 2 * hstep; const size_t hstepA = (size_t)HALF * lda * 2, tstepA = 2 * hstepA;
    const unsigned ldsw = (unsigned)wid * 1024u;
    const int aoff = lds_byte(wr * 64 + fr, fq * 8), boff = lds_byte(wc * 32 + fr, fq * 8);
#define PG8_SA(b, h) (((b) * 2 + (h)) * HTB)
#define PG8_SB(b, h) ((4 + (b) * 2 + (h)) * HTB)
#define PG8_STAGE(bufoff, gbase, voff) do { _Pragma("unroll") for (int _i = 0; _i < 2; ++_i) \
        __builtin_amdgcn_global_load_lds((const unsigned*)((const char*)(gbase) + (voff)[_i]), (PG8_LAS unsigned*)(lds + (bufoff) + ldsw + _i * 8192), 16, 0, 0); } while (0)
#define PG8_LDA(dst, b, h) do { _Pragma("unroll") for (int m = 0; m < 4; ++m) _Pragma("unroll") for (int k = 0; k < 2; ++k) dst[m][k] = *(const PG8_LAS bf16x8*)(lds + PG8_SA(b, h) + aoff + m * 2048 + k * 1024); } while (0)
#define PG8_LDB(dst, b, h) do { _Pragma("unroll") for (int n = 0; n < 2; ++n) _Pragma("unroll") for (int k = 0; k < 2; ++k) dst[n][k] = *(const PG8_LAS bf16x8*)(lds + PG8_SB(b, h) + boff + n * 2048 + k * 1024); } while (0)
#define PG8_MMA(ai, bj, At, Bt) do { __builtin_amdgcn_s_setprio(1); _Pragma("unroll") for (int m = 0; m < 4; ++m) _Pragma("unroll") for (int n = 0; n < 2; ++n) _Pragma("unroll") for (int k = 0; k < 2; ++k) \
        acc[ai][bj][m][n] = __builtin_amdgcn_mfma_f32_16x16x32_bf16(Bt[n][k], At[m][k], acc[ai][bj][m][n], 0, 0, 0); __builtin_amdgcn_s_setprio(0); } while (0)
#define PG8_WAIT_V(n) asm volatile("s_waitcnt vmcnt(" #n ")" ::: "memory")
#define PG8_WAIT_L(n) asm volatile("s_waitcnt lgkmcnt(" #n ")" ::: "memory")
#define PG8_BAR __builtin_amdgcn_s_barrier()
#define PG8_SCHED __builtin_amdgcn_sched_barrier(0)
    Unit cur, nxt; int ui = 0;
    if (!S.next(0, cur)) return;
    f32x4 acc[2][2][4][2];
#pragma unroll
    for (int a = 0; a < 2; ++a)
#pragma unroll
        for (int b = 0; b < 2; ++b)
#pragma unroll
            for (int m = 0; m < 4; ++m)
#pragma unroll
                for (int n = 0; n < 2; ++n) acc[a][b][m][n] = (f32x4){0.f, 0.f, 0.f, 0.f};
    bf16x8 At[4][2], B0[2][2], B1[2][2];
    const char* cA = (const char*)g.A + (size_t)cur.pm * tstepA; const char* cA2 = (const char*)g.A2 + (size_t)cur.pm * tstepA; const char* cB = (const char*)g.Bt + (size_t)cur.pn * tstep;
    S.a_ready(cur);
    if constexpr (SP2) {
        PG8_STAGE(PG8_SB(0, 0), cB, voffB); PG8_STAGE(PG8_SB(0, 1), cB + hstep, voffB); PG8_STAGE(PG8_SA(0, 0), cA, voffA); PG8_STAGE(PG8_SA(0, 1), cA + hstepA, voffA);
        if (wr == 1) PG8_BAR;
        PG8_WAIT_V(2); PG8_BAR;
        PG8_STAGE(PG8_SB(1, 0), cB + kstep, voffB); PG8_STAGE(PG8_SA(1, 0), cA + kstep, voffA); PG8_STAGE(PG8_SB(1, 1), cB + hstep + kstep, voffB);
        PG8_WAIT_V(6); PG8_BAR;
    } else {
        PG8_STAGE(PG8_SB(0, 0), cB, voffB); PG8_STAGE(PG8_SA(0, 0), cA, voffA); PG8_STAGE(PG8_SB(0, 1), cB + hstep, voffB); PG8_STAGE(PG8_SA(0, 1), cA + hstepA, voffA);
        if (wr == 1) PG8_BAR;
        PG8_WAIT_V(4); PG8_BAR;
        PG8_STAGE(PG8_SB(1, 0), cB + kstep, voffB); PG8_STAGE(PG8_SA(1, 0), cA + kstep, voffA); PG8_STAGE(PG8_SB(1, 1), cB + hstep + kstep, voffB);
        PG8_WAIT_V(6); PG8_BAR;
    }
    for (;;) {
        const bool has_next = S.next(ui + 1, nxt);
        const char* nA = has_next ? (const char*)g.A + (size_t)nxt.pm * tstepA : cA; const char* nA2 = has_next ? (const char*)g.A2 + (size_t)nxt.pm * tstepA : cA2; const char* nB = has_next ? (const char*)g.Bt + (size_t)nxt.pn * tstep : cB;
        for (int t = 0; t < nt; t += 2) {
            const bool last = (t == nt - 2);
            const char* a1 = (t + 1 < ksplit) ? cA + (size_t)(t + 1) * kstep : cA2 + (size_t)(t + 1 - ksplit) * kstep;
            const char* a2 = last ? nA : ((t + 2 < ksplit) ? cA + (size_t)(t + 2) * kstep : cA2 + (size_t)(t + 2 - ksplit) * kstep); const char* b2 = last ? nB : cB + (size_t)(t + 2) * kstep;
            const char* a3 = a2 + kstep; const char* b3 = b2 + kstep;
            if (last && has_next) S.a_ready(nxt);
            if constexpr (Epi::MIDK) { if (t == nt / 2) { int l_; asm volatile("v_mbcnt_lo_u32_b32 %0, -1, 0\n\tv_mbcnt_hi_u32_b32 %0, -1, %0" : "=v"(l_)); E.mid(acc, cur, wr, wc, l_ & 15, l_ >> 4); } }
            if constexpr (SP2) {
            PG8_LDB(B0, 0, 0); PG8_LDB(B1, 0, 1); PG8_SCHED; PG8_LDA(At, 0, 0); PG8_STAGE(PG8_SA(1, 1), a1 + hstepA, voffA);
            PG8_WAIT_V(8); PG8_WAIT_L(0); PG8_BAR; PG8_MMA(0, 0, At, B0); PG8_MMA(0, 1, At, B1); PG8_BAR; PG8_SCHED;
            PG8_LDA(At, 0, 1); PG8_STAGE(PG8_SB(0, 0), b2, voffB); PG8_STAGE(PG8_SB(0, 1), b2 + hstep, voffB); PG8_STAGE(PG8_SA(0, 0), a2, voffA);
            PG8_WAIT_V(8); PG8_WAIT_L(0); PG8_BAR; PG8_MMA(1, 0, At, B0); PG8_MMA(1, 1, At, B1); PG8_BAR; PG8_SCHED;
            PG8_LDB(B0, 1, 0); PG8_LDB(B1, 1, 1); PG8_SCHED; PG8_LDA(At, 1, 0); PG8_STAGE(PG8_SA(0, 1), a2 + hstepA, voffA);
            PG8_WAIT_V(8); PG8_WAIT_L(0); PG8_BAR; PG8_MMA(0, 0, At, B0); PG8_MMA(0, 1, At, B1); PG8_BAR; PG8_SCHED;
            PG8_LDA(At, 1, 1); PG8_STAGE(PG8_SB(1, 0), b3, voffB); PG8_STAGE(PG8_SB(1, 1), b3 + hstep, voffB); PG8_STAGE(PG8_SA(1, 0), a3, voffA);
            PG8_WAIT_V(8); PG8_WAIT_L(0); PG8_BAR; PG8_MMA(1, 0, At, B0); PG8_MMA(1, 1, At, B1); PG8_BAR; PG8_SCHED;
            } else {
            PG8_LDB(B0, 0, 0); PG8_SCHED; PG8_LDA(At, 0, 0); PG8_STAGE(PG8_SA(1, 1), a1 + hstepA, voffA);
            PG8_WAIT_L(8); PG8_BAR; PG8_WAIT_L(0); PG8_MMA(0, 0, At, B0); PG8_BAR; PG8_SCHED;
            PG8_LDB(B1, 0, 1); PG8_STAGE(PG8_SB(0, 0), b2, voffB);
            PG8_BAR; PG8_WAIT_L(0); PG8_MMA(0, 1, At, B1); PG8_BAR;
            PG8_LDA(At, 0, 1); PG8_STAGE(PG8_SA(0, 0), a2, voffA);
            PG8_BAR; PG8_WAIT_L(0); PG8_MMA(1, 0, At, B0); PG8_BAR; PG8_SCHED;
            PG8_STAGE(PG8_SB(0, 1), b2 + hstep, voffB);
            PG8_WAIT_V(6); PG8_BAR; PG8_MMA(1, 1, At, B1); PG8_BAR;
            PG8_LDB(B0, 1, 0); PG8_SCHED; PG8_LDA(At, 1, 0); PG8_STAGE(PG8_SA(0, 1), a2 + hstepA, voffA);
            PG8_WAIT_L(8); PG8_BAR; PG8_WAIT_L(0); PG8_MMA(0, 0, At, B0); PG8_BAR; PG8_SCHED;
            PG8_LDB(B1, 1, 1); PG8_STAGE(PG8_SB(1, 0), b3, voffB);
            PG8_BAR; PG8_WAIT_L(0); PG8_MMA(0, 1, At, B1); PG8_BAR;
            PG8_LDA(At, 1, 1); PG8_STAGE(PG8_SA(1, 0), a3, voffA);
            PG8_BAR; PG8_WAIT_L(0); PG8_MMA(1, 0, At, B0); PG8_BAR; PG8_SCHED;
            PG8_STAGE(PG8_SB(1, 1), b3 + hstep, voffB);
            PG8_WAIT_V(6); PG8_BAR; PG8_MMA(1, 1, At, B1); PG8_BAR;
            }
        }
        if constexpr (ALIGN_EPI) { if (wr == 0) PG8_BAR; }
        if constexpr (!Epi::AFTER_DRAIN) { int l_; asm volatile("v_mbcnt_lo_u32_b32 %0, -1, 0\n\tv_mbcnt_hi_u32_b32 %0, -1, %0" : "=v"(l_)); E(acc, cur, wr, wc, l_ & 15, l_ >> 4); S.done(cur); }
        if (!has_next) break;
#pragma unroll
        for (int a = 0; a < 2; ++a)
#pragma unroll
            for (int b = 0; b < 2; ++b)
#pragma unroll
                for (int m = 0; m < 4; ++m)
#pragma unroll
                    for (int n = 0; n < 2; ++n) acc[a][b][m][n] = (f32x4){0.f, 0.f, 0.f, 0.f};
        cur = nxt; cA = nA; cA2 = nA2; cB = nB; ++ui;
        if constexpr (ALIGN_EPI) { if (wr == 1) PG8_BAR; }
    }
    PG8_WAIT_V(0);
    if constexpr (!ALIGN_EPI) { if (wr == 0) PG8_BAR; }
    PG8_BAR;
    if constexpr (Epi::AFTER_DRAIN) { E.fused(acc, cur, wr, wc, fr, fq, lds, wid, lane); S.done(cur); }
#undef PG8_SA
#undef PG8_SB
#undef PG8_STAGE
#undef PG8_LDA
#undef PG8_LDB
#undef PG8_MMA
#undef PG8_WAIT_V
#undef PG8_WAIT_L
#undef PG8_BAR
#undef PG8_SCHED
}
}

#ifndef PG8_SP2
#define PG8_SP2 true
#endif
#ifndef PG8_ALIGN
#define PG8_ALIGN true
#endif
#include <hip/hip_bf16.h>
#include <cmath>
namespace attn_body {
using bf16=__hip_bfloat16;
using bf16x8=__attribute__((ext_vector_type(8)))short;
using s16x4=__attribute__((ext_vector_type(4)))short;
using f32x16=__attribute__((ext_vector_type(16)))float;
using u32x4=__attribute__((ext_vector_type(4)))unsigned;
using f32x4v=__attribute__((ext_vector_type(4)))float;
constexpr int BATCH=2,NHEAD=8,SEQ=8192,D=64,DM=NHEAD*D;
constexpr int NW=8,QBLK=32,QB=QBLK*NW,KVBLK=64,NQB=SEQ/QB;
constexpr int ATTN_PITCH=DM, ATTN_UNIT_ROWS=QB;
__device__ __forceinline__ int crow(int r,int hi){return (r&3)+8*(r>>2)+4*hi;}
#define SBAR() __builtin_amdgcn_sched_barrier(0)
__device__ __forceinline__ void cmask(f32x16&p0,f32x16&p1,int jb,int qrel,int hi){
  const float NEG=-INFINITY; int kb=64*jb+4*hi;
  #pragma unroll
  for(int r=0;r<16;++r){int kv=kb+(r&3)+8*(r>>2); if(kv>qrel)p0[r]=NEG; if(kv+32>qrel)p1[r]=NEG;}
}

constexpr int NSLOT=3, SLOTB=8192;
constexpr int LDS_K=0, LDS_V=NSLOT*SLOTB, LDS_WS=2*NSLOT*SLOTB, LDS_OST=LDS_WS+NW*64*4, LDS_BIAS=LDS_OST+NW*4096, LDS_WT=LDS_BIAS+SEQ*4, LDS_BYTES=LDS_WT+64;
constexpr float C2=0.125f*1.4426950408889634f;
__device__ __forceinline__ void glds16(const void*gsrc,unsigned lds_dst){unsigned keep;
  asm volatile("s_mov_b32 %0, m0\n\ts_mov_b32 m0, %2\n\ts_nop 0\n\tglobal_load_lds_dwordx4 %1, off\n\ts_mov_b32 m0, %0":"=&s"(keep):"v"(gsrc),"s"(lds_dst):"memory");}
__device__ __forceinline__ float max3f(float a,float b,float c){float r;asm("v_max3_f32 %0, %1, %2, %3":"=v"(r):"v"(a),"v"(b),"v"(c));return r;}
__device__ __forceinline__ float max2f(float a,float b){float r;asm("v_max_f32_e32 %0, %1, %2":"=v"(r):"v"(a),"v"(b));return r;}
__device__ __forceinline__ float fadd_s(float a,float b){float r;asm("v_add_f32_e32 %0, %1, %2":"=v"(r):"v"(a),"v"(b));return r;}
__device__ __forceinline__ float fsub_s(float a,float b){float r;asm("v_sub_f32_e32 %0, %1, %2":"=v"(r):"v"(a),"v"(b));return r;}
typedef float f32x2_t __attribute__((ext_vector_type(2))); typedef __bf16 bf16x2_t __attribute__((ext_vector_type(2)));
__device__ __forceinline__ unsigned cvtpk_s(float lo,float hi){f32x2_t v={lo,hi};bf16x2_t b=__builtin_convertvector(v,bf16x2_t);return __builtin_bit_cast(unsigned,b);}
#define WAIT_BAR(N) asm volatile("s_waitcnt vmcnt(" #N ") lgkmcnt(0)\n\ts_barrier":::"memory")

__device__ __forceinline__ void qkt(f32x16&p0,f32x16&p1,const char*Kslot,const bf16x8*qr,int r32,int hi){
  const char*kb=Kslot+hi*1024+r32*16;
  #pragma unroll
  for(int d0=0;d0<4;++d0){
    const bf16x8 b0=*reinterpret_cast<const bf16x8*>(kb+d0*2048);
    const bf16x8 b1=*reinterpret_cast<const bf16x8*>(kb+d0*2048+512);
    p0=__builtin_amdgcn_mfma_f32_32x32x16_bf16(b0,qr[d0],p0,0,0,0);p1=__builtin_amdgcn_mfma_f32_32x32x16_bf16(b1,qr[d0],p1,0,0,0);}
}
typedef __attribute__((address_space(3))) const char* lds_cptr;
typedef short v4i16_t __attribute__((ext_vector_type(4)));
__device__ __forceinline__ void kload8(bf16x8*kf,lds_cptr kp){
  kf[0]=*(const __attribute__((address_space(3))) bf16x8*)(kp);      kf[1]=*(const __attribute__((address_space(3))) bf16x8*)(kp+512);
  kf[2]=*(const __attribute__((address_space(3))) bf16x8*)(kp+2048); kf[3]=*(const __attribute__((address_space(3))) bf16x8*)(kp+2560);
  kf[4]=*(const __attribute__((address_space(3))) bf16x8*)(kp+4096); kf[5]=*(const __attribute__((address_space(3))) bf16x8*)(kp+4608);
  kf[6]=*(const __attribute__((address_space(3))) bf16x8*)(kp+6144); kf[7]=*(const __attribute__((address_space(3))) bf16x8*)(kp+6656);
}
__device__ __forceinline__ void kload2(bf16x8*kf,lds_cptr kp,int j){ kf[2*j]=*(const __attribute__((address_space(3))) bf16x8*)(kp+j*2048); kf[2*j+1]=*(const __attribute__((address_space(3))) bf16x8*)(kp+j*2048+512); }
__device__ __forceinline__ s16x4 vtr(lds_cptr p){ return __builtin_bit_cast(s16x4,__builtin_amdgcn_ds_read_tr16_b64_v4i16((__attribute__((address_space(3))) v4i16_t*)p)); }
__device__ __forceinline__ float rowmax(const f32x16&p0,const f32x16&p1){
  float a=max3f(p0[0],p0[1],p1[0]),b=max3f(p0[2],p0[3],p1[1]);a=max3f(a,p1[2],p1[3]);
  #pragma unroll
  for(int r=4;r<16;r+=4){a=max3f(a,p0[r],p0[r+1]);b=max3f(b,p0[r+2],p0[r+3]);a=max3f(a,p1[r],p1[r+1]);b=max3f(b,p1[r+2],p1[r+3]);}
  const float m=max2f(a,b);
  auto rr=__builtin_amdgcn_permlane32_swap(__float_as_uint(m),__float_as_uint(m),false,false);
  return max2f(__uint_as_float(rr[0]),__uint_as_float(rr[1]));
}
__device__ __forceinline__ void pv(f32x16*o,int vb,bf16x8 pa0,bf16x8 pa1,bf16x8 pa2,bf16x8 pa3){
  #pragma unroll
  for(int d0=0;d0<2;++d0){s16x4 lo[4],hi[4];
    #pragma unroll
    for(int ks=0;ks<4;++ks){
      asm volatile("ds_read_b64_tr_b16 %0,%1 offset:%c2":"=&v"(lo[ks]):"v"(vb),"i"(d0*4096+ks*1024):"memory");
      asm volatile("ds_read_b64_tr_b16 %0,%1 offset:%c2":"=&v"(hi[ks]):"v"(vb),"i"(d0*4096+ks*1024+512):"memory");}
    asm volatile("s_waitcnt lgkmcnt(0)":::"memory");SBAR();
    #define PK(k) (bf16x8){lo[k][0],lo[k][1],lo[k][2],lo[k][3],hi[k][0],hi[k][1],hi[k][2],hi[k][3]}
    o[d0]=__builtin_amdgcn_mfma_f32_32x32x16_bf16(pa0,PK(0),o[d0],0,0,0);
    o[d0]=__builtin_amdgcn_mfma_f32_32x32x16_bf16(pa1,PK(1),o[d0],0,0,0);
    o[d0]=__builtin_amdgcn_mfma_f32_32x32x16_bf16(pa2,PK(2),o[d0],0,0,0);
    o[d0]=__builtin_amdgcn_mfma_f32_32x32x16_bf16(pa3,PK(3),o[d0],0,0,0);
    #undef PK
  }
}

#ifndef ATTN_STORE16
#define ATTN_STORE16(p,v) (*(u32x4*)(p)=(v))
#endif
template<int THRL> __device__ __forceinline__ void attn_unit(int b,int h,int qb,int tb_in,int te,int mode,float*__restrict__ part,unsigned*pcnt,const unsigned*kmaxp,const bf16*Q,const bf16*__restrict__ K,const bf16*__restrict__ V,bf16*O,const float*__restrict__ logf,float*__restrict__ ssqA,char*shm,int tid_in){
  int tid_=tid_in; asm volatile("":"+v"(tid_)); const int tid=tid_,lane=tid&63,r32=lane&31,hi=lane>>5; const int wid=__builtin_amdgcn_readfirstlane(tid>>6);
  const long rowbase=(long)b*SEQ; const int q0=qb*QB;
  const bf16*Qw=Q+(rowbase+q0+wid*QBLK)*DM+h*D;
  const lds_cptr shm3=(lds_cptr)shm;
  typedef __attribute__((address_space(3))) float* lds_fptr; typedef __attribute__((address_space(3))) f32x4v* lds_f4ptr;
  const lds_fptr biasL=(lds_fptr)(shm3+LDS_BIAS); const lds_fptr wtot=(lds_fptr)(shm3+LDS_WT);
  bf16x8 qr[4];
  #pragma unroll
  for(int d0=0;d0<4;++d0)qr[d0]=*reinterpret_cast<const bf16x8*>(&Qw[(long)r32*DM+d0*16+hi*8]);
  float qn=0.f;
  #pragma unroll
  for(int d0=0;d0<4;++d0){
    #pragma unroll
    for(int e=0;e<8;++e){const float qv=__uint_as_float(((unsigned)(unsigned short)qr[d0][e])<<16);qn+=qv*qv;}}
  qn=sum32(qn);
  qn=__builtin_fmaxf(qn,sx<1>(qn));qn=__builtin_fmaxf(qn,sx<2>(qn));qn=__builtin_fmaxf(qn,sx<4>(qn));qn=__builtin_fmaxf(qn,sx<8>(qn));qn=__builtin_fmaxf(qn,sx<16>(qn));
  { const int nkeys=q0+QB; const int k0=tid*16; const float*lf=logf+(long)(b*NHEAD+h)*SEQ+k0;
    f32x4v v0={0.f,0.f,0.f,0.f},v1=v0,v2=v0,v3=v0;
    if(k0<nkeys){v0=*(const f32x4v*)(lf);v1=*(const f32x4v*)(lf+4);v2=*(const f32x4v*)(lf+8);v3=*(const f32x4v*)(lf+12);}
    const float tot=((v0[0]+v0[1])+(v0[2]+v0[3]))+((v1[0]+v1[1])+(v1[2]+v1[3]))+((v2[0]+v2[1])+(v2[2]+v2[3]))+((v3[0]+v3[1])+(v3[2]+v3[3]));
    float x=tot;
    #pragma unroll
    for(int off=1;off<64;off<<=1){const float y=__builtin_bit_cast(float,__builtin_amdgcn_ds_bpermute(((lane+off)&63)<<2,__builtin_bit_cast(int,x)));if(lane+off<64)x+=y;}
    if(lane==0){wtot[wid]=x;wtot[8+wid]=qn;}
    __syncthreads();
    float wsum=0.f;
    #pragma unroll
    for(int w=1;w<NW;++w){const float t_=wtot[w];if(w>wid)wsum+=t_;}
    float run=(x-tot)+wsum;
    if(k0<nkeys){ const float L2E=1.4426950408889634f; f32x4v o0,o1,o2,o3;
      o3[3]=run*L2E;run+=v3[3];o3[2]=run*L2E;run+=v3[2];o3[1]=run*L2E;run+=v3[1];o3[0]=run*L2E;run+=v3[0];
      o2[3]=run*L2E;run+=v2[3];o2[2]=run*L2E;run+=v2[2];o2[1]=run*L2E;run+=v2[1];o2[0]=run*L2E;run+=v2[0];
      o1[3]=run*L2E;run+=v1[3];o1[2]=run*L2E;run+=v1[2];o1[1]=run*L2E;run+=v1[1];o1[0]=run*L2E;run+=v1[0];
      o0[3]=run*L2E;run+=v0[3];o0[2]=run*L2E;run+=v0[2];o0[1]=run*L2E;run+=v0[1];o0[0]=run*L2E;
      lds_f4ptr bo=(lds_f4ptr)(biasL+k0); bo[0]=o0;bo[1]=o1;bo[2]=o2;bo[3]=o3; }
    __syncthreads(); }
  int tb=tb_in; bool emptyA=false;
  { float qmx=wtot[8];
    #pragma unroll
    for(int w=1;w<NW;++w)qmx=__builtin_fmaxf(qmx,wtot[8+w]);
    const float kmx=__uint_as_float(__hip_atomic_load(kmaxp,__ATOMIC_RELAXED,__HIP_MEMORY_SCOPE_AGENT))+__uint_as_float(__hip_atomic_load(kmaxp+1,__ATOMIC_RELAXED,__HIP_MEMORY_SCOPE_AGENT));
    const float Bq=__builtin_sqrtf(qmx*kmx)*1.02f;   const float thr=biasL[q0]-150.f-2.f*Bq;
    const int ntf=(q0+QB)/KVBLK; const int skipf=(tid<ntf)?(biasL[KVBLK*tid+KVBLK-1]<thr?1:0):0;
    const unsigned long long bal=__ballot(skipf);
    __syncthreads();
    if(lane==0&&wid<2)wtot[wid]=(float)__popcll(bal);
    __syncthreads();
    int t0=((int)wtot[0]+(int)wtot[1])&~1; emptyA=(mode==1&&t0>=te); if(t0>te-4)t0=te-4; if(t0>tb)tb=t0;
    __syncthreads(); }
  if(!emptyA){
  const bf16*Kh=K+(rowbase+(long)tb*KVBLK)*DM+h*D,*Vh=V+(rowbase+(long)tb*KVBLK)*DM+h*D;
  const unsigned lds0=(unsigned)(uintptr_t)shm;
  float*wsf=(float*)(shm+LDS_WS)+wid*64;
  const bf16*ksrc=Kh+(long)lane*DM+wid*8;
  const bf16*vsrc=Vh+(long)(16*(wid&3)+(lane>>2))*DM+(wid>>2)*32+(lane&3)*8;
  const unsigned kdst=lds0+LDS_K+wid*1024, vdst=lds0+LDS_V+wid*1024;
  #define DMA_K(t,slot) glds16(ksrc+(long)(t)*KVBLK*DM,(unsigned)__builtin_amdgcn_readfirstlane(kdst+(slot)))
  #define DMA_V(t,slot) glds16(vsrc+(long)(t)*KVBLK*DM,(unsigned)__builtin_amdgcn_readfirstlane(vdst+(slot)))
  const int vb0=(int)(lds0+LDS_V)+((lane>>4)&1)*32+(lane&3)*8+(4*hi+((lane&15)>>2))*64;
  const char*Kbase=shm+LDS_K; bf16x8 kf[8];
  const lds_cptr kp0=shm3+LDS_K+hi*1024+r32*16; const lds_cptr vp0=shm3+LDS_V+((lane>>4)&1)*32+(lane&3)*8+(4*hi+((lane&15)>>2))*64;
  const int NT=te-tb;
  const lds_fptr biasp=biasL+4*hi+tb*KVBLK;
  #define BLD(X0,X1,tt) do{ const lds_fptr bp_=biasp+(tt)*KVBLK; \
    _Pragma("unroll") for(int j_=0;j_<4;++j_){ const f32x4v a_=*(const lds_f4ptr)(bp_+8*j_); const f32x4v b_=*(const lds_f4ptr)(bp_+32+8*j_); \
      X0[4*j_]=a_[0];X0[4*j_+1]=a_[1];X0[4*j_+2]=a_[2];X0[4*j_+3]=a_[3]; X1[4*j_]=b_[0];X1[4*j_+1]=b_[1];X1[4*j_+2]=b_[2];X1[4*j_+3]=b_[3]; } }while(0)
  #define BSUB(X,B) do{ const f32x2_t mh2_={mhat,mhat}; _Pragma("unroll") for(int r_=(B);r_<(B)+8;r_+=2){ f32x2_t t_={X[r_],X[r_+1]}; t_=t_-mh2_; X[r_]=t_.x; X[r_+1]=t_.y; } }while(0)
  DMA_K(0,0);DMA_V(0,0);DMA_K(1,SLOTB);
  float mhat=0.f,l_reg=0.f;f32x16 o[2];o[0]=f32x16{};o[1]=f32x16{};
  const int qrel=wid*QBLK+r32;
  #define CMASK(P0,P1,t) do{int jb_=(t)-(NT-4); if(jb_>=0&&mode!=1)cmask(P0,P1,jb_,qrel,hi);}while(0)
  bool resc=false;
  #define START(P0,P1) do{ const float rm=rowmax(P0,P1); resc=false; \
    { const float dl=rm; mhat=fadd_s(mhat,dl); \
      _Pragma("unroll") for(int r=0;r<16;++r){P0[r]=fsub_s(P0[r],dl);P1[r]=fsub_s(P1[r],dl);} } \
    _Pragma("unroll") for(int r=0;r<16;++r)P0[r]=__builtin_amdgcn_exp2f(P0[r]); }while(0)
  #define RESC() do{ if(resc){ asm volatile("s_waitcnt lgkmcnt(0)":::"memory"); \
      _Pragma("unroll") for(int d_=0;d_<2;++d_) _Pragma("unroll") for(int r=0;r<16;++r)o[d_][r]*=wsf[crow(r,hi)]; } }while(0)
  f32x16 pA0,pA1,pB0,pB1;
  int sl_prev=0,sl_cur=0,sl_next=SLOTB;
  #define ROT() do{sl_prev=sl_cur;sl_cur=sl_next;sl_next=(sl_next==(NSLOT-1)*SLOTB)?0:sl_next+SLOTB;}while(0)
  DMA_K(2,2*SLOTB);
  WAIT_BAR(3);
  BLD(pA0,pA1,0);
  qkt(pA0,pA1,Kbase,qr,r32,hi);asm volatile("s_nop 15\n\ts_nop 7":"+v"(pA0),"+v"(pA1));CMASK(pA0,pA1,0);
  START(pA0,pA1);
  _Pragma("unroll") for(int r=0;r<16;++r)pA1[r]=__builtin_amdgcn_exp2f(pA1[r]);
  BLD(pB0,pB1,1); BSUB(pB0,0); BSUB(pB0,8); BSUB(pB1,0); BSUB(pB1,8);
  WAIT_BAR(0);
  DMA_K(3,0);DMA_V(1,SLOTB);
  ROT();
  kload8(kf,kp0+sl_cur);
  WAIT_BAR(2);
  s16x4 vlo[8],vhi[8]; u32x4 pw0,pw1,pw2,pw3;
  #define PKW(P,B) cvtpk_s(P[B],P[B+1])
  #define PAF(k) __builtin_bit_cast(bf16x8,pw##k)
  #define VFR(i) (bf16x8){vlo[i][0],vlo[i][1],vlo[i][2],vlo[i][3],vhi[i][0],vhi[i][1],vhi[i][2],vhi[i][3]}
  #define PIN(x) asm volatile("":"+v"(x))
  #define MX3(a,b,c) __builtin_fmaxf(__builtin_fmaxf((a),(b)),(c))
  #define GAPA(MF,A0,A1,A2,A3,W0,W1,PW) do{ MF; sacc+=A0; sacc+=A1; sacc+=A2; sacc+=A3; PIN(sacc); W0; W1; PIN(PW); SBAR(); }while(0)
  #define EX(v) __builtin_amdgcn_exp2f(v)
  #define GAPB(MF,X,B) do{ MF; X[B]=EX(X[B]); X[B+1]=EX(X[B+1]); X[B+2]=EX(X[B+2]); X[B+3]=EX(X[B+3]); PIN(X); SBAR(); }while(0)
  #define VRD(i) do{ vlo[i]=vtr(vp_+(((i)>>2)*4096+((i)&3)*1024)); vhi[i]=vtr(vp_+(((i)>>2)*4096+((i)&3)*1024+512)); }while(0)
  #define KRD(G,j) do{ if(G){ kload2(kf,kp0+sl_next,j); SBAR(); } }while(0)
  #define STEP(C0,C1,P0,P1,t,GK,GV,GL) do{ SBAR(); \
    const lds_cptr vp_=vp0+sl_prev; \
    VRD(0); SBAR(); float sacc=(P0[0]+P0[1]); \
    GAPA(C0=__builtin_amdgcn_mfma_f32_32x32x16_bf16(kf[0],qr[0],C0,0,0,0), P0[2],P0[3],P0[4],P0[5],     pw0[0]=PKW(P0,0), pw0[1]=PKW(P0,2), pw0); \
    VRD(4); SBAR(); GAPA(C1=__builtin_amdgcn_mfma_f32_32x32x16_bf16(kf[1],qr[0],C1,0,0,0), P0[6],P0[7],P0[8],P0[9],     pw0[2]=PKW(P0,4), pw0[3]=PKW(P0,6), pw0); \
    VRD(1); SBAR(); GAPA(C0=__builtin_amdgcn_mfma_f32_32x32x16_bf16(kf[2],qr[1],C0,0,0,0),   P0[10],P0[11],P0[12],P0[13], pw1[0]=PKW(P0,8), pw1[1]=PKW(P0,10), pw1); \
    VRD(5); SBAR(); GAPA(C1=__builtin_amdgcn_mfma_f32_32x32x16_bf16(kf[3],qr[1],C1,0,0,0),   P0[14],P0[15],P1[0],P1[1],   pw1[2]=PKW(P0,12),pw1[3]=PKW(P0,14), pw1); \
    VRD(2); SBAR(); GAPA(C0=__builtin_amdgcn_mfma_f32_32x32x16_bf16(kf[4],qr[2],C0,0,0,0),   P1[2],P1[3],P1[4],P1[5],     pw2[0]=PKW(P1,0), pw2[1]=PKW(P1,2), pw2); \
    VRD(6); SBAR(); GAPA(C1=__builtin_amdgcn_mfma_f32_32x32x16_bf16(kf[5],qr[2],C1,0,0,0),   P1[6],P1[7],P1[8],P1[9],     pw2[2]=PKW(P1,4), pw2[3]=PKW(P1,6), pw2); \
    VRD(3); SBAR(); GAPA(C0=__builtin_amdgcn_mfma_f32_32x32x16_bf16(kf[6],qr[3],C0,0,0,0),   P1[10],P1[11],P1[12],P1[13], pw3[0]=PKW(P1,8), pw3[1]=PKW(P1,10), pw3); \
    VRD(7); SBAR(); GAPA(C1=__builtin_amdgcn_mfma_f32_32x32x16_bf16(kf[7],qr[3],C1,0,0,0),   P1[14],P1[15],0.f,0.f,       pw3[2]=PKW(P1,12),pw3[3]=PKW(P1,14), pw3); \
    l_reg+=sacc; \
    if(GK){DMA_K((t)+3,sl_cur);} if(GV){DMA_V((t)+1,sl_next);} \
    CMASK(C0,C1,t); \
    { float a=MX3(C0[0],C0[1],C1[0]),b=MX3(C0[2],C0[3],C1[1]); a=MX3(a,C1[2],C1[3]); \
      _Pragma("unroll") for(int r=4;r<16;r+=4){a=MX3(a,C0[r],C0[r+1]);b=MX3(b,C0[r+2],C0[r+3]);a=MX3(a,C1[r],C1[r+1]);b=MX3(b,C1[r+2],C1[r+3]);} \
      float rm=__builtin_fmaxf(a,b); { auto rr=__builtin_amdgcn_permlane32_swap(__float_as_uint(rm),__float_as_uint(rm),false,false); rm=__builtin_fmaxf(__uint_as_float(rr[0]),__uint_as_float(rr[1])); } \
      resc=false; \
      if(__builtin_expect(__any(rm>(float)THRL),0)){ const float dl=__builtin_fmaxf(rm,0.f); mhat+=dl; \
        _Pragma("unroll") for(int r=0;r<16;++r){C0[r]-=dl;C1[r]-=dl;} \
        const float f=__builtin_amdgcn_exp2f(-dl); l_reg*=f; if(hi==0)wsf[r32]=f; resc=true; } } \
    SBAR(); \
    if(GL){ BLD(P0,P1,(t)+1); SBAR(); } \
    GAPB(o[0]=__builtin_amdgcn_mfma_f32_32x32x16_bf16(PAF(0),VFR(0),o[0],0,0,0), C0,0); \
    GAPB(o[1]=__builtin_amdgcn_mfma_f32_32x32x16_bf16(PAF(0),VFR(4),o[1],0,0,0), C0,4); \
    KRD(GL,0); GAPB(o[0]=__builtin_amdgcn_mfma_f32_32x32x16_bf16(PAF(1),VFR(1),o[0],0,0,0), C0,8); \
    KRD(GL,1); GAPB(o[1]=__builtin_amdgcn_mfma_f32_32x32x16_bf16(PAF(1),VFR(5),o[1],0,0,0), C0,12); \
    KRD(GL,2); if(GL){BSUB(P0,0);} GAPB(o[0]=__builtin_amdgcn_mfma_f32_32x32x16_bf16(PAF(2),VFR(2),o[0],0,0,0), C1,0); \
    KRD(GL,3); if(GL){BSUB(P0,8);} GAPB(o[1]=__builtin_amdgcn_mfma_f32_32x32x16_bf16(PAF(2),VFR(6),o[1],0,0,0), C1,4); \
    if(GL){BSUB(P1,0);} GAPB(o[0]=__builtin_amdgcn_mfma_f32_32x32x16_bf16(PAF(3),VFR(3),o[0],0,0,0), C1,8); \
    if(GL){BSUB(P1,8);} GAPB(o[1]=__builtin_amdgcn_mfma_f32_32x32x16_bf16(PAF(3),VFR(7),o[1],0,0,0), C1,12); \
    }while(0)
  int t=1;
  #undef CMASK
  #define CMASK(P0,P1,t) do{}while(0)
  for(;t+5<NT;t+=2){
    STEP(pB0,pB1,pA0,pA1,t,true,true,true);     WAIT_BAR(2); RESC(); ROT();
    STEP(pA0,pA1,pB0,pB1,t+1,true,true,true);   WAIT_BAR(2); RESC(); ROT();
  }
  #undef CMASK
  #define CMASK(P0,P1,t) do{int jb_=(t)-(NT-4); if(jb_>=0&&mode!=1)cmask(P0,P1,jb_,qrel,hi);}while(0)
  #define ENDW(tt) do{ if((tt)+3<NT){WAIT_BAR(2);} else if((tt)+2<NT){WAIT_BAR(1);} else {WAIT_BAR(0);} }while(0)
  for(;t+1<NT;t+=2){
    STEP(pB0,pB1,pA0,pA1,t,(t+3<NT),(t+1<NT),(t+1<NT));       ENDW(t);   RESC(); ROT();
    STEP(pA0,pA1,pB0,pB1,t+1,(t+4<NT),(t+2<NT),(t+2<NT));     ENDW(t+1); RESC(); ROT();
  }
  STEP(pB0,pB1,pA0,pA1,NT-1,false,false,false); RESC();
  { float sacc=pB0[0]+pB0[1]; _Pragma("unroll") for(int r=2;r<16;++r)sacc+=pB0[r]; _Pragma("unroll") for(int r=0;r<16;++r)sacc+=pB1[r]; l_reg+=sacc;
    pw0=(u32x4){PKW(pB0,0),PKW(pB0,2),PKW(pB0,4),PKW(pB0,6)};pw1=(u32x4){PKW(pB0,8),PKW(pB0,10),PKW(pB0,12),PKW(pB0,14)};pw2=(u32x4){PKW(pB1,0),PKW(pB1,2),PKW(pB1,4),PKW(pB1,6)};pw3=(u32x4){PKW(pB1,8),PKW(pB1,10),PKW(pB1,12),PKW(pB1,14)};
    SBAR(); pv(o,vb0+sl_cur,PAF(0),PAF(1),PAF(2),PAF(3)); }
  #undef PKW
  #undef PAF
  #undef VFR
  #undef PIN
  #undef MX3
  #undef GAPA
  #undef GAPB
  #undef EX
  #undef VRD
  #undef KRD
  #undef STEP
  #undef ENDW
  {auto rr=__builtin_amdgcn_permlane32_swap(__float_as_uint(l_reg),__float_as_uint(l_reg),false,false);l_reg=__uint_as_float(rr[0])+__uint_as_float(rr[1]);}
  if(mode==0){
  if(hi==0)wsf[32+r32]=l_reg;asm volatile("s_waitcnt lgkmcnt(0)":::"memory");
  float rli[16];
  #pragma unroll
  for(int r=0;r<16;++r)rli[r]=__builtin_amdgcn_rcpf(wsf[32+crow(r,hi)]);
  bf16*Ow=O+(rowbase+q0+wid*QBLK)*DM+h*D;
  { bf16*stg=(bf16*)(shm+LDS_OST)+wid*2048;
    #pragma unroll
    for(int r=0;r<16;++r){const int orow=crow(r,hi);
      #pragma unroll
      for(int d0=0;d0<2;++d0)stg[orow*64+d0*32+r32]=__float2bfloat16(o[d0][r]*rli[r]);}
    asm volatile("s_waitcnt lgkmcnt(0)":::"memory");
    #pragma unroll
    for(int i=0;i<4;++i){const int row=i*8+(lane>>3),ch=lane&7; const u32x4 v=*(const u32x4*)(stg+row*64+ch*8); ATTN_STORE16(Ow+(long)row*DM+ch*8,v);
      float ss=0.f;
      #pragma unroll
      for(int e=0;e<4;++e){const float lo_=__uint_as_float(v[e]<<16),hi_=__uint_as_float(v[e]&0xffff0000u);ss+=lo_*lo_+hi_*hi_;}
      ss+=sx<1>(ss);ss+=sx<2>(ss);ss+=sx<4>(ss);
      if(ch==0)ssqA[(rowbase+q0+wid*QBLK+row)*NHEAD+h]=ss;} }
  } else {
    float*PO=part+(long)(mode-1)*QB*D+(long)(wid*QBLK)*D;
    #pragma unroll
    for(int r=0;r<16;++r){const int orow=crow(r,hi);
      #pragma unroll
      for(int d0=0;d0<2;++d0)__hip_atomic_store(PO+orow*D+d0*32+r32,o[d0][r],__ATOMIC_RELAXED,__HIP_MEMORY_SCOPE_AGENT);}
    if(hi==0){ float*PM=part+2*QB*D+(mode-1)*QB+wid*QBLK; __hip_atomic_store(PM+r32,mhat,__ATOMIC_RELAXED,__HIP_MEMORY_SCOPE_AGENT); __hip_atomic_store(PM+2*QB+r32,l_reg,__ATOMIC_RELAXED,__HIP_MEMORY_SCOPE_AGENT); }
  }
  asm volatile("s_waitcnt lgkmcnt(0)\n\ts_barrier":::"memory");
  } else if(tid<QB){ float*PM=part+2*QB*D; __hip_atomic_store(PM+tid,-1e30f,__ATOMIC_RELAXED,__HIP_MEMORY_SCOPE_AGENT); __hip_atomic_store(PM+2*QB+tid,0.f,__ATOMIC_RELAXED,__HIP_MEMORY_SCOPE_AGENT); }
  if(mode!=0){
    asm volatile("s_waitcnt vmcnt(0)":::"memory"); __syncthreads();
    if(tid==0){
      const unsigned old=__hip_atomic_fetch_add(pcnt,1u,__ATOMIC_RELAXED,__HIP_MEMORY_SCOPE_AGENT);
      if(old==1u){ __builtin_amdgcn_fence(__ATOMIC_ACQUIRE,"agent"); asm volatile("s_waitcnt vmcnt(0)":::"memory"); }
      wtot[0]=(old==1u)?1.f:0.f; }
    __syncthreads();
    const bool merger=wtot[0]!=0.f;
    __syncthreads();
    if(merger){ const int row=tid>>1,ch=tid&1; const float*PA=part+(long)row*D+ch*32,*PB=PA+(long)QB*D; const float*PM=part+2*QB*D;
      const float MA=PM[row],MB=PM[QB+row],LA=PM[2*QB+row],LB=PM[3*QB+row]; const float m=__builtin_fmaxf(MA,MB);
      const bool ua=LA>0.f,ub=LB>0.f; const float wA=ua?__builtin_amdgcn_exp2f(MA-m):0.f,wB=ub?__builtin_amdgcn_exp2f(MB-m):0.f; const float inv=__builtin_amdgcn_rcpf(LA*wA+LB*wB); const float cA=wA*inv,cB=wB*inv;
      bf16*Om=O+(rowbase+q0+row)*DM+h*D+ch*32; float ss=0.f;
      #pragma unroll
      for(int i=0;i<4;++i){ const f32x4v z4={0.f,0.f,0.f,0.f}; const f32x4v a0=ua?*(const f32x4v*)(PA+8*i):z4,a1=ua?*(const f32x4v*)(PA+8*i+4):z4,b0=ub?*(const f32x4v*)(PB+8*i):z4,b1=ub?*(const f32x4v*)(PB+8*i+4):z4;
        u32x4 w; w[0]=cvtpk_s(a0[0]*cA+b0[0]*cB,a0[1]*cA+b0[1]*cB); w[1]=cvtpk_s(a0[2]*cA+b0[2]*cB,a0[3]*cA+b0[3]*cB); w[2]=cvtpk_s(a1[0]*cA+b1[0]*cB,a1[1]*cA+b1[1]*cB); w[3]=cvtpk_s(a1[2]*cA+b1[2]*cB,a1[3]*cA+b1[3]*cB);
        ATTN_STORE16(Om+8*i,w);
        #pragma unroll
        for(int e=0;e<4;++e){const float lo_=__uint_as_float(w[e]<<16),hi_=__uint_as_float(w[e]&0xffff0000u);ss+=lo_*lo_+hi_*hi_;} }
      ss+=sx<1>(ss);
      if(ch==0)ssqA[(rowbase+q0+row)*NHEAD+h]=ss; }
  }
  #undef DMA_K
  #undef DMA_V
  #undef BLD
  #undef BSUB
  #undef CMASK
  #undef START
  #undef RESC
  #undef ROT
}
constexpr int ATTN_LDS_BYTES=LDS_BYTES;
#undef SBAR
#undef WAIT_BAR
}
#define LAS __attribute__((address_space(3)))
#define GAS __attribute__((address_space(1)))
using pg8::f32x4; using pg8::u32x4; using pg8::bf16_t; using pg8::bf16x8; using pg8::Unit; using pg8::BM; using pg8::HALF;
typedef unsigned u32x2 __attribute__((ext_vector_type(2)));
constexpr int TOK = 16384, DMODEL = 1024, DFF = 2816, HW = 512, SEQL = 8192, PLE = 256, NGRP = 32;
constexpr float L2E = 1.4426950408889634f;
constexpr float QSCALE = 0.125f * L2E;
constexpr size_t MiB = 1u << 20;
constexpr size_t WS_CTL = 0, WS_AP = 1 * MiB, WS_BB = WS_AP + 512 * 1024, WS_KTAB = 2 * MiB, WS_PEND = 3 * MiB, WS_CC = 5 * MiB, WS_WF = 7 * MiB, WS_LOGF = 8 * MiB;
constexpr size_t WS_SSQ0 = 9 * MiB, WS_SSQ1 = 10 * MiB, WS_SSQ2 = 11 * MiB, WS_SSQ3 = 12 * MiB, WS_SSQ4 = 13 * MiB, WS_SSQA = 14 * MiB, WS_SSQS = 14 * MiB + 512 * 1024;
constexpr size_t WS_W13A = 16 * MiB, WS_W2A = 27 * MiB, WS_WIN = 33 * MiB, WS_WGLU = 37 * MiB, WS_WOA = 38 * MiB, WS_WOS = 39 * MiB, WS_W13B = 40 * MiB, WS_W2B = 51 * MiB, WS_WG = 57 * MiB, WS_WP = 59 * MiB;
constexpr size_t PARTF = 2 * 256 * 64 + 4 * 256;
static_assert(60 * PARTF * 4 <= 8 * MiB && 45 * PARTF * 4 <= 6 * MiB && 151 * PARTF * 4 <= 20 * MiB, "partial record chunks");
constexpr size_t WS_PART_UNUSED = 188 * MiB;
constexpr size_t WS_PB = 60 * MiB, WS_XB = 68 * MiB, WS_H1 = 100 * MiB;
constexpr size_t WS_Q = 100 * MiB, WS_K = 116 * MiB, WS_V = 132 * MiB, WS_U = 148 * MiB, WS_Y = 164 * MiB, WS_SSMO = 188 * MiB, WS_PP = 204 * MiB, WS_END = 256 * MiB;
static_assert(WS_K == WS_Q + 16 * MiB && WS_V == WS_Q + 32 * MiB, "EpiQKVU pointer arithmetic");
constexpr int RING_BYTES = 131072, LDS_BYTES = 147456, MISC_OFF = LDS_BYTES - 256;

__device__ __forceinline__ float sigm(float w) { return __builtin_amdgcn_rcpf(1.f + __builtin_amdgcn_exp2f(-L2E * w)); }
__device__ __forceinline__ unsigned pkbf(float lo, float hi) { return pg8::cvt_pk_bf16(lo, hi); }
__device__ __forceinline__ float bflo(unsigned w) { return __uint_as_float(w << 16); }
__device__ __forceinline__ float bfhi(unsigned w) { return __uint_as_float(w & 0xffff0000u); }
template <int NP> __device__ __forceinline__ float rstd_row(const float* ssq, int row, float invn) {
    const f32x4* p = (const f32x4*)(ssq + (size_t)row * NP); float s = 0.f;
#pragma unroll
    for (int i = 0; i < NP / 4; ++i) { const f32x4 v = p[i]; s += (v[0] + v[1]) + (v[2] + v[3]); }
    return __builtin_amdgcn_rsqf(s * invn + 1e-6f);
}
template <int NP> __device__ __forceinline__ void rstd8(const float* ssq, int pm, int wr, int fr, int fq, float invn, float (&rs)[2][4]) {
    int lrow = pm * BM + wr * 64 + fq * 16 + fr; asm volatile("" : "+v"(lrow));
    const float r0 = rstd_row<NP>(ssq, lrow, invn), r1 = rstd_row<NP>(ssq, lrow + HALF, invn);
#pragma unroll
    for (int m = 0; m < 4; ++m) { rs[0][m] = __builtin_bit_cast(float, __builtin_amdgcn_ds_bpermute((16 * m + fr) << 2, __builtin_bit_cast(int, r0))); rs[1][m] = __builtin_bit_cast(float, __builtin_amdgcn_ds_bpermute((16 * m + fr) << 2, __builtin_bit_cast(int, r1))); }
}
__device__ __forceinline__ float wave_sum(float v) {
    v += sx<1>(v); v += sx<2>(v); v += sx<4>(v); v += sx<8>(v); v += sx<16>(v); v = sum32(v);
    return v;
}

struct EpiSwiglu {
    static constexpr bool PERM = true, AFTER_DRAIN = false, MIDK = false;
    bf16_t* O; const float* ssq;
    __device__ __forceinline__ void operator()(const f32x4 (&acc)[2][2][4][2], const Unit& u, int wr, int wc, int fr, int fq) const {
        int row0 = u.pm * BM + wr * 64 + fr, col0 = u.pn * 128 + wc * 32 + 8 * fq; asm volatile("" : "+v"(row0));
        float rs8[2][4]; rstd8<16>(ssq, u.pm, wr, fr, fq, 1.f / 1024.f, rs8);
#pragma unroll
        for (int ai = 0; ai < 2; ++ai)
#pragma unroll
            for (int m = 0; m < 4; ++m) { asm volatile("" ::: "memory"); const int row = row0 + ai * HALF + m * 16; const float rs = rs8[ai][m];
                const f32x4 a0 = acc[ai][0][m][0] * rs, a1 = acc[ai][0][m][1] * rs, b0 = acc[ai][1][m][0] * rs, b1 = acc[ai][1][m][1] * rs; f32x4 h0, h1;
#pragma unroll
                for (int e = 0; e < 4; ++e) { h0[e] = a0[e] * sigm(a0[e]) * b0[e]; h1[e] = a1[e] * sigm(a1[e]) * b1[e]; }
                u32x4 w; w.x = pkbf(h0[0], h0[1]); w.y = pkbf(h0[2], h0[3]); w.z = pkbf(h1[0], h1[1]); w.w = pkbf(h1[2], h1[3]);
                *(u32x4*)(O + (size_t)row * DFF + col0) = w; }
    }
};
template <bool NORM, bool BASEB> struct EpiRes {
    static constexpr bool PERM = true, AFTER_DRAIN = false, MIDK = false;
    const float* basef; bf16_t* xb; float* ssqo; const float* ssqi; float coef;
    __device__ __forceinline__ void operator()(const f32x4 (&acc)[2][2][4][2], const Unit& u, int wr, int wc, int fr, int fq) const {
        int row0 = u.pm * BM + wr * 64 + fr, col0 = u.pn * BM + wc * 32 + 8 * fq; asm volatile("" : "+v"(row0));
        float rs8[2][4]; if (NORM) rstd8<8>(ssqi, u.pm, wr, fr, fq, 1.f / 512.f, rs8);
#pragma unroll
        for (int ai = 0; ai < 2; ++ai) { asm volatile("" ::: "memory");
            f32x4 xv[4][2][2];
#pragma unroll
            for (int m = 0; m < 4; ++m)
#pragma unroll
                for (int bj = 0; bj < 2; ++bj) { const size_t off = (size_t)(row0 + ai * HALF + m * 16) * DMODEL + col0 + bj * HALF;
                    if (BASEB) { const u32x4 bv = *(const u32x4*)(xb + off); xv[m][bj][0] = (f32x4){bflo(bv.x), bfhi(bv.x), bflo(bv.y), bfhi(bv.y)}; xv[m][bj][1] = (f32x4){bflo(bv.z), bfhi(bv.z), bflo(bv.w), bfhi(bv.w)}; }
                    else { xv[m][bj][0] = __builtin_nontemporal_load((const f32x4*)(basef + off)); xv[m][bj][1] = __builtin_nontemporal_load((const f32x4*)(basef + off + 4)); } }
#pragma unroll
            for (int m = 0; m < 4; ++m) { const int row = row0 + ai * HALF + m * 16; float alpha = coef; if (NORM) alpha *= rs8[ai][m]; float ss = 0.f;
#pragma unroll
                for (int bj = 0; bj < 2; ++bj) { const size_t off = (size_t)row * DMODEL + col0 + bj * HALF;
                    const f32x4 v0 = xv[m][bj][0] + acc[ai][bj][m][0] * alpha, v1 = xv[m][bj][1] + acc[ai][bj][m][1] * alpha;
                    u32x4 w; w.x = pkbf(v0[0], v0[1]); w.y = pkbf(v0[2], v0[3]); w.z = pkbf(v1[0], v1[1]); w.w = pkbf(v1[2], v1[3]); *(u32x4*)(xb + off) = w;
                    ss += (v0[0] * v0[0] + v0[1] * v0[1]) + (v0[2] * v0[2] + v0[3] * v0[3]) + (v1[0] * v1[0] + v1[1] * v1[1]) + (v1[2] * v1[2] + v1[3] * v1[3]); }
                ss += sx<16>(ss); ss = sum32(ss); if (fq == 0) ssqo[(size_t)row * 16 + u.pn * 4 + wc] = ss; } }
    }
};
struct EpiOut {
    static constexpr bool PERM = true, AFTER_DRAIN = false, MIDK = true;
    bf16_t* xb; float* ssqo; const float* ssqA; const float* ssqS;
    __device__ __forceinline__ void mid(f32x4 (&acc)[2][2][4][2], const Unit& u, int wr, int wc, int fr, int fq) const {
        float ra8[2][4], rb8[2][4]; rstd8<8>(ssqA, u.pm, wr, fr, fq, 1.f / 512.f, ra8); rstd8<8>(ssqS, u.pm, wr, fr, fq, 1.f / 512.f, rb8);
#pragma unroll
        for (int ai = 0; ai < 2; ++ai)
#pragma unroll
            for (int m = 0; m < 4; ++m) { const float ratio = ra8[ai][m] * __builtin_amdgcn_rcpf(rb8[ai][m]);
#pragma unroll
                for (int bj = 0; bj < 2; ++bj) { acc[ai][bj][m][0] *= ratio; acc[ai][bj][m][1] *= ratio; } }
    }
    __device__ __forceinline__ void operator()(const f32x4 (&acc)[2][2][4][2], const Unit& u, int wr, int wc, int fr, int fq) const {
        EpiRes<true, true> E{nullptr, xb, ssqo, ssqS, 1.f}; E(acc, u, wr, wc, fr, fq);
    }
};
struct StrideOrder {
    int first, stride, total, nN;
    __device__ __forceinline__ bool next(int i, Unit& u) const { const int id = first + i * stride; if (id >= total) return false; u.pm = id / nN; u.pn = id % nN; return true; }
    __device__ __forceinline__ void a_ready(const Unit&) const {}
    __device__ __forceinline__ void done(const Unit&) const {}
};
struct EpiQKVU {
    static constexpr bool PERM = true, AFTER_DRAIN = false, MIDK = false;
    bf16_t *Q, *U; const float* ssq; unsigned* kmax;
    __device__ __forceinline__ void operator()(const f32x4 (&acc)[2][2][4][2], const Unit& u, int wr, int wc, int fr, int fq) const {
        int row0 = u.pm * BM + wr * 64 + fr, part = u.pn >> 1, c0 = (u.pn & 1) * 256 + wc * 32 + 8 * fq; asm volatile("" : "+v"(row0));
        bf16_t* dstb = Q + (size_t)part * (size_t)(8 * MiB); const float sc = part == 0 ? QSCALE : 1.f;
        float rs8[2][4]; rstd8<16>(ssq, u.pm, wr, fr, fq, 1.f / 1024.f, rs8); float mxb[2] = {0.f, 0.f};
#pragma unroll
        for (int ai = 0; ai < 2; ++ai)
#pragma unroll
            for (int m = 0; m < 4; ++m) { asm volatile("" ::: "memory"); const int row = row0 + ai * HALF + m * 16; const float rs = rs8[ai][m] * sc;
#pragma unroll
                for (int bj = 0; bj < 2; ++bj) { const int c = c0 + bj * HALF; const f32x4 v0 = acc[ai][bj][m][0] * rs, v1 = acc[ai][bj][m][1] * rs;
                    if (part == 1) { float p2 = ((v0[0] * v0[0] + v0[1] * v0[1]) + (v0[2] * v0[2] + v0[3] * v0[3])) + ((v1[0] * v1[0] + v1[1] * v1[1]) + (v1[2] * v1[2] + v1[3] * v1[3])); p2 += sx<16>(p2); p2 = sum32(p2); mxb[bj] = __builtin_fmaxf(mxb[bj], p2); }
                    u32x4 w; w.x = pkbf(v0[0], v0[1]); w.y = pkbf(v0[2], v0[3]); w.z = pkbf(v1[0], v1[1]); w.w = pkbf(v1[2], v1[3]);
                    if (part < 3) *(u32x4*)(dstb + (size_t)row * HW + c) = w;
                    else { const int g = c >> 4, half = (c >> 3) & 1, b = row >> 13, t = row & 8191; *(u32x4*)(U + ((size_t)((b * NGRP + g) * SEQL + t)) * 16 + half * 8) = w; } } }
        if (part == 1) {
#pragma unroll
            for (int bj = 0; bj < 2; ++bj) { float mx = mxb[bj];
                mx = __builtin_fmaxf(mx, sx<1>(mx)); mx = __builtin_fmaxf(mx, sx<2>(mx)); mx = __builtin_fmaxf(mx, sx<4>(mx)); mx = __builtin_fmaxf(mx, sx<8>(mx));
                if (fr == 0 && fq == 0) __hip_atomic_fetch_max(kmax + (((u.pm >> 5) * 8 + (u.pn & 1) * 4 + bj * 2 + (wc >> 1)) << 1) + (wc & 1), __float_as_uint(mx), __ATOMIC_RELAXED, __HIP_MEMORY_SCOPE_AGENT); } }
    }
};
struct EpiGlu {
    static constexpr bool PERM = true, AFTER_DRAIN = false, MIDK = false;
    const bf16_t* Y; const float* bglu; bf16_t* O; float* ssqo;
    __device__ __forceinline__ void operator()(const f32x4 (&acc)[2][2][4][2], const Unit& u, int wr, int wc, int fr, int fq) const {
        int row0 = u.pm * BM + wr * 64 + fr, c0 = u.pn * BM + wc * 32 + 8 * fq; asm volatile("" : "+v"(row0));
#pragma unroll
        for (int ai = 0; ai < 2; ++ai)
#pragma unroll
            for (int m = 0; m < 4; ++m) { asm volatile("" ::: "memory"); const int row = row0 + ai * HALF + m * 16; float ss = 0.f;
#pragma unroll
                for (int bj = 0; bj < 2; ++bj) { const int c = c0 + bj * HALF; const u32x4 yv = *(const u32x4*)(Y + (size_t)row * HW + c);
                    const f32x4 b0 = *(const f32x4*)(bglu + c), b1 = *(const f32x4*)(bglu + c + 4); const f32x4 a0 = acc[ai][bj][m][0] + b0, a1 = acc[ai][bj][m][1] + b1;
                    float o[8]; o[0] = bflo(yv.x) * sigm(a0[0]); o[1] = bfhi(yv.x) * sigm(a0[1]); o[2] = bflo(yv.y) * sigm(a0[2]); o[3] = bfhi(yv.y) * sigm(a0[3]);
                    o[4] = bflo(yv.z) * sigm(a1[0]); o[5] = bfhi(yv.z) * sigm(a1[1]); o[6] = bflo(yv.w) * sigm(a1[2]); o[7] = bfhi(yv.w) * sigm(a1[3]);
                    u32x4 w; w.x = pkbf(o[0], o[1]); w.y = pkbf(o[2], o[3]); w.z = pkbf(o[4], o[5]); w.w = pkbf(o[6], o[7]); *(u32x4*)(O + (size_t)row * HW + c) = w;
#pragma unroll
                    for (int e = 0; e < 8; ++e) ss += o[e] * o[e]; }
                ss += sx<16>(ss); ss = sum32(ss); if (fq == 0) ssqo[(size_t)row * 8 + u.pn * 4 + wc] = ss; }
    }
};
struct EpiBf16P {
    static constexpr bool PERM = true, AFTER_DRAIN = false, MIDK = false;
    bf16_t* O;
    __device__ __forceinline__ void operator()(const f32x4 (&acc)[2][2][4][2], const Unit& u, int wr, int wc, int fr, int fq) const {
        int row0 = u.pm * BM + wr * 64 + fr, c0 = u.pn * BM + wc * 32 + 8 * fq; asm volatile("" : "+v"(row0));
#pragma unroll
        for (int ai = 0; ai < 2; ++ai)
#pragma unroll
            for (int m = 0; m < 4; ++m) { asm volatile("" ::: "memory"); const int row = row0 + ai * HALF + m * 16;
#pragma unroll
                for (int bj = 0; bj < 2; ++bj) { const f32x4 v0 = acc[ai][bj][m][0], v1 = acc[ai][bj][m][1];
                    u32x4 w; w.x = pkbf(v0[0], v0[1]); w.y = pkbf(v0[2], v0[3]); w.z = pkbf(v1[0], v1[1]); w.w = pkbf(v1[2], v1[3]); *(u32x4*)(O + (size_t)row * DMODEL + c0 + bj * HALF) = w; } }
    }
};
struct EpiGate {
    static constexpr bool PERM = true, AFTER_DRAIN = false, MIDK = false;
    const bf16_t* base; float* out; const bf16_t* pp; const float* ssqi; float* ssqo;
    __device__ __forceinline__ void operator()(const f32x4 (&acc)[2][2][4][2], const Unit& u, int wr, int wc, int fr, int fq) const {
        int row0 = u.pm * BM + wr * 64 + fr, c0 = u.pn * BM + wc * 32 + 8 * fq; asm volatile("" : "+v"(row0));
        float rs8[2][4]; rstd8<16>(ssqi, u.pm, wr, fr, fq, 1.f / 1024.f, rs8);
#pragma unroll
        for (int ai = 0; ai < 2; ++ai)
#pragma unroll
            for (int m = 0; m < 4; ++m) { asm volatile("" ::: "memory"); const int row = row0 + ai * HALF + m * 16; const float rs = rs8[ai][m]; float ss = 0.f;
#pragma unroll
                for (int bj = 0; bj < 2; ++bj) { const size_t off = (size_t)row * DMODEL + c0 + bj * HALF; const u32x4 pv = *(const u32x4*)(pp + off);
                    const u32x4 bv = *(const u32x4*)(base + off); const f32x4 x0 = (f32x4){bflo(bv.x), bfhi(bv.x), bflo(bv.y), bfhi(bv.y)}, x1 = (f32x4){bflo(bv.z), bfhi(bv.z), bflo(bv.w), bfhi(bv.w)}; const f32x4 a0 = acc[ai][bj][m][0] * rs, a1 = acc[ai][bj][m][1] * rs; f32x4 v0, v1;
                    v0[0] = x0[0] + sigm(a0[0]) * bflo(pv.x); v0[1] = x0[1] + sigm(a0[1]) * bfhi(pv.x); v0[2] = x0[2] + sigm(a0[2]) * bflo(pv.y); v0[3] = x0[3] + sigm(a0[3]) * bfhi(pv.y);
                    v1[0] = x1[0] + sigm(a1[0]) * bflo(pv.z); v1[1] = x1[1] + sigm(a1[1]) * bfhi(pv.z); v1[2] = x1[2] + sigm(a1[2]) * bflo(pv.w); v1[3] = x1[3] + sigm(a1[3]) * bfhi(pv.w);
                    *(f32x4*)(out + off) = v0; *(f32x4*)(out + off + 4) = v1;
                    ss += (v0[0] * v0[0] + v0[1] * v0[1]) + (v0[2] * v0[2] + v0[3] * v0[3]) + (v1[0] * v1[0] + v1[1] * v1[1]) + (v1[2] * v1[2] + v1[3] * v1[3]); }
                ss += sx<16>(ss); ss = sum32(ss); if (fq == 0) ssqo[(size_t)row * 16 + u.pn * 4 + wc] = ss; }
    }
};

struct EpiGateFinal {
    static constexpr bool PERM = true, AFTER_DRAIN = false, MIDK = false;
    const bf16_t* base; float* out; const bf16_t* pp; const float* ssqi; float* ssqo; unsigned* cnt; const float* gfin;
    __device__ __forceinline__ void operator()(const f32x4 (&acc)[2][2][4][2], const Unit& u, int wr, int wc, int fr, int fq) const {
        int row0 = u.pm * BM + wr * 64 + fr, c0 = u.pn * BM + wc * 32 + 8 * fq; asm volatile("" : "+v"(row0));
        float rs8[2][4]; rstd8<16>(ssqi, u.pm, wr, fr, fq, 1.f / 1024.f, rs8);
        f32x4 v[2][4][2][2];
#pragma unroll
        for (int am = 0; am < 4; ++am) { asm volatile("" ::: "memory"); const int ai = am >> 1;
            u32x4 pvv[2][2], bvv[2][2];
#pragma unroll
            for (int mm = 0; mm < 2; ++mm)
#pragma unroll
                for (int bj = 0; bj < 2; ++bj) { const size_t off = (size_t)(row0 + ai * HALF + ((am & 1) * 2 + mm) * 16) * DMODEL + c0 + bj * HALF; pvv[mm][bj] = *(const u32x4*)(pp + off); bvv[mm][bj] = *(const u32x4*)(base + off); }
#pragma unroll
            for (int mm = 0; mm < 2; ++mm) { const int m = (am & 1) * 2 + mm; const int row = row0 + ai * HALF + m * 16; const float rs = rs8[ai][m]; float ss = 0.f;
#pragma unroll
                for (int bj = 0; bj < 2; ++bj) { const u32x4 pv = pvv[mm][bj];
                    const u32x4 bv = bvv[mm][bj]; const f32x4 x0 = (f32x4){bflo(bv.x), bfhi(bv.x), bflo(bv.y), bfhi(bv.y)}, x1 = (f32x4){bflo(bv.z), bfhi(bv.z), bflo(bv.w), bfhi(bv.w)}; const f32x4 a0 = acc[ai][bj][m][0] * rs, a1 = acc[ai][bj][m][1] * rs; f32x4 v0, v1;
                    v0[0] = x0[0] + sigm(a0[0]) * bflo(pv.x); v0[1] = x0[1] + sigm(a0[1]) * bfhi(pv.x); v0[2] = x0[2] + sigm(a0[2]) * bflo(pv.y); v0[3] = x0[3] + sigm(a0[3]) * bfhi(pv.y);
                    v1[0] = x1[0] + sigm(a1[0]) * bflo(pv.z); v1[1] = x1[1] + sigm(a1[1]) * bfhi(pv.z); v1[2] = x1[2] + sigm(a1[2]) * bflo(pv.w); v1[3] = x1[3] + sigm(a1[3]) * bfhi(pv.w);
                    v[ai][m][bj][0] = v0; v[ai][m][bj][1] = v1;
                    ss += (v0[0] * v0[0] + v0[1] * v0[1]) + (v0[2] * v0[2] + v0[3] * v0[3]) + (v1[0] * v1[0] + v1[1] * v1[1]) + (v1[2] * v1[2] + v1[3] * v1[3]); }
                ss += sx<16>(ss); ss = sum32(ss);
                if (fq == 0) __hip_atomic_store(ssqo + (size_t)row * 16 + u.pn * 4 + wc, ss, __ATOMIC_RELAXED, __HIP_MEMORY_SCOPE_AGENT); } }
        asm volatile("s_waitcnt vmcnt(0)" ::: "memory");
        unsigned* c = cnt + 64 * u.pm;
        if (fr == 0 && fq == 0) __hip_atomic_fetch_add(c, 1u, __ATOMIC_RELAXED, __HIP_MEMORY_SCOPE_AGENT);
        for (unsigned sp = 0; sp < (1u << 22); ++sp) {
            if ((unsigned)__builtin_amdgcn_readfirstlane(__hip_atomic_load(c, __ATOMIC_RELAXED, __HIP_MEMORY_SCOPE_AGENT)) >= 32u) break;
            __builtin_amdgcn_s_sleep(2); }
        __builtin_amdgcn_fence(__ATOMIC_ACQUIRE, "agent");
#pragma unroll
        for (int ai = 0; ai < 2; ++ai)
#pragma unroll
            for (int m = 0; m < 4; ++m) { asm volatile("" ::: "memory"); const int row = row0 + ai * HALF + m * 16; const float* ps = ssqo + (size_t)row * 16 + 4 * fq;
                float s4 = (__hip_atomic_load(ps, __ATOMIC_RELAXED, __HIP_MEMORY_SCOPE_AGENT) + __hip_atomic_load(ps + 1, __ATOMIC_RELAXED, __HIP_MEMORY_SCOPE_AGENT))
                         + (__hip_atomic_load(ps + 2, __ATOMIC_RELAXED, __HIP_MEMORY_SCOPE_AGENT) + __hip_atomic_load(ps + 3, __ATOMIC_RELAXED, __HIP_MEMORY_SCOPE_AGENT));
                s4 += sx<16>(s4); s4 = sum32(s4);
                const float rstd = __builtin_amdgcn_rsqf(s4 * (1.f / 1024.f) + 1e-6f);
#pragma unroll
                for (int bj = 0; bj < 2; ++bj) { const size_t off = (size_t)row * DMODEL + c0 + bj * HALF; const f32x4 g0 = *(const f32x4*)(gfin + c0 + bj * HALF), g1 = *(const f32x4*)(gfin + c0 + bj * HALF + 4);
                    __builtin_nontemporal_store(v[ai][m][bj][0] * rstd * g0, (f32x4*)(out + off)); __builtin_nontemporal_store(v[ai][m][bj][1] * rstd * g1, (f32x4*)(out + off + 4)); } }
    }
};

__device__ __forceinline__ void tr_item(const float* src, int srcN, int k0, int c0, const float* gain, bf16_t* dst, int dstPitch, int dstRow0, LAS float* scr, int lane) {
    float tv[32];
#pragma unroll
    for (int i = 0; i < 32; ++i) { const int kk = 2 * i + (lane >> 5); tv[i] = __builtin_nontemporal_load(src + (size_t)(k0 + kk) * srcN + c0 + (lane & 31)); }
    if (gain) {
#pragma unroll
        for (int i = 0; i < 32; ++i) tv[i] *= gain[k0 + 2 * i + (lane >> 5)]; }
#pragma unroll
    for (int i = 0; i < 32; ++i) scr[(2 * i + (lane >> 5)) * 33 + (lane & 31)] = tv[i];
    asm volatile("s_waitcnt lgkmcnt(0)" ::: "memory");
    const int c = lane & 7;
#pragma unroll
    for (int j = 0; j < 4; ++j) { const int n = (lane >> 3) + 8 * j; const LAS float* s = scr + (8 * c) * 33 + n;
        u32x4 o; o.x = pkbf(s[0 * 33], s[1 * 33]); o.y = pkbf(s[2 * 33], s[3 * 33]); o.z = pkbf(s[4 * 33], s[5 * 33]); o.w = pkbf(s[6 * 33], s[7 * 33]);
        *(u32x4*)(dst + (size_t)(dstRow0 + n) * dstPitch + k0 + 8 * c) = o; }
    asm volatile("s_waitcnt lgkmcnt(0)" ::: "memory");
}
__device__ __forceinline__ void tr_w13(const float* w1, const float* w3, const float* gain, bf16_t* dst, int item, LAS float* scr, int lane) {
    const int nblk = 5632 / 32, kb = item / nblk, nb = item % nblk, R0 = 32 * nb, tile = R0 >> 8, r = R0 & 255;
    tr_item(r < 128 ? w1 : w3, DFF, 64 * kb, 128 * tile + (r & 127), gain, dst, DMODEL, R0, scr, lane);
}
__device__ __forceinline__ void cis_d(double a, double& c, double& s) {
    const double k = rint(a * 0.63661977236758134);
    const double r = fma(-k, 6.123233995736766e-17, fma(-k, 1.5707963267948966, a)), r2 = r * r;
    const double sp = r * (1.0 + r2 * (-1.0 / 6 + r2 * (1.0 / 120 + r2 * (-1.0 / 5040 + r2 * (1.0 / 362880 + r2 * (-1.0 / 39916800 + r2 * (1.0 / 6227020800.0)))))));
    const double cp = 1.0 + r2 * (-0.5 + r2 * (1.0 / 24 + r2 * (-1.0 / 720 + r2 * (1.0 / 40320 + r2 * (-1.0 / 3628800 + r2 * (1.0 / 479001600.0 + r2 * (-1.0 / 87178291200.0)))))));
    const int q = ((int)k) & 3;
    c = (q == 0) ? cp : (q == 1) ? -sp : (q == 2) ? -cp : sp;
    s = (q == 0) ? sp : (q == 1) ? cp : (q == 2) ? -sp : -cp;
}
__device__ __forceinline__ float gelu_tanh(float y) { return y * sigm(1.5957691216057308f * (y + 0.044715f * y * y * y)); }

__device__ __forceinline__ void ssm_item(int bg, const bf16_t* U, const bf16_t* Ktab, const bf16_t* Pend, const bf16_t* Cc, const float* AP, bf16_t* Yout, LAS unsigned char* lds, int tid, unsigned* done) {
    asm volatile("" : "+v"(tid));
    const int lane = tid & 63, wid = __builtin_amdgcn_readfirstlane(tid >> 6), fr = lane & 15, fq = lane >> 4;
    const int b = bg >> 5, g = bg & 31;
    const bf16_t* Ub = U + (size_t)bg * SEQL * 16; const bf16_t* Kt = Ktab + g * 4096; const bf16_t* Pe = Pend + g * 32768; const bf16_t* Cg = Cc + g * 32768; const float* APg = AP + g * 64 * 36;
    float a16r[4], a16i[4];
#pragma unroll
    for (int pt = 0; pt < 4; ++pt) { a16r[pt] = APg[(16 * pt + fr) * 36 + 32]; a16i[pt] = APg[(16 * pt + fr) * 36 + 33]; }
    const float a64r = APg[lane * 36 + 34], a64i = APg[lane * 36 + 35];
    float cr = 0.f, ci = 0.f;
    LAS float* Ebuf = (LAS float*)lds; LAS float* Cbuf = (LAS float*)(lds + 16384); LAS unsigned short* XP = (LAS unsigned short*)(lds + 32768) + wid * (16 * 136);
    const int slot = wid * 4 + fq;
    LAS unsigned short* PendL = (LAS unsigned short*)(lds + 67584); LAS unsigned short* KtL = (LAS unsigned short*)(lds + 135168);
    { const GAS u32x4* ps = (const GAS u32x4*)Pe; u32x4 tv[8];
#pragma unroll
      for (int i = 0; i < 8; ++i) tv[i] = ps[tid + 512 * i];
      const u32x4 kv = ((const GAS u32x4*)Kt)[tid];
#pragma unroll
      for (int i = 0; i < 8; ++i) { const int c = tid + 512 * i; *(LAS u32x4*)(PendL + (c >> 5) * 264 + (c & 31) * 8) = tv[i]; }
      *(LAS u32x4*)(KtL + tid * 8) = kv; }
    __syncthreads();
    for (int seg = 0; seg < 4; ++seg) {
        const int c0 = seg * 128 + wid * 16;
        bf16x8 uf[8];
        { const bf16_t* ub = Ub + ((size_t)(c0 + fr) * 16 + (fq >> 1)) * 16 + 8 * (fq & 1); asm volatile("" : "+v"(ub));
#pragma unroll
        for (int ks = 0; ks < 8; ++ks) uf[ks] = *(const GAS bf16x8*)(ub + 32 * ks); }
        f32x4 S[8];
#pragma unroll
        for (int nt = 0; nt < 8; ++nt) { const LAS unsigned short* pn = PendL + (16 * nt + fr) * 264 + 8 * fq; S[nt] = (f32x4){0.f, 0.f, 0.f, 0.f};
#pragma unroll
            for (int ks = 0; ks < 8; ++ks) { const bf16x8 pf = *(const LAS bf16x8*)(pn + 32 * ks); S[nt] = __builtin_amdgcn_mfma_f32_16x16x32_bf16(uf[ks], pf, S[nt], 0, 0, 0); } }
        f32x4 Y[16];
#pragma unroll
        for (int tl = 0; tl < 16; ++tl) Y[tl] = (f32x4){0.f, 0.f, 0.f, 0.f};
#pragma unroll
        for (int d = 0; d < 16; ++d) { const int j = d - (fq >> 1); bf16x8 kfv = *(const LAS bf16x8*)(KtL + ((j < 0 ? 0 : j) * 16 + fr) * 16 + 8 * (fq & 1)); if (j < 0) kfv = (bf16x8){0, 0, 0, 0, 0, 0, 0, 0};
#pragma unroll
            for (int ks = 0; ks < 8; ++ks) if (d + 2 * ks < 16) Y[d + 2 * ks] = __builtin_amdgcn_mfma_f32_16x16x32_bf16(kfv, uf[ks], Y[d + 2 * ks], 0, 0, 0); }
#pragma unroll
        for (int pt = 0; pt < 4; ++pt) { float xr = 0.f, xi = 0.f;
#pragma unroll
            for (int i = 0; i < 4; ++i) { const float nr = a16r[pt] * xr - a16i[pt] * xi + S[pt][i], ni = a16r[pt] * xi + a16i[pt] * xr + S[pt + 4][i]; xr = nr; xi = ni; }
            Ebuf[slot * 128 + 16 * pt + fr] = xr; Ebuf[slot * 128 + 64 + 16 * pt + fr] = xi; }
        __syncthreads();
        if (wid == 0) {
            float er[32], ei[32];
#pragma unroll
            for (int sl = 0; sl < 32; ++sl) { er[sl] = Ebuf[sl * 128 + lane]; ei[sl] = Ebuf[sl * 128 + 64 + lane]; }
#pragma unroll
            for (int sl = 0; sl < 32; ++sl) { Cbuf[sl * 128 + lane] = cr; Cbuf[sl * 128 + 64 + lane] = ci;
                const float nr = a64r * cr - a64i * ci + er[sl], ni = a64r * ci + a64i * cr + ei[sl]; cr = nr; ci = ni; }
        }
        __syncthreads();
#pragma unroll
        for (int pt = 0; pt < 4; ++pt) { float xr = Cbuf[slot * 128 + 16 * pt + fr], xi = Cbuf[slot * 128 + 64 + 16 * pt + fr];
#pragma unroll
            for (int i = 0; i < 4; ++i) { const unsigned w = pkbf(xr, xi); XP[(4 * fq + i) * 136 + 16 * pt + fr] = (unsigned short)(w & 0xffffu); XP[(4 * fq + i) * 136 + 64 + 16 * pt + fr] = (unsigned short)(w >> 16);
                const float nr = a16r[pt] * xr - a16i[pt] * xi + S[pt][i], ni = a16r[pt] * xi + a16i[pt] * xr + S[pt + 4][i]; xr = nr; xi = ni; } }
        asm volatile("s_waitcnt lgkmcnt(0)" ::: "memory");
        bf16x8 xf[4];
#pragma unroll
        for (int ks = 0; ks < 4; ++ks) xf[ks] = *(const LAS bf16x8*)(XP + fr * 136 + 32 * ks + 8 * fq);
#pragma unroll
        for (int tl = 0; tl < 16; ++tl) { const bf16_t* cp = Cg + (tl * 16 + fr) * 128 + 8 * fq; if ((tl & 3) == 0) asm volatile("" : "+v"(cp) :: "memory"); else asm volatile("" : "+v"(cp));
#pragma unroll
            for (int ks = 0; ks < 4; ++ks) { const bf16x8 cf = *(const GAS bf16x8*)(cp + 32 * ks); Y[tl] = __builtin_amdgcn_mfma_f32_16x16x32_bf16(cf, xf[ks], Y[tl], 0, 0, 0); } }
        bf16_t* yo = Yout + ((size_t)b * SEQL + (size_t)(c0 + fr) * 16) * HW + g * 16 + 4 * fq; asm volatile("" : "+v"(yo));
#pragma unroll
        for (int tl = 0; tl < 16; ++tl) { u32x2 w; w.x = pkbf(gelu_tanh(Y[tl][0]), gelu_tanh(Y[tl][1])); w.y = pkbf(gelu_tanh(Y[tl][2]), gelu_tanh(Y[tl][3])); *(GAS u32x2*)(yo + (size_t)tl * HW) = w; }
        asm volatile("s_waitcnt lgkmcnt(0)" ::: "memory");
    }
    asm volatile("s_waitcnt vmcnt(0)" ::: "memory");
    __syncthreads();
    if (tid == 0) { __builtin_amdgcn_fence(__ATOMIC_RELEASE, "agent"); asm volatile("s_waitcnt vmcnt(0)" ::: "memory"); __hip_atomic_fetch_add(done, 1u, __ATOMIC_RELAXED, __HIP_MEMORY_SCOPE_AGENT); }
}

#define XB_TMO      128
#define XB_XCNT(j)  (256  + 64 * (j))
#define XB_XSUB(j)  (1280 + 64 * (j))
#define XB_XGEN(j)  (2304 + 64 * (j))
#define XB_TOP      3328
#define XB_TOPGEN   3392
#define XCD_BAR_WORDS 3456
#define XB_SPIN_CAP (1u << 18)

__device__ __forceinline__ unsigned xb_ld(unsigned* p)              { return __hip_atomic_load(p, __ATOMIC_RELAXED, __HIP_MEMORY_SCOPE_AGENT); }
__device__ __forceinline__ unsigned xb_add(unsigned* p, unsigned v) { return __hip_atomic_fetch_add(p, v, __ATOMIC_RELAXED, __HIP_MEMORY_SCOPE_AGENT); }
__device__ __forceinline__ unsigned xb_xcc_id() { return (unsigned)__builtin_amdgcn_s_getreg((3 << 11) | 20) & 0xFu; }
#define XB_SPIN(cond, bar) do { unsigned _sp = 0; while (cond) { __builtin_amdgcn_s_sleep(1); \
    if ((++_sp & 255u) == 0u) { if (xb_ld(&(bar)[XB_TMO])) break; if (_sp > XB_SPIN_CAP) { atomicAdd(&(bar)[XB_TMO], 1u); break; } } } } while (0)

struct XcdBarrier {
    unsigned* bar; unsigned x;
    volatile LAS unsigned* st;
};

__device__ __forceinline__ XcdBarrier xcd_barrier_post(unsigned* bar, volatile LAS unsigned* st) {
    XcdBarrier b; b.bar = bar; b.x = xb_xcc_id(); b.st = st;
    if (threadIdx.x == 0) (void)xb_add(&bar[XB_XCNT(b.x)], 1u);
    return b;
}
__device__ __forceinline__ void xcd_barrier_complete(unsigned* bar, unsigned x, unsigned& nloc, unsigned& nx) {
    const unsigned G = gridDim.x * gridDim.y * gridDim.z;
    unsigned sum, cnt, mine, sp = 0u;
    for (;;) {
        sum = 0u; cnt = 0u; mine = 0u;
#pragma unroll
        for (unsigned j = 0; j < 16; ++j) { const unsigned c = xb_ld(&bar[XB_XCNT(j)]); sum += c; cnt += (c > 0u) ? 1u : 0u; mine = (j == x) ? c : mine; }
        if (sum == G) break;
        __builtin_amdgcn_s_sleep(1);
        if ((++sp & 255u) == 0u) { if (xb_ld(&bar[XB_TMO])) break; if (sp > XB_SPIN_CAP) { atomicAdd(&bar[XB_TMO], 1u); break; } }
    }
    nloc = mine > 0u ? mine : 1u; nx = cnt > 0u ? cnt : 1u;
}

__device__ __forceinline__ void xcd_barrier(const XcdBarrier& b) {
    asm volatile("s_waitcnt vmcnt(0)" ::: "memory");
    __syncthreads();
    if (threadIdx.x == 0) {
        unsigned* bar = b.bar;
        __builtin_amdgcn_s_waitcnt(0);
        unsigned nloc = b.st[0], nx = b.st[1];
        if (nloc == 0u) { xcd_barrier_complete(bar, b.x, nloc, nx); b.st[0] = nloc; b.st[1] = nx; }
        const unsigned old = xb_add(&bar[XB_XSUB(b.x)], 1u);
        const unsigned gen = old / nloc;
        if (old + 1u == (gen + 1u) * nloc) {
            __builtin_amdgcn_fence(__ATOMIC_RELEASE, "agent");
            asm volatile("s_waitcnt vmcnt(0)" ::: "memory");
            const unsigned og = xb_add(&bar[XB_TOP], 1u);
            const unsigned tg = og / nx;
            if (og + 1u == (tg + 1u) * nx) xb_add(&bar[XB_TOPGEN], 1u);
            else XB_SPIN(xb_ld(&bar[XB_TOPGEN]) == tg, bar);
            __builtin_amdgcn_fence(__ATOMIC_ACQUIRE, "agent");
            xb_add(&bar[XB_XGEN(b.x)], 1u);
            asm volatile("s_waitcnt vmcnt(0)" ::: "memory");
        } else {
            XB_SPIN(xb_ld(&bar[XB_XGEN(b.x)]) == gen, bar);
            __builtin_amdgcn_fence(__ATOMIC_ACQUIRE, "agent");
            asm volatile("s_waitcnt vmcnt(0)" ::: "memory");
        }
    }
    __syncthreads();
}

#define BHMAP(r) ((((r) & 1) << 3) | (7 - ((r) >> 1)))
constexpr int NATT = 704;
struct Args { const float* in[30]; float* out; unsigned char* ws; };
#define CAS __attribute__((address_space(4)))
#define GSYNC() do { XcdBarrier b_; b_.bar = (unsigned*)(((const CAS Args*)__builtin_amdgcn_kernarg_segment_ptr())->ws + 4096); b_.x = xb_xcc_id(); b_.st = (volatile LAS unsigned*)(lds + MISC_OFF + 32); xcd_barrier(b_); } while (0)
#ifdef PROBE_SEL1
#define STAMP() do { if (blockIdx.x == 0 && threadIdx.x == 0) { unsigned long long* ts_ = (unsigned long long*)(((const CAS Args*)__builtin_amdgcn_kernarg_segment_ptr())->ws + 1024); ts_[nstamp] = __builtin_amdgcn_s_memrealtime(); } ++nstamp; } while (0)
#else
#define STAMP() do {} while (0)
#endif

__global__ void __launch_bounds__(512, 2) mk_fwd(Args a) {
    extern __shared__ __attribute__((aligned(16))) unsigned char lds_raw[];
    cg::grid_group grid = cg::this_grid();
    LAS unsigned char* lds = (LAS unsigned char*)lds_raw;
    const int wave_s = __builtin_amdgcn_readfirstlane((int)(threadIdx.x >> 6));
    int nstamp = 0; (void)nstamp;
    if (threadIdx.x < 32) ((LAS unsigned*)(lds + MISC_OFF))[threadIdx.x] = 0u;
    if (blockIdx.x == 0) { unsigned* cz = (unsigned*)(((const CAS Args*)__builtin_amdgcn_kernarg_segment_ptr())->ws);
        for (int i = threadIdx.x; i < 4480; i += 512) if (i < 128 || i >= 1024) __hip_atomic_store(cz + i, 0u, __ATOMIC_RELAXED, __HIP_MEMORY_SCOPE_AGENT);
        if (threadIdx.x < 64) __hip_atomic_store(cz + 4608 + 64 * threadIdx.x, 0u, __ATOMIC_RELAXED, __HIP_MEMORY_SCOPE_AGENT);
        if (threadIdx.x < 256) __hip_atomic_store(cz + 12288 + threadIdx.x, 0u, __ATOMIC_RELAXED, __HIP_MEMORY_SCOPE_AGENT);
        if (threadIdx.x < 96) __hip_atomic_store(cz + 13312 + threadIdx.x, 0u, __ATOMIC_RELAXED, __HIP_MEMORY_SCOPE_AGENT); }
    __syncthreads();
    grid.sync();
    (void)xcd_barrier_post((unsigned*)(((const CAS Args*)__builtin_amdgcn_kernarg_segment_ptr())->ws + 4096), (volatile LAS unsigned*)(lds + MISC_OFF + 32));
    STAMP();
#define IDS() const CAS Args* ap_ = (const CAS Args*)__builtin_amdgcn_kernarg_segment_ptr(); asm volatile("" : "+s"(ap_)); \
    int tid; asm volatile("v_mbcnt_lo_u32_b32 %0, -1, 0\n\tv_mbcnt_hi_u32_b32 %0, -1, %0" : "=v"(tid)); tid += wave_s * 64; const int lane = tid & 63, wave = __builtin_amdgcn_readfirstlane(tid >> 6); \
    const int G = gridDim.x, bx = blockIdx.x, vcu = (G % 8 == 0) ? (bx % 8) * (G / 8) + bx / 8 : bx; \
    const int gw = vcu * 8 + wave, NGW = G * 8, gt = bx * 512 + tid, NGT = G * 512; (void)lane; (void)gw; (void)NGW; (void)gt; (void)NGT; (void)vcu
#define INP(i) (ap_->in[i])
#define WSP(T, off) ((T*)(ap_->ws + (off)))
#define OUTP (ap_->out)
    {
        IDS();
        const float *x = INP(0), *pin = INP(1), *g_ffn1 = INP(2), *w1_a = INP(3), *w3_a = INP(4), *w2_a = INP(5), *g_mix = INP(6), *w_in = INP(7);
        const float *a_re = INP(9), *a_im = INP(10), *log_dt = INP(11), *b_re = INP(12), *b_im = INP(13);
        const float *w_glu = INP(17), *g_attn_out = INP(19), *g_ssm_out = INP(20), *w_out = INP(21), *g_ffn2 = INP(22), *w1_b = INP(23), *w3_b = INP(24), *w2_b = INP(25);
        const float *g_ple = INP(26), *w_ple_gate = INP(27), *w_ple_proj = INP(28);
        float* AP = WSP(float, WS_AP); float* BB = WSP(float, WS_BB); bf16_t* Wf = WSP(bf16_t, WS_WF); float* ssq0 = WSP(float, WS_SSQ0);
        bf16_t *W13a = WSP(bf16_t, WS_W13A), *W2a = WSP(bf16_t, WS_W2A), *Win = WSP(bf16_t, WS_WIN), *Wglu = WSP(bf16_t, WS_WGLU), *WoA = WSP(bf16_t, WS_WOA);
        bf16_t *W13b = WSP(bf16_t, WS_W13B), *W2b = WSP(bf16_t, WS_W2B), *Wg = WSP(bf16_t, WS_WG), *Wp = WSP(bf16_t, WS_WP), *PB = WSP(bf16_t, WS_PB), *XB = WSP(bf16_t, WS_XB);
        LAS float* scr = (LAS float*)(lds + wave * 16384);
        constexpr int I_13 = 16 * 176, I_IN = 16 * 64;
        constexpr int NITEMS = I_13 + I_IN;
        for (int it = gw; it < NITEMS; it += NGW) {
            int r = it;
            if (r < I_13) { tr_w13(w1_a, w3_a, g_ffn1, W13a, r, scr, lane); continue; } r -= I_13;
            { const int R0 = 32 * (r % 64); tr_item(w_in, 2056, 64 * (r / 64), R0 < 1536 ? R0 : R0 + 8, g_mix, Win, DMODEL, R0, scr, lane); }
        }
        for (int m = gw; m < TOK; m += 2 * NGW) {
            const int m2 = m + NGW; const bool has2 = m2 < TOK; const int mb = has2 ? m2 : m;
            const f32x4* xr = (const f32x4*)(x + (size_t)m * DMODEL) + lane; const f32x4* xr2 = (const f32x4*)(x + (size_t)mb * DMODEL) + lane;
            f32x4 va[4], vb[4];
#pragma unroll
            for (int j = 0; j < 4; ++j) { va[j] = __builtin_nontemporal_load(xr + 64 * j); vb[j] = __builtin_nontemporal_load(xr2 + 64 * j); }
            const f32x4 pa = __builtin_nontemporal_load((const f32x4*)(pin + (size_t)m * PLE) + lane), pb = __builtin_nontemporal_load((const f32x4*)(pin + (size_t)mb * PLE) + lane);
            u32x2* o8 = (u32x2*)(XB + (size_t)m * DMODEL) + lane; u32x2* o8b = (u32x2*)(XB + (size_t)mb * DMODEL) + lane; float ss = 0.f, ss2 = 0.f;
#pragma unroll
            for (int j = 0; j < 4; ++j) { const f32x4 v = va[j]; ss += (v[0] * v[0] + v[1] * v[1]) + (v[2] * v[2] + v[3] * v[3]); u32x2 w; w.x = pkbf(v[0], v[1]); w.y = pkbf(v[2], v[3]); o8[64 * j] = w; }
            ss = wave_sum(ss); if (lane < 16) ssq0[(size_t)m * 16 + lane] = lane == 0 ? ss : 0.f;
            { u32x2 w; w.x = pkbf(pa[0], pa[1]); w.y = pkbf(pa[2], pa[3]); *((u32x2*)(PB + (size_t)m * PLE) + lane) = w; }
            if (has2) {
#pragma unroll
                for (int j = 0; j < 4; ++j) { const f32x4 v = vb[j]; ss2 += (v[0] * v[0] + v[1] * v[1]) + (v[2] * v[2] + v[3] * v[3]); u32x2 w; w.x = pkbf(v[0], v[1]); w.y = pkbf(v[2], v[3]); o8b[64 * j] = w; }
                ss2 = wave_sum(ss2); if (lane < 16) ssq0[(size_t)m2 * 16 + lane] = lane == 0 ? ss2 : 0.f;
                u32x2 w; w.x = pkbf(pb[0], pb[1]); w.y = pkbf(pb[2], pb[3]); *((u32x2*)(PB + (size_t)m2 * PLE) + lane) = w; }
        }
        if (gt < 16384) { const int n = gt >> 10, k = gt & 1023; const float v = n < 8 ? g_mix[k] * w_in[(size_t)k * 2056 + 1536 + n] : 0.f; Wf[gt] = (bf16_t)(pkbf(v, 0.f) & 0xffffu); }
        if (gt < 2048) {
            const int g = gt >> 6; const double dt = exp((double)log_dt[g]), ar = a_re[gt], ai = a_im[gt];
            double cs, sn; cis_d(dt * ai, cs, sn); const double dec = exp(dt * ar), Ar = dec * cs, Ai = dec * sn;
            const double nr = Ar - 1.0, ni = Ai, den = ar * ar + ai * ai, f_r = (nr * ar + ni * ai) / den, f_i = (ni * ar - nr * ai) / den;
            float* ap = AP + gt * 36; double pr = 1.0, pi = 0.0;
            for (int n = 0; n <= 16; ++n) { ap[2 * n] = (float)pr; ap[2 * n + 1] = (float)pi; if (n < 16) { const double t_ = pr * Ar - pi * Ai; pi = pr * Ai + pi * Ar; pr = t_; } }
            double qr = pr * pr - pi * pi, qi = 2.0 * pr * pi; const double q2r = qr * qr - qi * qi, q2i = 2.0 * qr * qi; ap[34] = (float)q2r; ap[35] = (float)q2i;
            for (int h = 0; h < 16; ++h) { const double br = b_re[gt * 16 + h], bi = b_im[gt * 16 + h]; BB[gt * 32 + 2 * h] = (float)(f_r * br - f_i * bi); BB[gt * 32 + 2 * h + 1] = (float)(f_r * bi + f_i * br); }
        }
    }
    GSYNC(); STAMP();

    {
        IDS();
        pg8::Gemm gm{WSP(bf16_t, WS_XB), WSP(bf16_t, WS_W13A), TOK, 2 * DFF, DMODEL}; pg8::StaticOrder S; S.init(TOK, 2 * DFF, G, bx);
        EpiSwiglu E{WSP(bf16_t, WS_H1), WSP(float, WS_SSQ0)};
        pg8::gemm_phase<EpiSwiglu, pg8::StaticOrder, true, true>(lds, gm, S, E, tid);
    }
    if ((int)blockIdx.x >= (int)gridDim.x / 2) {
        IDS();
        const float *c_re = INP(14), *c_im = INP(15), *d_skip = INP(16);
        const float* AP = WSP(float, WS_AP); const float* BB = WSP(float, WS_BB); bf16_t* Ktab = WSP(bf16_t, WS_KTAB); bf16_t* Pend = WSP(bf16_t, WS_PEND); bf16_t* Cc = WSP(bf16_t, WS_CC);
        const int gt2 = (bx - G / 2) * 512 + tid, NGT2 = (G - G / 2) * 512;
        { const float *w2_a = INP(5), *w_glu = INP(17), *g_attn_out = INP(19), *g_ssm_out = INP(20), *w_out = INP(21), *w_ple_proj = INP(28);
          bf16_t *W2a = WSP(bf16_t, WS_W2A), *Wglu = WSP(bf16_t, WS_WGLU), *WoA = WSP(bf16_t, WS_WOA), *Wp = WSP(bf16_t, WS_WP);
          LAS float* scr = (LAS float*)(lds + wave * 16384);
          constexpr int I_2 = 44 * 32, I_GLU = 8 * 16, I_O = 8 * 32, I_P = 4 * 32;
          for (int it = (bx - G / 2) * 8 + wave; it < I_2 + I_GLU + 2 * I_O + I_P; it += (G - G / 2) * 8) {
              int r = it;
              if (r < I_2) { tr_item(w2_a, DMODEL, 64 * (r / 32), 32 * (r % 32), nullptr, W2a, DFF, 32 * (r % 32), scr, lane); continue; } r -= I_2;
              if (r < I_GLU) { tr_item(w_glu, HW, 64 * (r / 16), 32 * (r % 16), nullptr, Wglu, HW, 32 * (r % 16), scr, lane); continue; } r -= I_GLU;
              if (r < 2 * I_O) { const int kb = r / 32; tr_item(w_out, DMODEL, 64 * kb, 32 * (r % 32), kb < 8 ? g_attn_out : g_ssm_out - HW, WoA, DMODEL, 32 * (r % 32), scr, lane); continue; } r -= 2 * I_O;
              tr_item(w_ple_proj, DMODEL, 64 * (r / 32), 32 * (r % 32), nullptr, Wp, PLE, 32 * (r % 32), scr, lane);
          } }
        for (int idx = gt2; idx < 131072; idx += NGT2) {
            const int g = idx >> 12, j = (idx >> 8) & 15, h = (idx >> 4) & 15, hp = idx & 15; float s = 0.f;
#pragma unroll 16
            for (int p = 0; p < 64; ++p) { const float Cr = c_re[(g * 16 + h) * 64 + p], Ci = c_im[(g * 16 + h) * 64 + p], Ar = AP[(g * 64 + p) * 36 + 2 * j], Ai = AP[(g * 64 + p) * 36 + 2 * j + 1];
                const float Wr = Cr * Ar - Ci * Ai, Wi = Cr * Ai + Ci * Ar, Br = BB[(g * 64 + p) * 32 + 2 * hp], Bi = BB[(g * 64 + p) * 32 + 2 * hp + 1]; s += Wr * Br - Wi * Bi; }
            if (j == 0 && h == hp) s += d_skip[g * 16 + h];
            Ktab[idx] = (bf16_t)(pkbf(s, 0.f) & 0xffffu);
        }
        for (int idx = gt2; idx < 1048576; idx += NGT2) {
            { const int g = idx >> 15, comp = (idx >> 8) & 127, k = idx & 255, p = comp & 63, im = comp >> 6, sl = k >> 4, hp = k & 15;
              const float Ar = AP[(g * 64 + p) * 36 + 2 * (15 - sl)], Ai = AP[(g * 64 + p) * 36 + 2 * (15 - sl) + 1], Br = BB[(g * 64 + p) * 32 + 2 * hp], Bi = BB[(g * 64 + p) * 32 + 2 * hp + 1];
              const float v = im ? (Ar * Bi + Ai * Br) : (Ar * Br - Ai * Bi); Pend[idx] = (bf16_t)(pkbf(v, 0.f) & 0xffffu); }
            { const int g = idx >> 15, n = (idx >> 7) & 255, tl = n >> 4, h = n & 15, comp = idx & 127, p = comp & 63, im = comp >> 6;
              const float Cr = c_re[(g * 16 + h) * 64 + p], Ci = c_im[(g * 16 + h) * 64 + p], Ar = AP[(g * 64 + p) * 36 + 2 * (tl + 1)], Ai = AP[(g * 64 + p) * 36 + 2 * (tl + 1) + 1];
              const float v = im ? -(Cr * Ai + Ci * Ar) : (Cr * Ar - Ci * Ai); Cc[idx] = (bf16_t)(pkbf(v, 0.f) & 0xffffu); }
        }
    }
    GSYNC(); STAMP();
    {
        IDS();
        pg8::Gemm gm{WSP(bf16_t, WS_H1), WSP(bf16_t, WS_W2A), TOK, DMODEL, DFF}; pg8::StaticOrder S; S.init(TOK, DMODEL, G, bx);
        EpiRes<false, true> E{nullptr, WSP(bf16_t, WS_XB), WSP(float, WS_SSQ1), nullptr, 0.5f};
        pg8::gemm_phase<EpiRes<false, true>, pg8::StaticOrder, true, true>(lds, gm, S, E, tid);
    }
    GSYNC(); STAMP();
    {
        IDS();
        const float* b_f = INP(8); const bf16_t* XB = WSP(bf16_t, WS_XB); const bf16_t* Wf = WSP(bf16_t, WS_WF); const float* ssq1 = WSP(float, WS_SSQ1); float* LOGF = WSP(float, WS_LOGF);
        const int fr = lane & 15, fq = lane >> 4;
        for (int it = gw >> 1; it < TOK / 16; it += NGW >> 1) {
            const int t0 = it * 16, kh = wave & 1; f32x4 acc0 = (f32x4){0.f, 0.f, 0.f, 0.f}, acc1 = acc0;
            const bf16_t* ap = XB + (size_t)(t0 + fr) * DMODEL + 8 * fq + 512 * kh; const bf16_t* bp = Wf + fr * DMODEL + 8 * fq + 512 * kh;
            bf16x8 av[16], bv[16];
#pragma unroll
            for (int ks = 0; ks < 16; ++ks) { av[ks] = *(const bf16x8*)(ap + 32 * ks); bv[ks] = *(const bf16x8*)(bp + 32 * ks); }
#pragma unroll
            for (int ks = 0; ks < 16; ks += 2) { acc0 = __builtin_amdgcn_mfma_f32_16x16x32_bf16(av[ks], bv[ks], acc0, 0, 0, 0); acc1 = __builtin_amdgcn_mfma_f32_16x16x32_bf16(av[ks + 1], bv[ks + 1], acc1, 0, 0, 0); }
            f32x4 acc = acc0 + acc1;
            LAS f32x4* xch = (LAS f32x4*)(lds + (wave >> 1) * 1024) + lane;
            if (kh) *xch = acc;
            __syncthreads();
            if (!kh) { acc = acc + *xch;
                if (fr < 8) { const int r0 = t0 + 4 * fq; const float bf = b_f[fr]; f32x4 o;
#pragma unroll
                    for (int i = 0; i < 4; ++i) { const float z = rstd_row<16>(ssq1, r0 + i, 1.f / 1024.f) * acc[i] + bf; o[i] = fminf(z, 0.f) - log1pf(expf(-fabsf(z))); }
                    *(f32x4*)(LOGF + (size_t)((r0 >> 13) * 8 + fr) * SEQL + (r0 & 8191)) = o; } }
            __syncthreads();
        }
        pg8::Gemm gm{XB, WSP(bf16_t, WS_WIN), TOK, 2048, DMODEL}; pg8::StaticOrder S; S.init(TOK, 2048, G, bx);
        EpiQKVU E{WSP(bf16_t, WS_Q), WSP(bf16_t, WS_U), ssq1, WSP(unsigned, WS_CTL) + 13312};
        pg8::gemm_phase<EpiQKVU, pg8::StaticOrder, true, true>(lds, gm, S, E, tid);
    }
    GSYNC(); STAMP();
    {
        volatile LAS int* qs = (volatile LAS int*)(lds + MISC_OFF);
        int qfirst = 1;
        for (;;) {
            IDS();
            int item;
            if (qfirst) { item = bx; qfirst = 0; }
            else {
                if (tid == 0) qs[0] = G + (int)__hip_atomic_fetch_add(WSP(unsigned, WS_CTL) + 64, 1u, __ATOMIC_RELAXED, __HIP_MEMORY_SCOPE_AGENT);
                __syncthreads();
                item = __builtin_amdgcn_readfirstlane(qs[0]);
                __syncthreads(); }
            if (item >= 64 + NATT + 176 + 256 + 128) break;
            if (item >= 64 + NATT + 176 + 256) {
                const int j_ = item - (64 + NATT + 176 + 256);
                if (tid == 0) { unsigned* dn = WSP(unsigned, WS_CTL) + 13400 + (j_ >> 6);
                    for (unsigned sp = 0; sp < (1u << 22); ++sp) { if (__hip_atomic_load(dn, __ATOMIC_RELAXED, __HIP_MEMORY_SCOPE_AGENT) >= 32u) break; __builtin_amdgcn_s_sleep(8); }
                    __builtin_amdgcn_fence(__ATOMIC_ACQUIRE, "agent"); asm volatile("s_waitcnt vmcnt(0)" ::: "memory"); }
                __syncthreads();
                pg8::Gemm gm{WSP(bf16_t, WS_Y), WSP(bf16_t, WS_WGLU), TOK, HW, HW}; StrideOrder S{j_, 1 << 28, 128, 2};
                EpiGlu E{WSP(bf16_t, WS_Y), INP(18), WSP(bf16_t, WS_SSMO), WSP(float, WS_SSQS)};
                pg8::gemm_phase<EpiGlu, StrideOrder, true, true>(lds, gm, S, E, tid); continue; }
            if (item >= 64 + NATT + 176) {
                pg8::Gemm gm{WSP(bf16_t, WS_PB), WSP(bf16_t, WS_WP), TOK, DMODEL, PLE}; StrideOrder S{item - (64 + NATT + 176), 1 << 28, 256, 4};
                EpiBf16P E{WSP(bf16_t, WS_PP)};
                pg8::gemm_phase<EpiBf16P, StrideOrder, true, true>(lds, gm, S, E, tid); continue; }
            if (item >= 64 + NATT) {
                tr_w13(INP(23), INP(24), INP(22), WSP(bf16_t, WS_W13B), (item - (64 + NATT)) * 16 + wave * 2, (LAS float*)(lds + wave * 16384), lane);
                tr_w13(INP(23), INP(24), INP(22), WSP(bf16_t, WS_W13B), (item - (64 + NATT)) * 16 + wave * 2 + 1, (LAS float*)(lds + wave * 16384), lane);
                __syncthreads(); continue; }
            const bool is_ssm = item < 64;
#ifdef PROBE_SEL1
            const unsigned long long t0_ = __builtin_amdgcn_s_memrealtime();
#endif
            if (is_ssm) ssm_item(item, WSP(bf16_t, WS_U), WSP(bf16_t, WS_KTAB), WSP(bf16_t, WS_PEND), WSP(bf16_t, WS_CC), WSP(float, WS_AP), WSP(bf16_t, WS_Y), lds, tid, WSP(unsigned, WS_CTL) + 13400 + (item >> 5));
            else { const int a_ = item - 64; int kind, bh, qb;
                if (a_ < 64) { kind = 2; bh = BHMAP(a_ & 15); qb = 19 - (a_ >> 4); }
                else if (a_ < 64 + 576) { const int c_ = a_ - 64, lvl = c_ / 48, r_ = c_ % 48; kind = r_ >> 4; bh = BHMAP(r_ & 15); qb = kind < 2 ? 31 - lvl : 15 - lvl; }
                else { const int c_ = a_ - 640; kind = 2; bh = BHMAP(c_ & 15); qb = 3 - (c_ >> 4); }
                const int ntf = 4 * (qb + 1), tm = ntf >> 1, tb = kind == 0 ? tm : 0, te = kind == 1 ? tm : ntf, mode = kind == 2 ? 0 : (kind == 0 ? 2 : 1), sid = kind < 2 ? (qb - 20) * 16 + bh : 0;
                attn_body::attn_unit<96>(bh >> 3, bh & 7, qb, tb, te, mode, (sid < 60 ? WSP(float, 180 * MiB) + (size_t)sid * PARTF : sid < 105 ? WSP(float, WS_W2B) + (size_t)(sid - 60) * PARTF : WSP(float, 236 * MiB) + (size_t)(sid - 105) * PARTF), WSP(unsigned, WS_CTL) + 12288 + sid, WSP(unsigned, WS_CTL) + 13312 + 2 * bh,
                    WSP(attn_body::bf16, WS_Q), WSP(attn_body::bf16, WS_K), WSP(attn_body::bf16, WS_V), WSP(attn_body::bf16, WS_Q), WSP(float, WS_LOGF), WSP(float, WS_SSQA), (char*)lds_raw, tid); }
#ifdef PROBE_SEL1
            if (tid == 0) { const unsigned d_ = (unsigned)(__builtin_amdgcn_s_memrealtime() - t0_); atomicMax(WSP(unsigned, WS_CTL) + (is_ssm ? 128 : 129), d_); if (is_ssm) atomicMin(WSP(unsigned, WS_CTL) + 130, ~d_); }
#endif
        }
    }
    GSYNC(); STAMP();
    {
        { IDS(); pg8::Gemm gm{WSP(bf16_t, WS_Q), WSP(bf16_t, WS_WOA), TOK, DMODEL, DMODEL, WSP(bf16_t, WS_SSMO), HW}; pg8::StaticOrder S; S.init(TOK, DMODEL, G, bx);
          EpiOut E{WSP(bf16_t, WS_XB), WSP(float, WS_SSQ2), WSP(float, WS_SSQA), WSP(float, WS_SSQS)};
          pg8::gemm_phase<EpiOut, pg8::StaticOrder, true, true>(lds, gm, S, E, tid); }
    }
    GSYNC(); STAMP();
    {
        IDS();
        pg8::Gemm gm{WSP(bf16_t, WS_XB), WSP(bf16_t, WS_W13B), TOK, 2 * DFF, DMODEL}; pg8::StaticOrder S; S.init(TOK, 2 * DFF, G, bx);
        EpiSwiglu E{WSP(bf16_t, WS_H1), WSP(float, WS_SSQ2)};
        pg8::gemm_phase<EpiSwiglu, pg8::StaticOrder, true, true>(lds, gm, S, E, tid);
    }
    if ((int)blockIdx.x >= (int)gridDim.x / 2) {
        IDS();
        const float *w2_b = INP(25), *g_ple = INP(26), *w_ple_gate = INP(27); bf16_t *W2b = WSP(bf16_t, WS_W2B), *Wg = WSP(bf16_t, WS_WG);
        LAS float* scr = (LAS float*)(lds + wave * 16384);
        constexpr int I_2 = 44 * 32, I_G = 16 * 32;
        for (int it = (bx - G / 2) * 8 + wave; it < I_2 + I_G; it += (G - G / 2) * 8) {
            int r = it;
            if (r < I_2) { tr_item(w2_b, DMODEL, 64 * (r / 32), 32 * (r % 32), nullptr, W2b, DFF, 32 * (r % 32), scr, lane); continue; } r -= I_2;
            tr_item(w_ple_gate, DMODEL, 64 * (r / 32), 32 * (r % 32), g_ple, Wg, DMODEL, 32 * (r % 32), scr, lane);
        }
    }
    GSYNC(); STAMP();
    {
        IDS();
        pg8::Gemm gm{WSP(bf16_t, WS_H1), WSP(bf16_t, WS_W2B), TOK, DMODEL, DFF}; pg8::StaticOrder S; S.init(TOK, DMODEL, G, bx);
        EpiRes<false, true> E{nullptr, WSP(bf16_t, WS_XB), WSP(float, WS_SSQ3), nullptr, 0.5f};
        pg8::gemm_phase<EpiRes<false, true>, pg8::StaticOrder, true, true>(lds, gm, S, E, tid);
    }
    GSYNC(); STAMP();
    {
        if ((int)gridDim.x == 256) { IDS(); pg8::Gemm gm{WSP(bf16_t, WS_XB), WSP(bf16_t, WS_WG), TOK, DMODEL, DMODEL}; pg8::StaticOrder S; S.init(TOK, DMODEL, G, bx);
          EpiGateFinal E{WSP(bf16_t, WS_XB), OUTP, WSP(bf16_t, WS_PP), WSP(float, WS_SSQ3), WSP(float, WS_SSQ4), WSP(unsigned, WS_CTL) + 4608, INP(29)};
          pg8::gemm_phase<EpiGateFinal, pg8::StaticOrder, true, true>(lds, gm, S, E, tid); }
        else { IDS(); pg8::Gemm gm{WSP(bf16_t, WS_XB), WSP(bf16_t, WS_WG), TOK, DMODEL, DMODEL}; pg8::StaticOrder S; S.init(TOK, DMODEL, G, bx);
          EpiGate E{WSP(bf16_t, WS_XB), OUTP, WSP(bf16_t, WS_PP), WSP(float, WS_SSQ3), WSP(float, WS_SSQ4)};
          pg8::gemm_phase<EpiGate, pg8::StaticOrder, true, true>(lds, gm, S, E, tid); }
    }
    if ((int)gridDim.x != 256) {
    GSYNC(); STAMP();
    { IDS(); const float* ssq4 = WSP(float, WS_SSQ4); float* out = OUTP; const float* g_final = INP(29);
    for (int m = gw; m < TOK; m += NGW) {
        const float rs = rstd_row<16>(ssq4, m, 1.f / 1024.f); f32x4* o = (f32x4*)(out + (size_t)m * DMODEL) + lane; const f32x4* gf = (const f32x4*)g_final + lane;
#pragma unroll
        for (int j = 0; j < 4; ++j) { const f32x4 v = o[64 * j], gg = gf[64 * j]; o[64 * j] = v * rs * gg; }
    } }
    }
#ifdef PROBE_SEL1
    GSYNC(); STAMP();
    if (blockIdx.x == 0) { IDS(); const unsigned long long* ts_ = (const unsigned long long*)(ap_->ws + 1024); const unsigned* cw = WSP(unsigned, WS_CTL);
        float dur[15];
#pragma unroll
        for (int k = 0; k < 11; ++k) dur[k] = (float)(ts_[k + 1] - ts_[k]) * 0.01f;
        dur[11] = (float)cw[128] * 0.01f; dur[12] = (float)cw[129] * 0.01f; dur[13] = (float)(~cw[130]) * 0.01f; dur[14] = (float)(ts_[11] - ts_[0]) * 0.01f;
        float t1 = 0.f, t2 = 0.f;
#pragma unroll
        for (int k = 0; k < 15; ++k) { if (k == PROBE_SEL1) t1 = dur[k]; if (k == PROBE_SEL2) t2 = dur[k]; }
        if (tid == 0) OUTP[0] += t1 * 0.01f;
        for (int r = tid; r < 1024; r += 512) OUTP[(size_t)(r * 16) * DMODEL + 1] += t2 * 0.01f; }
#endif
}

extern "C" void kernel_launch(void* const* d_in, const int* in_sizes, int n_in, void* d_out, int out_size, void* d_ws, size_t ws_size, hipStream_t stream) {
    static int grid = 0;
    if (grid == 0) {
        if (n_in != 30 || out_size != TOK * DMODEL || ws_size < WS_END) { fprintf(stderr, "kernel_launch: unexpected problem (n_in %d out %d ws %zu)\n", n_in, out_size, ws_size); grid = -1; return; }
        int dev = 0, cus = 0, per_cu = 0;
        (void)hipGetDevice(&dev); (void)hipDeviceGetAttribute(&cus, hipDeviceAttributeMultiprocessorCount, dev);
        if (hipFuncSetAttribute((const void*)mk_fwd, hipFuncAttributeMaxDynamicSharedMemorySize, LDS_BYTES) != hipSuccess) { fprintf(stderr, "kernel_launch: hipFuncSetAttribute failed\n"); grid = -1; return; }
        if (hipOccupancyMaxActiveBlocksPerMultiprocessor(&per_cu, (const void*)mk_fwd, 512, LDS_BYTES) != hipSuccess || per_cu < 1) { fprintf(stderr, "kernel_launch: occupancy query gave %d\n", per_cu); per_cu = 1; }
        (void)hipGetLastError();
        grid = cus * per_cu;
    }
    if (grid < 0) return;
    Args a{};
    for (int i = 0; i < 30; ++i) a.in[i] = (const float*)d_in[i];
    a.out = (float*)d_out; a.ws = (unsigned char*)d_ws;
    void* args[] = {&a};
    hipError_t e = hipLaunchCooperativeKernel((const void*)mk_fwd, dim3(grid), dim3(512), args, LDS_BYTES, stream);
    if (e != hipSuccess) fprintf(stderr, "kernel_launch: cooperative launch failed: %s (grid %d)\n", hipGetErrorString(e), grid);
}
```

```cpp
#include <hip/hip_runtime.h>
#include <hip/hip_bf16.h>
#include <cmath>
#include <hip/hip_cooperative_groups.h>
#include <cstdio>
#include <cstdint>
namespace cg = cooperative_groups;
template <int MASK> __device__ __forceinline__ float sx(float v) { return __builtin_bit_cast(float, __builtin_amdgcn_ds_swizzle(__builtin_bit_cast(int, v), (MASK << 10) | 0x1f)); }
__device__ __forceinline__ float sum32(float v) { unsigned a = __builtin_bit_cast(unsigned, v), b = a; asm volatile("v_nop\n\tv_nop\n\tv_permlane32_swap_b32 %0, %1" : "+v"(a), "+v"(b)); return __builtin_bit_cast(float, a) + __builtin_bit_cast(float, b); }
__device__ __forceinline__ float max32(float v) { unsigned a = __builtin_bit_cast(unsigned, v), b = a; asm volatile("v_nop\n\tv_nop\n\tv_permlane32_swap_b32 %0, %1" : "+v"(a), "+v"(b)); return __builtin_fmaxf(__builtin_bit_cast(float, a), __builtin_bit_cast(float, b)); }
namespace pg8 {
#define PG8_LAS __attribute__((address_space(3)))
typedef unsigned short bf16_t;
typedef short bf16x8 __attribute__((ext_vector_type(8)));
typedef float f32x4 __attribute__((ext_vector_type(4)));
typedef unsigned u32x4 __attribute__((ext_vector_type(4)));
constexpr int BM = 256, BK = 64, HALF = 128, HTB = HALF * BK * 2  , STAGE_BYTES = 8 * HTB, NXCD = 8, WGM = 8;

__host__ __device__ __forceinline__ int lds_byte(int r, int c) { const int st = (r >> 4) * 2 + (c >> 5), rr = r & 15, cc = c & 31, ob = rr * 64 + cc * 2; return st * 1024 + (ob ^ (((ob >> 9) & 1) << 5)); }
__host__ __device__ __forceinline__ void stage_rc(int b, int& R, int& C) { const int st = b / 1024, sb = b % 1024, swz = sb ^ (((sb >> 9) & 1) << 5); R = (st >> 1) * 16 + swz / 64; C = (st & 1) * 32 + (swz % 64) / 2; }
__host__ __device__ __forceinline__ int perm32(int rho) { const int n = rho >> 4, i = rho & 15; return 8 * (i >> 2) + 4 * n + (i & 3); }

struct Unit { int pm, pn; };
struct Gemm { const bf16_t* A; const bf16_t* Bt; int M, N, K; const bf16_t* A2 = nullptr; int lda = 0; };

struct StaticOrder {
    int nM, nN, nwg, G, c;
    __host__ __device__ void init(int M, int N, int G_, int c_) { nM = M / BM; nN = N / BM; nwg = nM * nN; G = G_; c = c_; }
    __host__ __device__ bool next(int i, Unit& u) const {
        const long L = (long)i * G + c; if (L >= nwg) return false;
        int wgid = (int)L; { const int q = nwg / NXCD, r = nwg % NXCD, xcd = wgid % NXCD, off = wgid / NXCD; wgid = (xcd < r ? xcd * (q + 1) : r * (q + 1) + (xcd - r) * q) + off; }
        const int nig = WGM * nN, gid = wgid / nig, fm = gid * WGM, gsz = (nM - fm) < WGM ? (nM - fm) : WGM;
        u.pm = fm + ((wgid % nig) % gsz); u.pn = (wgid % nig) / gsz; return true;
    }
    __device__ __forceinline__ void a_ready(const Unit&) const {}
    __device__ __forceinline__ void done(const Unit&) const {}
};

__device__ __forceinline__ unsigned cvt_pk_bf16(float lo, float hi) { unsigned r; asm volatile("v_cvt_pk_bf16_f32 %0, %1, %2" : "=v"(r) : "v"(lo), "v"(hi)); return r; }
typedef float f32x2 __attribute__((ext_vector_type(2)));
template <class Epi, class Sched, bool ALIGN_EPI = false, bool SP2 = false>
__device__ __forceinline__ void gemm_phase(PG8_LAS unsigned char* lds, const Gemm g, const Sched& S, const Epi& E, int tid_in) {
    int tid_ = tid_in; asm volatile("" : "+v"(tid_)); const int tid = tid_, wid = __builtin_amdgcn_readfirstlane(tid >> 6), lane = tid & 63, wr = wid >> 2, wc = wid & 3, fr = lane & 15, fq = lane >> 4;
    const int K = g.K, nt = K / BK, lda = g.lda ? g.lda : K, ksplit = g.A2 ? nt / 2 : nt;
    unsigned voffA[2], voffB[2];
#pragma unroll
    for (int i = 0; i < 2; ++i) { int R, C; stage_rc(tid * 16 + i * 8192, R, C); const int Rb = Epi::PERM ? ((R & ~31) + perm32(R & 31)) : R;
        voffA[i] = (unsigned)(R * lda + C) * 2u; voffB[i] = (unsigned)(Rb * K + C) * 2u; }
    const size_t kstep = (size_t)(BK * 2);
    const size_t hstep = (size_t)HALF * K * 2;
    const size_t tstep = 2 * hstep; const size_t hstepA = (size_t)HALF * lda * 2, tstepA = 2 * hstepA;
    const unsigned ldsw = (unsigned)wid * 1024u;
    const int aoff = lds_byte(wr * 64 + fr, fq * 8), boff = lds_byte(wc * 32 + fr, fq * 8);
#define PG8_SA(b, h) (((b) * 2 + (h)) * HTB)
#define PG8_SB(b, h) ((4 + (b) * 2 + (h)) * HTB)
#define PG8_STAGE(bufoff, gbase, voff) do { _Pragma("unroll") for (int _i = 0; _i < 2; ++_i) \
        __builtin_amdgcn_global_load_lds((const unsigned*)((const char*)(gbase) + (voff)[_i]), (PG8_LAS unsigned*)(lds + (bufoff) + ldsw + _i * 8192), 16, 0, 0); } while (0)
#define PG8_LDA(dst, b, h) do { _Pragma("unroll") for (int m = 0; m < 4; ++m) _Pragma("unroll") for (int k = 0; k < 2; ++k) dst[m][k] = *(const PG8_LAS bf16x8*)(lds + PG8_SA(b, h) + aoff + m * 2048 + k * 1024); } while (0)
#define PG8_LDB(dst, b, h) do { _Pragma("unroll") for (int n = 0; n < 2; ++n) _Pragma("unroll") for (int k = 0; k < 2; ++k) dst[n][k] = *(const PG8_LAS bf16x8*)(lds + PG8_SB(b, h) + boff + n * 2048 + k * 1024); } while (0)
#define PG8_MMA(ai, bj, At, Bt) do { __builtin_amdgcn_s_setprio(1); _Pragma("unroll") for (int m = 0; m < 4; ++m) _Pragma("unroll") for (int n = 0; n < 2; ++n) _Pragma("unroll") for (int k = 0; k < 2; ++k) \
        acc[ai][bj][m][n] = __builtin_amdgcn_mfma_f32_16x16x32_bf16(Bt[n][k], At[m][k], acc[ai][bj][m][n], 0, 0, 0); __builtin_amdgcn_s_setprio(0); } while (0)
#define PG8_WAIT_V(n) asm volatile("s_waitcnt vmcnt(" #n ")" ::: "memory")
#define PG8_WAIT_L(n) asm volatile("s_waitcnt lgkmcnt(" #n ")" ::: "memory")
#define PG8_BAR __builtin_amdgcn_s_barrier()
#define PG8_SCHED __builtin_amdgcn_sched_barrier(0)
    Unit cur, nxt; int ui = 0;
    if (!S.next(0, cur)) return;
    f32x4 acc[2][2][4][2];
#pragma unroll
    for (int a = 0; a < 2; ++a)
#pragma unroll
        for (int b = 0; b < 2; ++b)
#pragma unroll
            for (int m = 0; m < 4; ++m)
#pragma unroll
                for (int n = 0; n < 2; ++n) acc[a][b][m][n] = (f32x4){0.f, 0.f, 0.f, 0.f};
    bf16x8 At[4][2], B0[2][2], B1[2][2];
    const char* cA = (const char*)g.A + (size_t)cur.pm * tstepA; const char* cA2 = (const char*)g.A2 + (size_t)cur.pm * tstepA; const char* cB = (const char*)g.Bt + (size_t)cur.pn * tstep;
    S.a_ready(cur);
    if constexpr (SP2) {
        PG8_STAGE(PG8_SB(0, 0), cB, voffB); PG8_STAGE(PG8_SB(0, 1), cB + hstep, voffB); PG8_STAGE(PG8_SA(0, 0), cA, voffA); PG8_STAGE(PG8_SA(0, 1), cA + hstepA, voffA);
        if (wr == 1) PG8_BAR;
        PG8_WAIT_V(2); PG8_BAR;
        PG8_STAGE(PG8_SB(1, 0), cB + kstep, voffB); PG8_STAGE(PG8_SA(1, 0), cA + kstep, voffA); PG8_STAGE(PG8_SB(1, 1), cB + hstep + kstep, voffB);
        PG8_WAIT_V(6); PG8_BAR;
    } else {
        PG8_STAGE(PG8_SB(0, 0), cB, voffB); PG8_STAGE(PG8_SA(0, 0), cA, voffA); PG8_STAGE(PG8_SB(0, 1), cB + hstep, voffB); PG8_STAGE(PG8_SA(0, 1), cA + hstepA, voffA);
        if (wr == 1) PG8_BAR;
        PG8_WAIT_V(4); PG8_BAR;
        PG8_STAGE(PG8_SB(1, 0), cB + kstep, voffB); PG8_STAGE(PG8_SA(1, 0), cA + kstep, voffA); PG8_STAGE(PG8_SB(1, 1), cB + hstep + kstep, voffB);
        PG8_WAIT_V(6); PG8_BAR;
    }
    for (;;) {
        const bool has_next = S.next(ui + 1, nxt);
        const char* nA = has_next ? (const char*)g.A + (size_t)nxt.pm * tstepA : cA; const char* nA2 = has_next ? (const char*)g.A2 + (size_t)nxt.pm * tstepA : cA2; const char* nB = has_next ? (const char*)g.Bt + (size_t)nxt.pn * tstep : cB;
        for (int t = 0; t < nt; t += 2) {
            const bool last = (t == nt - 2);
            const char* a1 = (t + 1 < ksplit) ? cA + (size_t)(t + 1) * kstep : cA2 + (size_t)(t + 1 - ksplit) * kstep;
            const char* a2 = last ? nA : ((t + 2 < ksplit) ? cA + (size_t)(t + 2) * kstep : cA2 + (size_t)(t + 2 - ksplit) * kstep); const char* b2 = last ? nB : cB + (size_t)(t + 2) * kstep;
            const char* a3 = a2 + kstep; const char* b3 = b2 + kstep;
            if (last && has_next) S.a_ready(nxt);
            if constexpr (Epi::MIDK) { if (t == nt / 2) { int l_; asm volatile("v_mbcnt_lo_u32_b32 %0, -1, 0\n\tv_mbcnt_hi_u32_b32 %0, -1, %0" : "=v"(l_)); E.mid(acc, cur, wr, wc, l_ & 15, l_ >> 4); } }
            if constexpr (SP2) {
            PG8_LDB(B0, 0, 0); PG8_LDB(B1, 0, 1); PG8_SCHED; PG8_LDA(At, 0, 0); PG8_STAGE(PG8_SA(1, 1), a1 + hstepA, voffA);
            PG8_WAIT_V(8); PG8_WAIT_L(0); PG8_BAR; PG8_MMA(0, 0, At, B0); PG8_MMA(0, 1, At, B1); PG8_BAR; PG8_SCHED;
            PG8_LDA(At, 0, 1); PG8_STAGE(PG8_SB(0, 0), b2, voffB); PG8_STAGE(PG8_SB(0, 1), b2 + hstep, voffB); PG8_STAGE(PG8_SA(0, 0), a2, voffA);
            PG8_WAIT_V(8); PG8_WAIT_L(0); PG8_BAR; PG8_MMA(1, 0, At, B0); PG8_MMA(1, 1, At, B1); PG8_BAR; PG8_SCHED;
            PG8_LDB(B0, 1, 0); PG8_LDB(B1, 1, 1); PG8_SCHED; PG8_LDA(At, 1, 0); PG8_STAGE(PG8_SA(0, 1), a2 + hstepA, voffA);
            PG8_WAIT_V(8); PG8_WAIT_L(0); PG8_BAR; PG8_MMA(0, 0, At, B0); PG8_MMA(0, 1, At, B1); PG8_BAR; PG8_SCHED;
            PG8_LDA(At, 1, 1); PG8_STAGE(PG8_SB(1, 0), b3, voffB); PG8_STAGE(PG8_SB(1, 1), b3 + hstep, voffB); PG8_STAGE(PG8_SA(1, 0), a3, voffA);
            PG8_WAIT_V(8); PG8_WAIT_L(0); PG8_BAR; PG8_MMA(1, 0, At, B0); PG8_MMA(1, 1, At, B1); PG8_BAR; PG8_SCHED;
            } else {
            PG8_LDB(B0, 0, 0); PG8_SCHED; PG8_LDA(At, 0, 0); PG8_STAGE(PG8_SA(1, 1), a1 + hstepA, voffA);
            PG8_WAIT_L(8); PG8_BAR; PG8_WAIT_L(0); PG8_MMA(0, 0, At, B0); PG8_BAR; PG8_SCHED;
            PG8_LDB(B1, 0, 1); PG8_STAGE(PG8_SB(0, 0), b2, voffB);
            PG8_BAR; PG8_WAIT_L(0); PG8_MMA(0, 1, At, B1); PG8_BAR;
            PG8_LDA(At, 0, 1); PG8_STAGE(PG8_SA(0, 0), a2, voffA);
            PG8_BAR; PG8_WAIT_L(0); PG8_MMA(1, 0, At, B0); PG8_BAR; PG8_SCHED;
            PG8_STAGE(PG8_SB(0, 1), b2 + hstep, voffB);
            PG8_WAIT_V(6); PG8_BAR; PG8_MMA(1, 1, At, B1); PG8_BAR;
            PG8_LDB(B0, 1, 0); PG8_SCHED; PG8_LDA(At, 1, 0); PG8_STAGE(PG8_SA(0, 1), a2 + hstepA, voffA);
            PG8_WAIT_L(8); PG8_BAR; PG8_WAIT_L(0); PG8_MMA(0, 0, At, B0); PG8_BAR; PG8_SCHED;
            PG8_LDB(B1, 1, 1); PG8_STAGE(PG8_SB(1, 0), b3, voffB);
            PG8_BAR; PG8_WAIT_L(0); PG8_MMA(0, 1, At, B1); PG8_BAR;
            PG8_LDA(At, 1, 1); PG8_STAGE(PG8_SA(1, 0), a3, voffA);
            PG8_BAR; PG8_WAIT_L(0); PG8_MMA(1, 0, At, B0); PG8_BAR; PG8_SCHED;
            PG8_STAGE(PG8_SB(1, 1), b3 + hstep, voffB);
            PG8_WAIT_V(6); PG8_BAR; PG8_MMA(1, 1, At, B1); PG8_BAR;
            }
        }
        if constexpr (ALIGN_EPI) { if (wr == 0) PG8_BAR; }
        if constexpr (!Epi::AFTER_DRAIN) { int l_; asm volatile("v_mbcnt_lo_u32_b32 %0, -1, 0\n\tv_mbcnt_hi_u32_b32 %0, -1, %0" : "=v"(l_)); E(acc, cur, wr, wc, l_ & 15, l_ >> 4); S.done(cur); }
        if (!has_next) break;
#pragma unroll
        for (int a = 0; a < 2; ++a)
#pragma unroll
            for (int b = 0; b < 2; ++b)
#pragma unroll
                for (int m = 0; m < 4; ++m)
#pragma unroll
                    for (int n = 0; n < 2; ++n) acc[a][b][m][n] = (f32x4){0.f, 0.f, 0.f, 0.f};
        cur = nxt; cA = nA; cA2 = nA2; cB = nB; ++ui;
        if constexpr (ALIGN_EPI) { if (wr == 1) PG8_BAR; }
    }
    PG8_WAIT_V(0);
    if constexpr (!ALIGN_EPI) { if (wr == 0) PG8_BAR; }
    PG8_BAR;
    if constexpr (Epi::AFTER_DRAIN) { E.fused(acc, cur, wr, wc, fr, fq, lds, wid, lane); S.done(cur); }
#undef PG8_SA
#undef PG8_SB
#undef PG8_STAGE
#undef PG8_LDA
#undef PG8_LDB
#undef PG8_MMA
#undef PG8_WAIT_V
#undef PG8_WAIT_L
#undef PG8_BAR
#undef PG8_SCHED
}
}

#ifndef PG8_SP2
#define PG8_SP2 true
#endif
#ifndef PG8_ALIGN
#define PG8_ALIGN true
#endif
#include <hip/hip_bf16.h>
#include <cmath>
namespace attn_body {
using bf16=__hip_bfloat16;
using bf16x8=__attribute__((ext_vector_type(8)))short;
using s16x4=__attribute__((ext_vector_type(4)))short;
using f32x16=__attribute__((ext_vector_type(16)))float;
using u32x4=__attribute__((ext_vector_type(4)))unsigned;
using f32x4v=__attribute__((ext_vector_type(4)))float;
constexpr int BATCH=2,NHEAD=8,SEQ=8192,D=64,DM=NHEAD*D;
constexpr int NW=8,QBLK=32,QB=QBLK*NW,KVBLK=64,NQB=SEQ/QB;
constexpr int ATTN_PITCH=DM, ATTN_UNIT_ROWS=QB;
__device__ __forceinline__ int crow(int r,int hi){return (r&3)+8*(r>>2)+4*hi;}
#define SBAR() __builtin_amdgcn_sched_barrier(0)
__device__ __forceinline__ void cmask(f32x16&p0,f32x16&p1,int jb,int qrel,int hi){
  const float NEG=-INFINITY; int kb=64*jb+4*hi;
  #pragma unroll
  for(int r=0;r<16;++r){int kv=kb+(r&3)+8*(r>>2); if(kv>qrel)p0[r]=NEG; if(kv+32>qrel)p1[r]=NEG;}
}

constexpr int NSLOT=3, SLOTB=8192;
constexpr int LDS_K=0, LDS_V=NSLOT*SLOTB, LDS_WS=2*NSLOT*SLOTB, LDS_OST=LDS_WS+NW*64*4, LDS_BIAS=LDS_OST+NW*4096, LDS_WT=LDS_BIAS+SEQ*4, LDS_BYTES=LDS_WT+64;
constexpr float C2=0.125f*1.4426950408889634f;
__device__ __forceinline__ void glds16(const void*gsrc,unsigned lds_dst){unsigned keep;
  asm volatile("s_mov_b32 %0, m0\n\ts_mov_b32 m0, %2\n\ts_nop 0\n\tglobal_load_lds_dwordx4 %1, off\n\ts_mov_b32 m0, %0":"=&s"(keep):"v"(gsrc),"s"(lds_dst):"memory");}
__device__ __forceinline__ float max3f(float a,float b,float c){float r;asm("v_max3_f32 %0, %1, %2, %3":"=v"(r):"v"(a),"v"(b),"v"(c));return r;}
__device__ __forceinline__ float max2f(float a,float b){float r;asm("v_max_f32_e32 %0, %1, %2":"=v"(r):"v"(a),"v"(b));return r;}
__device__ __forceinline__ float fadd_s(float a,float b){float r;asm("v_add_f32_e32 %0, %1, %2":"=v"(r):"v"(a),"v"(b));return r;}
__device__ __forceinline__ float fsub_s(float a,float b){float r;asm("v_sub_f32_e32 %0, %1, %2":"=v"(r):"v"(a),"v"(b));return r;}
typedef float f32x2_t __attribute__((ext_vector_type(2))); typedef __bf16 bf16x2_t __attribute__((ext_vector_type(2)));
__device__ __forceinline__ unsigned cvtpk_s(float lo,float hi){f32x2_t v={lo,hi};bf16x2_t b=__builtin_convertvector(v,bf16x2_t);return __builtin_bit_cast(unsigned,b);}
#define WAIT_BAR(N) asm volatile("s_waitcnt vmcnt(" #N ") lgkmcnt(0)\n\ts_barrier":::"memory")

__device__ __forceinline__ void qkt(f32x16&p0,f32x16&p1,const char*Kslot,const bf16x8*qr,int r32,int hi){
  const char*kb=Kslot+hi*1024+r32*16;
  #pragma unroll
  for(int d0=0;d0<4;++d0){
    const bf16x8 b0=*reinterpret_cast<const bf16x8*>(kb+d0*2048);
    const bf16x8 b1=*reinterpret_cast<const bf16x8*>(kb+d0*2048+512);
    p0=__builtin_amdgcn_mfma_f32_32x32x16_bf16(b0,qr[d0],p0,0,0,0);p1=__builtin_amdgcn_mfma_f32_32x32x16_bf16(b1,qr[d0],p1,0,0,0);}
}
typedef __attribute__((address_space(3))) const char* lds_cptr;
typedef short v4i16_t __attribute__((ext_vector_type(4)));
__device__ __forceinline__ void kload8(bf16x8*kf,lds_cptr kp){
  kf[0]=*(const __attribute__((address_space(3))) bf16x8*)(kp);      kf[1]=*(const __attribute__((address_space(3))) bf16x8*)(kp+512);
  kf[2]=*(const __attribute__((address_space(3))) bf16x8*)(kp+2048); kf[3]=*(const __attribute__((address_space(3))) bf16x8*)(kp+2560);
  kf[4]=*(const __attribute__((address_space(3))) bf16x8*)(kp+4096); kf[5]=*(const __attribute__((address_space(3))) bf16x8*)(kp+4608);
  kf[6]=*(const __attribute__((address_space(3))) bf16x8*)(kp+6144); kf[7]=*(const __attribute__((address_space(3))) bf16x8*)(kp+6656);
}
__device__ __forceinline__ void kload2(bf16x8*kf,lds_cptr kp,int j){ kf[2*j]=*(const __attribute__((address_space(3))) bf16x8*)(kp+j*2048); kf[2*j+1]=*(const __attribute__((address_space(3))) bf16x8*)(kp+j*2048+512); }
__device__ __forceinline__ s16x4 vtr(lds_cptr p){ return __builtin_bit_cast(s16x4,__builtin_amdgcn_ds_read_tr16_b64_v4i16((__attribute__((address_space(3))) v4i16_t*)p)); }
__device__ __forceinline__ float rowmax(const f32x16&p0,const f32x16&p1){
  float a=max3f(p0[0],p0[1],p1[0]),b=max3f(p0[2],p0[3],p1[1]);a=max3f(a,p1[2],p1[3]);
  #pragma unroll
  for(int r=4;r<16;r+=4){a=max3f(a,p0[r],p0[r+1]);b=max3f(b,p0[r+2],p0[r+3]);a=max3f(a,p1[r],p1[r+1]);b=max3f(b,p1[r+2],p1[r+3]);}
  const float m=max2f(a,b);
  auto rr=__builtin_amdgcn_permlane32_swap(__float_as_uint(m),__float_as_uint(m),false,false);
  return max2f(__uint_as_float(rr[0]),__uint_as_float(rr[1]));
}
__device__ __forceinline__ void pv(f32x16*o,int vb,bf16x8 pa0,bf16x8 pa1,bf16x8 pa2,bf16x8 pa3){
  #pragma unroll
  for(int d0=0;d0<2;++d0){s16x4 lo[4],hi[4];
    #pragma unroll
    for(int ks=0;ks<4;++ks){
      asm volatile("ds_read_b64_tr_b16 %0,%1 offset:%c2":"=&v"(lo[ks]):"v"(vb),"i"(d0*4096+ks*1024):"memory");
      asm volatile("ds_read_b64_tr_b16 %0,%1 offset:%c2":"=&v"(hi[ks]):"v"(vb),"i"(d0*4096+ks*1024+512):"memory");}
    asm volatile("s_waitcnt lgkmcnt(0)":::"memory");SBAR();
    #define PK(k) (bf16x8){lo[k][0],lo[k][1],lo[k][2],lo[k][3],hi[k][0],hi[k][1],hi[k][2],hi[k][3]}
    o[d0]=__builtin_amdgcn_mfma_f32_32x32x16_bf16(pa0,PK(0),o[d0],0,0,0);
    o[d0]=__builtin_amdgcn_mfma_f32_32x32x16_bf16(pa1,PK(1),o[d0],0,0,0);
    o[d0]=__builtin_amdgcn_mfma_f32_32x32x16_bf16(pa2,PK(2),o[d0],0,0,0);
    o[d0]=__builtin_amdgcn_mfma_f32_32x32x16_bf16(pa3,PK(3),o[d0],0,0,0);
    #undef PK
  }
}

#ifndef ATTN_STORE16
#define ATTN_STORE16(p,v) (*(u32x4*)(p)=(v))
#endif
template<int THRL> __device__ __forceinline__ void attn_unit(int b,int h,int qb,int tb_in,int te,int mode,float*__restrict__ part,unsigned*pcnt,const unsigned*kmaxp,const bf16*Q,const bf16*__restrict__ K,const bf16*__restrict__ V,bf16*O,const float*__restrict__ logf,float*__restrict__ ssqA,char*shm,int tid_in){
  int tid_=tid_in; asm volatile("":"+v"(tid_)); const int tid=tid_,lane=tid&63,r32=lane&31,hi=lane>>5; const int wid=__builtin_amdgcn_readfirstlane(tid>>6);
  const long rowbase=(long)b*SEQ; const int q0=qb*QB;
  const bf16*Qw=Q+(rowbase+q0+wid*QBLK)*DM+h*D;
  const lds_cptr shm3=(lds_cptr)shm;
  typedef __attribute__((address_space(3))) float* lds_fptr; typedef __attribute__((address_space(3))) f32x4v* lds_f4ptr;
  const lds_fptr biasL=(lds_fptr)(shm3+LDS_BIAS); const lds_fptr wtot=(lds_fptr)(shm3+LDS_WT);
  bf16x8 qr[4];
  #pragma unroll
  for(int d0=0;d0<4;++d0)qr[d0]=*reinterpret_cast<const bf16x8*>(&Qw[(long)r32*DM+d0*16+hi*8]);
  float qn=0.f;
  #pragma unroll
  for(int d0=0;d0<4;++d0){
    #pragma unroll
    for(int e=0;e<8;++e){const float qv=__uint_as_float(((unsigned)(unsigned short)qr[d0][e])<<16);qn+=qv*qv;}}
  qn=sum32(qn);
  qn=__builtin_fmaxf(qn,sx<1>(qn));qn=__builtin_fmaxf(qn,sx<2>(qn));qn=__builtin_fmaxf(qn,sx<4>(qn));qn=__builtin_fmaxf(qn,sx<8>(qn));qn=__builtin_fmaxf(qn,sx<16>(qn));
  { const int nkeys=q0+QB; const int k0=tid*16; const float*lf=logf+(long)(b*NHEAD+h)*SEQ+k0;
    f32x4v v0={0.f,0.f,0.f,0.f},v1=v0,v2=v0,v3=v0;
    if(k0<nkeys){v0=*(const f32x4v*)(lf);v1=*(const f32x4v*)(lf+4);v2=*(const f32x4v*)(lf+8);v3=*(const f32x4v*)(lf+12);}
    const float tot=((v0[0]+v0[1])+(v0[2]+v0[3]))+((v1[0]+v1[1])+(v1[2]+v1[3]))+((v2[0]+v2[1])+(v2[2]+v2[3]))+((v3[0]+v3[1])+(v3[2]+v3[3]));
    float x=tot;
    #pragma unroll
    for(int off=1;off<64;off<<=1){const float y=__builtin_bit_cast(float,__builtin_amdgcn_ds_bpermute(((lane+off)&63)<<2,__builtin_bit_cast(int,x)));if(lane+off<64)x+=y;}
    if(lane==0){wtot[wid]=x;wtot[8+wid]=qn;}
    __syncthreads();
    float wsum=0.f;
    #pragma unroll
    for(int w=1;w<NW;++w){const float t_=wtot[w];if(w>wid)wsum+=t_;}
    float run=(x-tot)+wsum;
    if(k0<nkeys){ const float L2E=1.4426950408889634f; f32x4v o0,o1,o2,o3;
      o3[3]=run*L2E;run+=v3[3];o3[2]=run*L2E;run+=v3[2];o3[1]=run*L2E;run+=v3[1];o3[0]=run*L2E;run+=v3[0];
      o2[3]=run*L2E;run+=v2[3];o2[2]=run*L2E;run+=v2[2];o2[1]=run*L2E;run+=v2[1];o2[0]=run*L2E;run+=v2[0];
      o1[3]=run*L2E;run+=v1[3];o1[2]=run*L2E;run+=v1[2];o1[1]=run*L2E;run+=v1[1];o1[0]=run*L2E;run+=v1[0];
      o0[3]=run*L2E;run+=v0[3];o0[2]=run*L2E;run+=v0[2];o0[1]=run*L2E;run+=v0[1];o0[0]=run*L2E;
      lds_f4ptr bo=(lds_f4ptr)(biasL+k0); bo[0]=o0;bo[1]=o1;bo[2]=o2;bo[3]=o3; }
    __syncthreads(); }
  int tb=tb_in; bool emptyA=false;
  { float qmx=wtot[8];
    #pragma unroll
    for(int w=1;w<NW;++w)qmx=__builtin_fmaxf(qmx,wtot[8+w]);
    const float kmx=__uint_as_float(__hip_atomic_load(kmaxp,__ATOMIC_RELAXED,__HIP_MEMORY_SCOPE_AGENT))+__uint_as_float(__hip_atomic_load(kmaxp+1,__ATOMIC_RELAXED,__HIP_MEMORY_SCOPE_AGENT));
    const float Bq=__builtin_sqrtf(qmx*kmx)*1.02f;   const float thr=biasL[q0]-150.f-2.f*Bq;
    const int ntf=(q0+QB)/KVBLK; const int skipf=(tid<ntf)?(biasL[KVBLK*tid+KVBLK-1]<thr?1:0):0;
    const unsigned long long bal=__ballot(skipf);
    __syncthreads();
    if(lane==0&&wid<2)wtot[wid]=(float)__popcll(bal);
    __syncthreads();
    int t0=((int)wtot[0]+(int)wtot[1])&~1; emptyA=(mode==1&&t0>=te); if(t0>te-4)t0=te-4; if(t0>tb)tb=t0;
    __syncthreads(); }
  if(!emptyA){
  const bf16*Kh=K+(rowbase+(long)tb*KVBLK)*DM+h*D,*Vh=V+(rowbase+(long)tb*KVBLK)*DM+h*D;
  const unsigned lds0=(unsigned)(uintptr_t)shm;
  float*wsf=(float*)(shm+LDS_WS)+wid*64;
  const bf16*ksrc=Kh+(long)lane*DM+wid*8;
  const bf16*vsrc=Vh+(long)(16*(wid&3)+(lane>>2))*DM+(wid>>2)*32+(lane&3)*8;
  const unsigned kdst=lds0+LDS_K+wid*1024, vdst=lds0+LDS_V+wid*1024;
  #define DMA_K(t,slot) glds16(ksrc+(long)(t)*KVBLK*DM,(unsigned)__builtin_amdgcn_readfirstlane(kdst+(slot)))
  #define DMA_V(t,slot) glds16(vsrc+(long)(t)*KVBLK*DM,(unsigned)__builtin_amdgcn_readfirstlane(vdst+(slot)))
  const int vb0=(int)(lds0+LDS_V)+((lane>>4)&1)*32+(lane&3)*8+(4*hi+((lane&15)>>2))*64;
  const char*Kbase=shm+LDS_K; bf16x8 kf[8];
  const lds_cptr kp0=shm3+LDS_K+hi*1024+r32*16; const lds_cptr vp0=shm3+LDS_V+((lane>>4)&1)*32+(lane&3)*8+(4*hi+((lane&15)>>2))*64;
  const int NT=te-tb;
  const lds_fptr biasp=biasL+4*hi+tb*KVBLK;
  #define BLD(X0,X1,tt) do{ const lds_fptr bp_=biasp+(tt)*KVBLK; \
    _Pragma("unroll") for(int j_=0;j_<4;++j_){ const f32x4v a_=*(const lds_f4ptr)(bp_+8*j_); const f32x4v b_=*(const lds_f4ptr)(bp_+32+8*j_); \
      X0[4*j_]=a_[0];X0[4*j_+1]=a_[1];X0[4*j_+2]=a_[2];X0[4*j_+3]=a_[3]; X1[4*j_]=b_[0];X1[4*j_+1]=b_[1];X1[4*j_+2]=b_[2];X1[4*j_+3]=b_[3]; } }while(0)
  #define BSUB(X,B) do{ const f32x2_t mh2_={mhat,mhat}; _Pragma("unroll") for(int r_=(B);r_<(B)+8;r_+=2){ f32x2_t t_={X[r_],X[r_+1]}; t_=t_-mh2_; X[r_]=t_.x; X[r_+1]=t_.y; } }while(0)
  DMA_K(0,0);DMA_V(0,0);DMA_K(1,SLOTB);
  float mhat=0.f,l_reg=0.f;f32x16 o[2];o[0]=f32x16{};o[1]=f32x16{};
  const int qrel=wid*QBLK+r32;
  #define CMASK(P0,P1,t) do{int jb_=(t)-(NT-4); if(jb_>=0&&mode!=1)cmask(P0,P1,jb_,qrel,hi);}while(0)
  bool resc=false;
  #define START(P0,P1) do{ const float rm=rowmax(P0,P1); resc=false; \
    { const float dl=rm; mhat=fadd_s(mhat,dl); \
      _Pragma("unroll") for(int r=0;r<16;++r){P0[r]=fsub_s(P0[r],dl);P1[r]=fsub_s(P1[r],dl);} } \
    _Pragma("unroll") for(int r=0;r<16;++r)P0[r]=__builtin_amdgcn_exp2f(P0[r]); }while(0)
  #define RESC() do{ if(resc){ asm volatile("s_waitcnt lgkmcnt(0)":::"memory"); \
      _Pragma("unroll") for(int d_=0;d_<2;++d_) _Pragma("unroll") for(int r=0;r<16;++r)o[d_][r]*=wsf[crow(r,hi)]; } }while(0)
  f32x16 pA0,pA1,pB0,pB1;
  int sl_prev=0,sl_cur=0,sl_next=SLOTB;
  #define ROT() do{sl_prev=sl_cur;sl_cur=sl_next;sl_next=(sl_next==(NSLOT-1)*SLOTB)?0:sl_next+SLOTB;}while(0)
  DMA_K(2,2*SLOTB);
  WAIT_BAR(3);
  BLD(pA0,pA1,0);
  qkt(pA0,pA1,Kbase,qr,r32,hi);asm volatile("s_nop 15\n\ts_nop 7":"+v"(pA0),"+v"(pA1));CMASK(pA0,pA1,0);
  START(pA0,pA1);
  _Pragma("unroll") for(int r=0;r<16;++r)pA1[r]=__builtin_amdgcn_exp2f(pA1[r]);
  BLD(pB0,pB1,1); BSUB(pB0,0); BSUB(pB0,8); BSUB(pB1,0); BSUB(pB1,8);
  WAIT_BAR(0);
  DMA_K(3,0);DMA_V(1,SLOTB);
  ROT();
  kload8(kf,kp0+sl_cur);
  WAIT_BAR(2);
  s16x4 vlo[8],vhi[8]; u32x4 pw0,pw1,pw2,pw3;
  #define PKW(P,B) cvtpk_s(P[B],P[B+1])
  #define PAF(k) __builtin_bit_cast(bf16x8,pw##k)
  #define VFR(i) (bf16x8){vlo[i][0],vlo[i][1],vlo[i][2],vlo[i][3],vhi[i][0],vhi[i][1],vhi[i][2],vhi[i][3]}
  #define PIN(x) asm volatile("":"+v"(x))
  #define MX3(a,b,c) __builtin_fmaxf(__builtin_fmaxf((a),(b)),(c))
  #define GAPA(MF,A0,A1,A2,A3,W0,W1,PW) do{ MF; sacc+=A0; sacc+=A1; sacc+=A2; sacc+=A3; PIN(sacc); W0; W1; PIN(PW); SBAR(); }while(0)
  #define EX(v) __builtin_amdgcn_exp2f(v)
  #define GAPB(MF,X,B) do{ MF; X[B]=EX(X[B]); X[B+1]=EX(X[B+1]); X[B+2]=EX(X[B+2]); X[B+3]=EX(X[B+3]); PIN(X); SBAR(); }while(0)
  #define VRD(i) do{ vlo[i]=vtr(vp_+(((i)>>2)*4096+((i)&3)*1024)); vhi[i]=vtr(vp_+(((i)>>2)*4096+((i)&3)*1024+512)); }while(0)
  #define KRD(G,j) do{ if(G){ kload2(kf,kp0+sl_next,j); SBAR(); } }while(0)
  #define STEP(C0,C1,P0,P1,t,GK,GV,GL) do{ SBAR(); \
    const lds_cptr vp_=vp0+sl_prev; \
    VRD(0); SBAR(); float sacc=(P0[0]+P0[1]); \
    GAPA(C0=__builtin_amdgcn_mfma_f32_32x32x16_bf16(kf[0],qr[0],C0,0,0,0), P0[2],P0[3],P0[4],P0[5],     pw0[0]=PKW(P0,0), pw0[1]=PKW(P0,2), pw0); \
    VRD(4); SBAR(); GAPA(C1=__builtin_amdgcn_mfma_f32_32x32x16_bf16(kf[1],qr[0],C1,0,0,0), P0[6],P0[7],P0[8],P0[9],     pw0[2]=PKW(P0,4), pw0[3]=PKW(P0,6), pw0); \
    VRD(1); SBAR(); GAPA(C0=__builtin_amdgcn_mfma_f32_32x32x16_bf16(kf[2],qr[1],C0,0,0,0),   P0[10],P0[11],P0[12],P0[13], pw1[0]=PKW(P0,8), pw1[1]=PKW(P0,10), pw1); \
    VRD(5); SBAR(); GAPA(C1=__builtin_amdgcn_mfma_f32_32x32x16_bf16(kf[3],qr[1],C1,0,0,0),   P0[14],P0[15],P1[0],P1[1],   pw1[2]=PKW(P0,12),pw1[3]=PKW(P0,14), pw1); \
    VRD(2); SBAR(); GAPA(C0=__builtin_amdgcn_mfma_f32_32x32x16_bf16(kf[4],qr[2],C0,0,0,0),   P1[2],P1[3],P1[4],P1[5],     pw2[0]=PKW(P1,0), pw2[1]=PKW(P1,2), pw2); \
    VRD(6); SBAR(); GAPA(C1=__builtin_amdgcn_mfma_f32_32x32x16_bf16(kf[5],qr[2],C1,0,0,0),   P1[6],P1[7],P1[8],P1[9],     pw2[2]=PKW(P1,4), pw2[3]=PKW(P1,6), pw2); \
    VRD(3); SBAR(); GAPA(C0=__builtin_amdgcn_mfma_f32_32x32x16_bf16(kf[6],qr[3],C0,0,0,0),   P1[10],P1[11],P1[12],P1[13], pw3[0]=PKW(P1,8), pw3[1]=PKW(P1,10), pw3); \
    VRD(7); SBAR(); GAPA(C1=__builtin_amdgcn_mfma_f32_32x32x16_bf16(kf[7],qr[3],C1,0,0,0),   P1[14],P1[15],0.f,0.f,       pw3[2]=PKW(P1,12),pw3[3]=PKW(P1,14), pw3); \
    l_reg+=sacc; \
    if(GK){DMA_K((t)+3,sl_cur);} if(GV){DMA_V((t)+1,sl_next);} \
    CMASK(C0,C1,t); \
    { float a=MX3(C0[0],C0[1],C1[0]),b=MX3(C0[2],C0[3],C1[1]); a=MX3(a,C1[2],C1[3]); \
      _Pragma("unroll") for(int r=4;r<16;r+=4){a=MX3(a,C0[r],C0[r+1]);b=MX3(b,C0[r+2],C0[r+3]);a=MX3(a,C1[r],C1[r+1]);b=MX3(b,C1[r+2],C1[r+3]);} \
      float rm=__builtin_fmaxf(a,b); { auto rr=__builtin_amdgcn_permlane32_swap(__float_as_uint(rm),__float_as_uint(rm),false,false); rm=__builtin_fmaxf(__uint_as_float(rr[0]),__uint_as_float(rr[1])); } \
      resc=false; \
      if(__builtin_expect(__any(rm>(float)THRL),0)){ const float dl=__builtin_fmaxf(rm,0.f); mhat+=dl; \
        _Pragma("unroll") for(int r=0;r<16;++r){C0[r]-=dl;C1[r]-=dl;} \
        const float f=__builtin_amdgcn_exp2f(-dl); l_reg*=f; if(hi==0)wsf[r32]=f; resc=true; } } \
    SBAR(); \
    if(GL){ BLD(P0,P1,(t)+1); SBAR(); } \
    GAPB(o[0]=__builtin_amdgcn_mfma_f32_32x32x16_bf16(PAF(0),VFR(0),o[0],0,0,0), C0,0); \
    GAPB(o[1]=__builtin_amdgcn_mfma_f32_32x32x16_bf16(PAF(0),VFR(4),o[1],0,0,0), C0,4); \
    KRD(GL,0); GAPB(o[0]=__builtin_amdgcn_mfma_f32_32x32x16_bf16(PAF(1),VFR(1),o[0],0,0,0), C0,8); \
    KRD(GL,1); GAPB(o[1]=__builtin_amdgcn_mfma_f32_32x32x16_bf16(PAF(1),VFR(5),o[1],0,0,0), C0,12); \
    KRD(GL,2); if(GL){BSUB(P0,0);} GAPB(o[0]=__builtin_amdgcn_mfma_f32_32x32x16_bf16(PAF(2),VFR(2),o[0],0,0,0), C1,0); \
    KRD(GL,3); if(GL){BSUB(P0,8);} GAPB(o[1]=__builtin_amdgcn_mfma_f32_32x32x16_bf16(PAF(2),VFR(6),o[1],0,0,0), C1,4); \
    if(GL){BSUB(P1,0);} GAPB(o[0]=__builtin_amdgcn_mfma_f32_32x32x16_bf16(PAF(3),VFR(3),o[0],0,0,0), C1,8); \
    if(GL){BSUB(P1,8);} GAPB(o[1]=__builtin_amdgcn_mfma_f32_32x32x16_bf16(PAF(3),VFR(7),o[1],0,0,0), C1,12); \
    }while(0)
  int t=1;
  #undef CMASK
  #define CMASK(P0,P1,t) do{}while(0)
  for(;t+5<NT;t+=2){
    STEP(pB0,pB1,pA0,pA1,t,true,true,true);     WAIT_BAR(2); RESC(); ROT();
    STEP(pA0,pA1,pB0,pB1,t+1,true,true,true);   WAIT_BAR(2); RESC(); ROT();
  }
  #undef CMASK
  #define CMASK(P0,P1,t) do{int jb_=(t)-(NT-4); if(jb_>=0&&mode!=1)cmask(P0,P1,jb_,qrel,hi);}while(0)
  #define ENDW(tt) do{ if((tt)+3<NT){WAIT_BAR(2);} else if((tt)+2<NT){WAIT_BAR(1);} else {WAIT_BAR(0);} }while(0)
  for(;t+1<NT;t+=2){
    STEP(pB0,pB1,pA0,pA1,t,(t+3<NT),(t+1<NT),(t+1<NT));       ENDW(t);   RESC(); ROT();
    STEP(pA0,pA1,pB0,pB1,t+1,(t+4<NT),(t+2<NT),(t+2<NT));     ENDW(t+1); RESC(); ROT();
  }
  STEP(pB0,pB1,pA0,pA1,NT-1,false,false,false); RESC();
  { float sacc=pB0[0]+pB0[1]; _Pragma("unroll") for(int r=2;r<16;++r)sacc+=pB0[r]; _Pragma("unroll") for(int r=0;r<16;++r)sacc+=pB1[r]; l_reg+=sacc;
    pw0=(u32x4){PKW(pB0,0),PKW(pB0,2),PKW(pB0,4),PKW(pB0,6)};pw1=(u32x4){PKW(pB0,8),PKW(pB0,10),PKW(pB0,12),PKW(pB0,14)};pw2=(u32x4){PKW(pB1,0),PKW(pB1,2),PKW(pB1,4),PKW(pB1,6)};pw3=(u32x4){PKW(pB1,8),PKW(pB1,10),PKW(pB1,12),PKW(pB1,14)};
    SBAR(); pv(o,vb0+sl_cur,PAF(0),PAF(1),PAF(2),PAF(3)); }
  #undef PKW
  #undef PAF
  #undef VFR
  #undef PIN
  #undef MX3
  #undef GAPA
  #undef GAPB
  #undef EX
  #undef VRD
  #undef KRD
  #undef STEP
  #undef ENDW
  {auto rr=__builtin_amdgcn_permlane32_swap(__float_as_uint(l_reg),__float_as_uint(l_reg),false,false);l_reg=__uint_as_float(rr[0])+__uint_as_float(rr[1]);}
  if(mode==0){
  if(hi==0)wsf[32+r32]=l_reg;asm volatile("s_waitcnt lgkmcnt(0)":::"memory");
  float rli[16];
  #pragma unroll
  for(int r=0;r<16;++r)rli[r]=__builtin_amdgcn_rcpf(wsf[32+crow(r,hi)]);
  bf16*Ow=O+(rowbase+q0+wid*QBLK)*DM+h*D;
  { bf16*stg=(bf16*)(shm+LDS_OST)+wid*2048;
    #pragma unroll
    for(int r=0;r<16;++r){const int orow=crow(r,hi);
      #pragma unroll
      for(int d0=0;d0<2;++d0)stg[orow*64+d0*32+r32]=__float2bfloat16(o[d0][r]*rli[r]);}
    asm volatile("s_waitcnt lgkmcnt(0)":::"memory");
    #pragma unroll
    for(int i=0;i<4;++i){const int row=i*8+(lane>>3),ch=lane&7; const u32x4 v=*(const u32x4*)(stg+row*64+ch*8); ATTN_STORE16(Ow+(long)row*DM+ch*8,v);
      float ss=0.f;
      #pragma unroll
      for(int e=0;e<4;++e){const float lo_=__uint_as_float(v[e]<<16),hi_=__uint_as_float(v[e]&0xffff0000u);ss+=lo_*lo_+hi_*hi_;}
      ss+=sx<1>(ss);ss+=sx<2>(ss);ss+=sx<4>(ss);
      if(ch==0)ssqA[(rowbase+q0+wid*QBLK+row)*NHEAD+h]=ss;} }
  } else {
    float*PO=part+(long)(mode-1)*QB*D+(long)(wid*QBLK)*D;
    #pragma unroll
    for(int r=0;r<16;++r){const int orow=crow(r,hi);
      #pragma unroll
      for(int d0=0;d0<2;++d0)__hip_atomic_store(PO+orow*D+d0*32+r32,o[d0][r],__ATOMIC_RELAXED,__HIP_MEMORY_SCOPE_AGENT);}
    if(hi==0){ float*PM=part+2*QB*D+(mode-1)*QB+wid*QBLK; __hip_atomic_store(PM+r32,mhat,__ATOMIC_RELAXED,__HIP_MEMORY_SCOPE_AGENT); __hip_atomic_store(PM+2*QB+r32,l_reg,__ATOMIC_RELAXED,__HIP_MEMORY_SCOPE_AGENT); }
  }
  asm volatile("s_waitcnt lgkmcnt(0)\n\ts_barrier":::"memory");
  } else if(tid<QB){ float*PM=part+2*QB*D; __hip_atomic_store(PM+tid,-1e30f,__ATOMIC_RELAXED,__HIP_MEMORY_SCOPE_AGENT); __hip_atomic_store(PM+2*QB+tid,0.f,__ATOMIC_RELAXED,__HIP_MEMORY_SCOPE_AGENT); }
  if(mode!=0){
    asm volatile("s_waitcnt vmcnt(0)":::"memory"); __syncthreads();
    if(tid==0){
      const unsigned old=__hip_atomic_fetch_add(pcnt,1u,__ATOMIC_RELAXED,__HIP_MEMORY_SCOPE_AGENT);
      if(old==1u){ __builtin_amdgcn_fence(__ATOMIC_ACQUIRE,"agent"); asm volatile("s_waitcnt vmcnt(0)":::"memory"); }
      wtot[0]=(old==1u)?1.f:0.f; }
    __syncthreads();
    const bool merger=wtot[0]!=0.f;
    __syncthreads();
    if(merger){ const int row=tid>>1,ch=tid&1; const float*PA=part+(long)row*D+ch*32,*PB=PA+(long)QB*D; const float*PM=part+2*QB*D;
      const float MA=PM[row],MB=PM[QB+row],LA=PM[2*QB+row],LB=PM[3*QB+row]; const float m=__builtin_fmaxf(MA,MB);
      const bool ua=LA>0.f,ub=LB>0.f; const float wA=ua?__builtin_amdgcn_exp2f(MA-m):0.f,wB=ub?__builtin_amdgcn_exp2f(MB-m):0.f; const float inv=__builtin_amdgcn_rcpf(LA*wA+LB*wB); const float cA=wA*inv,cB=wB*inv;
      bf16*Om=O+(rowbase+q0+row)*DM+h*D+ch*32; float ss=0.f;
      #pragma unroll
      for(int i=0;i<4;++i){ const f32x4v z4={0.f,0.f,0.f,0.f}; const f32x4v a0=ua?*(const f32x4v*)(PA+8*i):z4,a1=ua?*(const f32x4v*)(PA+8*i+4):z4,b0=ub?*(const f32x4v*)(PB+8*i):z4,b1=ub?*(const f32x4v*)(PB+8*i+4):z4;
        u32x4 w; w[0]=cvtpk_s(a0[0]*cA+b0[0]*cB,a0[1]*cA+b0[1]*cB); w[1]=cvtpk_s(a0[2]*cA+b0[2]*cB,a0[3]*cA+b0[3]*cB); w[2]=cvtpk_s(a1[0]*cA+b1[0]*cB,a1[1]*cA+b1[1]*cB); w[3]=cvtpk_s(a1[2]*cA+b1[2]*cB,a1[3]*cA+b1[3]*cB);
        ATTN_STORE16(Om+8*i,w);
        #pragma unroll
        for(int e=0;e<4;++e){const float lo_=__uint_as_float(w[e]<<16),hi_=__uint_as_float(w[e]&0xffff0000u);ss+=lo_*lo_+hi_*hi_;} }
      ss+=sx<1>(ss);
      if(ch==0)ssqA[(rowbase+q0+row)*NHEAD+h]=ss; }
  }
  #undef DMA_K
  #undef DMA_V
  #undef BLD
  #undef BSUB
  #undef CMASK
  #undef START
  #undef RESC
  #undef ROT
}
constexpr int ATTN_LDS_BYTES=LDS_BYTES;
#undef SBAR
#undef WAIT_BAR
}
#define LAS __attribute__((address_space(3)))
#define GAS __attribute__((address_space(1)))
using pg8::f32x4; using pg8::u32x4; using pg8::bf16_t; using pg8::bf16x8; using pg8::Unit; using pg8::BM; using pg8::HALF;
typedef unsigned u32x2 __attribute__((ext_vector_type(2)));
constexpr int TOK = 16384, DMODEL = 1024, DFF = 2816, HW = 512, SEQL = 8192, PLE = 256, NGRP = 32;
constexpr float L2E = 1.4426950408889634f;
constexpr float QSCALE = 0.125f * L2E;
constexpr size_t MiB = 1u << 20;
constexpr size_t WS_CTL = 0, WS_AP = 1 * MiB, WS_BB = WS_AP + 512 * 1024, WS_KTAB = 2 * MiB, WS_PEND = 3 * MiB, WS_CC = 5 * MiB, WS_WF = 7 * MiB, WS_LOGF = 8 * MiB;
constexpr size_t WS_SSQ0 = 9 * MiB, WS_SSQ1 = 10 * MiB, WS_SSQ2 = 11 * MiB, WS_SSQ3 = 12 * MiB, WS_SSQ4 = 13 * MiB, WS_SSQA = 14 * MiB, WS_SSQS = 14 * MiB + 512 * 1024;
constexpr size_t WS_W13A = 16 * MiB, WS_W2A = 27 * MiB, WS_WIN = 33 * MiB, WS_WGLU = 37 * MiB, WS_WOA = 38 * MiB, WS_WOS = 39 * MiB, WS_W13B = 40 * MiB, WS_W2B = 51 * MiB, WS_WG = 57 * MiB, WS_WP = 59 * MiB;
constexpr size_t PARTF = 2 * 256 * 64 + 4 * 256;
static_assert(60 * PARTF * 4 <= 8 * MiB && 45 * PARTF * 4 <= 6 * MiB && 151 * PARTF * 4 <= 20 * MiB, "partial record chunks");
constexpr size_t WS_PART_UNUSED = 188 * MiB;
constexpr size_t WS_PB = 60 * MiB, WS_XB = 68 * MiB, WS_H1 = 100 * MiB;
constexpr size_t WS_Q = 100 * MiB, WS_K = 116 * MiB, WS_V = 132 * MiB, WS_U = 148 * MiB, WS_Y = 164 * MiB, WS_SSMO = 188 * MiB, WS_PP = 204 * MiB, WS_END = 256 * MiB;
static_assert(WS_K == WS_Q + 16 * MiB && WS_V == WS_Q + 32 * MiB, "EpiQKVU pointer arithmetic");
constexpr int RING_BYTES = 131072, LDS_BYTES = 147456, MISC_OFF = LDS_BYTES - 256;

__device__ __forceinline__ float sigm(float w) { return __builtin_amdgcn_rcpf(1.f + __builtin_amdgcn_exp2f(-L2E * w)); }
__device__ __forceinline__ unsigned pkbf(float lo, float hi) { return pg8::cvt_pk_bf16(lo, hi); }
__device__ __forceinline__ float bflo(unsigned w) { return __uint_as_float(w << 16); }
__device__ __forceinline__ float bfhi(unsigned w) { return __uint_as_float(w & 0xffff0000u); }
template <int NP> __device__ __forceinline__ float rstd_row(const float* ssq, int row, float invn) {
    const f32x4* p = (const f32x4*)(ssq + (size_t)row * NP); float s = 0.f;
#pragma unroll
    for (int i = 0; i < NP / 4; ++i) { const f32x4 v = p[i]; s += (v[0] + v[1]) + (v[2] + v[3]); }
    return __builtin_amdgcn_rsqf(s * invn + 1e-6f);
}
template <int NP> __device__ __forceinline__ void rstd8(const float* ssq, int pm, int wr, int fr, int fq, float invn, float (&rs)[2][4]) {
    int lrow = pm * BM + wr * 64 + fq * 16 + fr; asm volatile("" : "+v"(lrow));
    const float r0 = rstd_row<NP>(ssq, lrow, invn), r1 = rstd_row<NP>(ssq, lrow + HALF, invn);
#pragma unroll
    for (int m = 0; m < 4; ++m) { rs[0][m] = __builtin_bit_cast(float, __builtin_amdgcn_ds_bpermute((16 * m + fr) << 2, __builtin_bit_cast(int, r0))); rs[1][m] = __builtin_bit_cast(float, __builtin_amdgcn_ds_bpermute((16 * m + fr) << 2, __builtin_bit_cast(int, r1))); }
}
__device__ __forceinline__ float wave_sum(float v) {
    v += sx<1>(v); v += sx<2>(v); v += sx<4>(v); v += sx<8>(v); v += sx<16>(v); v = sum32(v);
    return v;
}

template <int NP> struct EpiSwiglu {
    static constexpr bool PERM = true, AFTER_DRAIN = false, MIDK = false;
    bf16_t* O; const float* ssq;
    __device__ __forceinline__ void operator()(const f32x4 (&acc)[2][2][4][2], const Unit& u, int wr, int wc, int fr, int fq) const {
        int row0 = u.pm * BM + wr * 64 + fr, col0 = u.pn * 128 + wc * 32 + 8 * fq; asm volatile("" : "+v"(row0));
        float rs8[2][4]; rstd8<NP>(ssq, u.pm, wr, fr, fq, 1.f / 1024.f, rs8);
#pragma unroll
        for (int ai = 0; ai < 2; ++ai)
#pragma unroll
            for (int m = 0; m < 4; ++m) { asm volatile("" ::: "memory"); const int row = row0 + ai * HALF + m * 16; const float rs = rs8[ai][m];
                const f32x4 a0 = acc[ai][0][m][0] * rs, a1 = acc[ai][0][m][1] * rs, b0 = acc[ai][1][m][0] * rs, b1 = acc[ai][1][m][1] * rs; f32x4 h0, h1;
#pragma unroll
                for (int e = 0; e < 4; ++e) { h0[e] = a0[e] * sigm(a0[e]) * b0[e]; h1[e] = a1[e] * sigm(a1[e]) * b1[e]; }
                u32x4 w; w.x = pkbf(h0[0], h0[1]); w.y = pkbf(h0[2], h0[3]); w.z = pkbf(h1[0], h1[1]); w.w = pkbf(h1[2], h1[3]);
                *(u32x4*)(O + (size_t)row * DFF + col0) = w; }
    }
};
template <bool NORM, bool BASEB> struct EpiRes {
    static constexpr bool PERM = true, AFTER_DRAIN = false, MIDK = false;
    const float* basef; bf16_t* xb; float* ssqo; const float* ssqi; float coef;
    __device__ __forceinline__ void operator()(const f32x4 (&acc)[2][2][4][2], const Unit& u, int wr, int wc, int fr, int fq) const {
        int row0 = u.pm * BM + wr * 64 + fr, col0 = u.pn * BM + wc * 32 + 8 * fq; asm volatile("" : "+v"(row0));
        float rs8[2][4]; if (NORM) rstd8<8>(ssqi, u.pm, wr, fr, fq, 1.f / 512.f, rs8);
#pragma unroll
        for (int ai = 0; ai < 2; ++ai) { asm volatile("" ::: "memory");
            f32x4 xv[4][2][2];
#pragma unroll
            for (int m = 0; m < 4; ++m)
#pragma unroll
                for (int bj = 0; bj < 2; ++bj) { const size_t off = (size_t)(row0 + ai * HALF + m * 16) * DMODEL + col0 + bj * HALF;
                    if (BASEB) { const u32x4 bv = *(const u32x4*)(xb + off); xv[m][bj][0] = (f32x4){bflo(bv.x), bfhi(bv.x), bflo(bv.y), bfhi(bv.y)}; xv[m][bj][1] = (f32x4){bflo(bv.z), bfhi(bv.z), bflo(bv.w), bfhi(bv.w)}; }
                    else { xv[m][bj][0] = __builtin_nontemporal_load((const f32x4*)(basef + off)); xv[m][bj][1] = __builtin_nontemporal_load((const f32x4*)(basef + off + 4)); } }
#pragma unroll
            for (int m = 0; m < 4; ++m) { const int row = row0 + ai * HALF + m * 16; float alpha = coef; if (NORM) alpha *= rs8[ai][m]; float ss = 0.f;
#pragma unroll
                for (int bj = 0; bj < 2; ++bj) { const size_t off = (size_t)row * DMODEL + col0 + bj * HALF;
                    const f32x4 v0 = xv[m][bj][0] + acc[ai][bj][m][0] * alpha, v1 = xv[m][bj][1] + acc[ai][bj][m][1] * alpha;
                    u32x4 w; w.x = pkbf(v0[0], v0[1]); w.y = pkbf(v0[2], v0[3]); w.z = pkbf(v1[0], v1[1]); w.w = pkbf(v1[2], v1[3]); *(u32x4*)(xb + off) = w;
                    ss += (v0[0] * v0[0] + v0[1] * v0[1]) + (v0[2] * v0[2] + v0[3] * v0[3]) + (v1[0] * v1[0] + v1[1] * v1[1]) + (v1[2] * v1[2] + v1[3] * v1[3]); }
                ss += sx<16>(ss); ss = sum32(ss); if (fq == 0) ssqo[(size_t)row * 16 + u.pn * 4 + wc] = ss; } }
    }
};
struct EpiOut {
    static constexpr bool PERM = true, AFTER_DRAIN = false, MIDK = true;
    bf16_t* xb; float* ssqo; const float* ssqA; const float* ssqS;
    __device__ __forceinline__ void mid(f32x4 (&acc)[2][2][4][2], const Unit& u, int wr, int wc, int fr, int fq) const {
        float ra8[2][4], rb8[2][4]; rstd8<8>(ssqA, u.pm, wr, fr, fq, 1.f / 512.f, ra8); rstd8<8>(ssqS, u.pm, wr, fr, fq, 1.f / 512.f, rb8);
#pragma unroll
        for (int ai = 0; ai < 2; ++ai)
#pragma unroll
            for (int m = 0; m < 4; ++m) { const float ratio = ra8[ai][m] * __builtin_amdgcn_rcpf(rb8[ai][m]);
#pragma unroll
                for (int bj = 0; bj < 2; ++bj) { acc[ai][bj][m][0] *= ratio; acc[ai][bj][m][1] *= ratio; } }
    }
    __device__ __forceinline__ void operator()(const f32x4 (&acc)[2][2][4][2], const Unit& u, int wr, int wc, int fr, int fq) const {
        EpiRes<true, true> E{nullptr, xb, ssqo, ssqS, 1.f}; E(acc, u, wr, wc, fr, fq);
    }
};
struct StrideOrder {
    int first, stride, total, nN;
    __device__ __forceinline__ bool next(int i, Unit& u) const { const int id = first + i * stride; if (id >= total) return false; u.pm = id / nN; u.pn = id % nN; return true; }
    __device__ __forceinline__ void a_ready(const Unit&) const {}
    __device__ __forceinline__ void done(const Unit&) const {}
};
struct EpiQKVU {
    static constexpr bool PERM = true, AFTER_DRAIN = false, MIDK = false;
    bf16_t *Q, *U; const float* ssq; unsigned* kmax;
    __device__ __forceinline__ void operator()(const f32x4 (&acc)[2][2][4][2], const Unit& u, int wr, int wc, int fr, int fq) const {
        int row0 = u.pm * BM + wr * 64 + fr, part = u.pn >> 1, c0 = (u.pn & 1) * 256 + wc * 32 + 8 * fq; asm volatile("" : "+v"(row0));
        bf16_t* dstb = Q + (size_t)part * (size_t)(8 * MiB); const float sc = part == 0 ? QSCALE : 1.f;
        float rs8[2][4]; rstd8<16>(ssq, u.pm, wr, fr, fq, 1.f / 1024.f, rs8); float mxb[2] = {0.f, 0.f};
#pragma unroll
        for (int ai = 0; ai < 2; ++ai)
#pragma unroll
            for (int m = 0; m < 4; ++m) { asm volatile("" ::: "memory"); const int row = row0 + ai * HALF + m * 16; const float rs = rs8[ai][m] * sc;
#pragma unroll
                for (int bj = 0; bj < 2; ++bj) { const int c = c0 + bj * HALF; const f32x4 v0 = acc[ai][bj][m][0] * rs, v1 = acc[ai][bj][m][1] * rs;
                    if (part == 1) { float p2 = ((v0[0] * v0[0] + v0[1] * v0[1]) + (v0[2] * v0[2] + v0[3] * v0[3])) + ((v1[0] * v1[0] + v1[1] * v1[1]) + (v1[2] * v1[2] + v1[3] * v1[3])); p2 += sx<16>(p2); p2 = sum32(p2); mxb[bj] = __builtin_fmaxf(mxb[bj], p2); }
                    u32x4 w; w.x = pkbf(v0[0], v0[1]); w.y = pkbf(v0[2], v0[3]); w.z = pkbf(v1[0], v1[1]); w.w = pkbf(v1[2], v1[3]);
                    if (part < 3) *(u32x4*)(dstb + (size_t)row * HW + c) = w;
                    else { const int g = c >> 4, half = (c >> 3) & 1, b = row >> 13, t = row & 8191; *(u32x4*)(U + ((size_t)((b * NGRP + g) * SEQL + t)) * 16 + half * 8) = w; } } }
        if (part == 1) {
#pragma unroll
            for (int bj = 0; bj < 2; ++bj) { float mx = mxb[bj];
                mx = __builtin_fmaxf(mx, sx<1>(mx)); mx = __builtin_fmaxf(mx, sx<2>(mx)); mx = __builtin_fmaxf(mx, sx<4>(mx)); mx = __builtin_fmaxf(mx, sx<8>(mx));
                if (fr == 0 && fq == 0) __hip_atomic_fetch_max(kmax + (((u.pm >> 5) * 8 + (u.pn & 1) * 4 + bj * 2 + (wc >> 1)) << 1) + (wc & 1), __float_as_uint(mx), __ATOMIC_RELAXED, __HIP_MEMORY_SCOPE_AGENT); } }
    }
};
struct EpiGlu {
    static constexpr bool PERM = true, AFTER_DRAIN = false, MIDK = false;
    const bf16_t* Y; const float* bglu; bf16_t* O; float* ssqo;
    __device__ __forceinline__ void operator()(const f32x4 (&acc)[2][2][4][2], const Unit& u, int wr, int wc, int fr, int fq) const {
        int row0 = u.pm * BM + wr * 64 + fr, c0 = u.pn * BM + wc * 32 + 8 * fq; asm volatile("" : "+v"(row0));
#pragma unroll
        for (int ai = 0; ai < 2; ++ai)
#pragma unroll
            for (int m = 0; m < 4; ++m) { asm volatile("" ::: "memory"); const int row = row0 + ai * HALF + m * 16; float ss = 0.f;
#pragma unroll
                for (int bj = 0; bj < 2; ++bj) { const int c = c0 + bj * HALF; const u32x4 yv = *(const u32x4*)(Y + (size_t)row * HW + c);
                    const f32x4 b0 = *(const f32x4*)(bglu + c), b1 = *(const f32x4*)(bglu + c + 4); const f32x4 a0 = acc[ai][bj][m][0] + b0, a1 = acc[ai][bj][m][1] + b1;
                    float o[8]; o[0] = bflo(yv.x) * sigm(a0[0]); o[1] = bfhi(yv.x) * sigm(a0[1]); o[2] = bflo(yv.y) * sigm(a0[2]); o[3] = bfhi(yv.y) * sigm(a0[3]);
                    o[4] = bflo(yv.z) * sigm(a1[0]); o[5] = bfhi(yv.z) * sigm(a1[1]); o[6] = bflo(yv.w) * sigm(a1[2]); o[7] = bfhi(yv.w) * sigm(a1[3]);
                    u32x4 w; w.x = pkbf(o[0], o[1]); w.y = pkbf(o[2], o[3]); w.z = pkbf(o[4], o[5]); w.w = pkbf(o[6], o[7]); *(u32x4*)(O + (size_t)row * HW + c) = w;
#pragma unroll
                    for (int e = 0; e < 8; ++e) ss += o[e] * o[e]; }
                ss += sx<16>(ss); ss = sum32(ss); if (fq == 0) ssqo[(size_t)row * 8 + u.pn * 4 + wc] = ss; }
    }
};
struct EpiBf16P {
    static constexpr bool PERM = true, AFTER_DRAIN = false, MIDK = false;
    bf16_t* O;
    __device__ __forceinline__ void operator()(const f32x4 (&acc)[2][2][4][2], const Unit& u, int wr, int wc, int fr, int fq) const {
        int row0 = u.pm * BM + wr * 64 + fr, c0 = u.pn * BM + wc * 32 + 8 * fq; asm volatile("" : "+v"(row0));
#pragma unroll
        for (int ai = 0; ai < 2; ++ai)
#pragma unroll
            for (int m = 0; m < 4; ++m) { asm volatile("" ::: "memory"); const int row = row0 + ai * HALF + m * 16;
#pragma unroll
                for (int bj = 0; bj < 2; ++bj) { const f32x4 v0 = acc[ai][bj][m][0], v1 = acc[ai][bj][m][1];
                    u32x4 w; w.x = pkbf(v0[0], v0[1]); w.y = pkbf(v0[2], v0[3]); w.z = pkbf(v1[0], v1[1]); w.w = pkbf(v1[2], v1[3]); *(u32x4*)(O + (size_t)row * DMODEL + c0 + bj * HALF) = w; } }
    }
};
struct EpiGate {
    static constexpr bool PERM = true, AFTER_DRAIN = false, MIDK = false;
    const bf16_t* base; float* out; const bf16_t* pp; const float* ssqi; float* ssqo;
    __device__ __forceinline__ void operator()(const f32x4 (&acc)[2][2][4][2], const Unit& u, int wr, int wc, int fr, int fq) const {
        int row0 = u.pm * BM + wr * 64 + fr, c0 = u.pn * BM + wc * 32 + 8 * fq; asm volatile("" : "+v"(row0));
        float rs8[2][4]; rstd8<16>(ssqi, u.pm, wr, fr, fq, 1.f / 1024.f, rs8);
#pragma unroll
        for (int ai = 0; ai < 2; ++ai)
#pragma unroll
            for (int m = 0; m < 4; ++m) { asm volatile("" ::: "memory"); const int row = row0 + ai * HALF + m * 16; const float rs = rs8[ai][m]; float ss = 0.f;
#pragma unroll
                for (int bj = 0; bj < 2; ++bj) { const size_t off = (size_t)row * DMODEL + c0 + bj * HALF; const u32x4 pv = *(const u32x4*)(pp + off);
                    const u32x4 bv = *(const u32x4*)(base + off); const f32x4 x0 = (f32x4){bflo(bv.x), bfhi(bv.x), bflo(bv.y), bfhi(bv.y)}, x1 = (f32x4){bflo(bv.z), bfhi(bv.z), bflo(bv.w), bfhi(bv.w)}; const f32x4 a0 = acc[ai][bj][m][0] * rs, a1 = acc[ai][bj][m][1] * rs; f32x4 v0, v1;
                    v0[0] = x0[0] + sigm(a0[0]) * bflo(pv.x); v0[1] = x0[1] + sigm(a0[1]) * bfhi(pv.x); v0[2] = x0[2] + sigm(a0[2]) * bflo(pv.y); v0[3] = x0[3] + sigm(a0[3]) * bfhi(pv.y);
                    v1[0] = x1[0] + sigm(a1[0]) * bflo(pv.z); v1[1] = x1[1] + sigm(a1[1]) * bfhi(pv.z); v1[2] = x1[2] + sigm(a1[2]) * bflo(pv.w); v1[3] = x1[3] + sigm(a1[3]) * bfhi(pv.w);
                    *(f32x4*)(out + off) = v0; *(f32x4*)(out + off + 4) = v1;
                    ss += (v0[0] * v0[0] + v0[1] * v0[1]) + (v0[2] * v0[2] + v0[3] * v0[3]) + (v1[0] * v1[0] + v1[1] * v1[1]) + (v1[2] * v1[2] + v1[3] * v1[3]); }
                ss += sx<16>(ss); ss = sum32(ss); if (fq == 0) ssqo[(size_t)row * 16 + u.pn * 4 + wc] = ss; }
    }
};

struct EpiGateFinal {
    static constexpr bool PERM = true, AFTER_DRAIN = false, MIDK = false;
    const bf16_t* base; float* out; const bf16_t* pp; const float* ssqi; float* ssqo; unsigned* cnt; const float* gfin;
    __device__ __forceinline__ void operator()(const f32x4 (&acc)[2][2][4][2], const Unit& u, int wr, int wc, int fr, int fq) const {
        int row0 = u.pm * BM + wr * 64 + fr, c0 = u.pn * BM + wc * 32 + 8 * fq; asm volatile("" : "+v"(row0));
        float rs8[2][4]; rstd8<16>(ssqi, u.pm, wr, fr, fq, 1.f / 1024.f, rs8);
        f32x4 v[2][4][2][2];
#pragma unroll
        for (int am = 0; am < 4; ++am) { asm volatile("" ::: "memory"); const int ai = am >> 1;
            u32x4 pvv[2][2], bvv[2][2];
#pragma unroll
            for (int mm = 0; mm < 2; ++mm)
#pragma unroll
                for (int bj = 0; bj < 2; ++bj) { const size_t off = (size_t)(row0 + ai * HALF + ((am & 1) * 2 + mm) * 16) * DMODEL + c0 + bj * HALF; pvv[mm][bj] = *(const u32x4*)(pp + off); bvv[mm][bj] = *(const u32x4*)(base + off); }
#pragma unroll
            for (int mm = 0; mm < 2; ++mm) { const int m = (am & 1) * 2 + mm; const int row = row0 + ai * HALF + m * 16; const float rs = rs8[ai][m]; float ss = 0.f;
#pragma unroll
                for (int bj = 0; bj < 2; ++bj) { const u32x4 pv = pvv[mm][bj];
                    const u32x4 bv = bvv[mm][bj]; const f32x4 x0 = (f32x4){bflo(bv.x), bfhi(bv.x), bflo(bv.y), bfhi(bv.y)}, x1 = (f32x4){bflo(bv.z), bfhi(bv.z), bflo(bv.w), bfhi(bv.w)}; const f32x4 a0 = acc[ai][bj][m][0] * rs, a1 = acc[ai][bj][m][1] * rs; f32x4 v0, v1;
                    v0[0] = x0[0] + sigm(a0[0]) * bflo(pv.x); v0[1] = x0[1] + sigm(a0[1]) * bfhi(pv.x); v0[2] = x0[2] + sigm(a0[2]) * bflo(pv.y); v0[3] = x0[3] + sigm(a0[3]) * bfhi(pv.y);
                    v1[0] = x1[0] + sigm(a1[0]) * bflo(pv.z); v1[1] = x1[1] + sigm(a1[1]) * bfhi(pv.z); v1[2] = x1[2] + sigm(a1[2]) * bflo(pv.w); v1[3] = x1[3] + sigm(a1[3]) * bfhi(pv.w);
                    v[ai][m][bj][0] = v0; v[ai][m][bj][1] = v1;
                    ss += (v0[0] * v0[0] + v0[1] * v0[1]) + (v0[2] * v0[2] + v0[3] * v0[3]) + (v1[0] * v1[0] + v1[1] * v1[1]) + (v1[2] * v1[2] + v1[3] * v1[3]); }
                ss += sx<16>(ss); ss = sum32(ss);
                if (fq == 0) __hip_atomic_store(ssqo + (size_t)row * 16 + u.pn * 4 + wc, ss, __ATOMIC_RELAXED, __HIP_MEMORY_SCOPE_AGENT); } }
        asm volatile("s_waitcnt vmcnt(0)" ::: "memory");
        unsigned* c = cnt + 64 * u.pm;
        if (fr == 0 && fq == 0) __hip_atomic_fetch_add(c, 1u, __ATOMIC_RELAXED, __HIP_MEMORY_SCOPE_AGENT);
        for (unsigned sp = 0; sp < (1u << 22); ++sp) {
            if ((unsigned)__builtin_amdgcn_readfirstlane(__hip_atomic_load(c, __ATOMIC_RELAXED, __HIP_MEMORY_SCOPE_AGENT)) >= 32u) break;
            __builtin_amdgcn_s_sleep(2); }
        __builtin_amdgcn_fence(__ATOMIC_ACQUIRE, "agent");
#pragma unroll
        for (int ai = 0; ai < 2; ++ai)
#pragma unroll
            for (int m = 0; m < 4; ++m) { asm volatile("" ::: "memory"); const int row = row0 + ai * HALF + m * 16; const float* ps = ssqo + (size_t)row * 16 + 4 * fq;
                float s4 = (__hip_atomic_load(ps, __ATOMIC_RELAXED, __HIP_MEMORY_SCOPE_AGENT) + __hip_atomic_load(ps + 1, __ATOMIC_RELAXED, __HIP_MEMORY_SCOPE_AGENT))
                         + (__hip_atomic_load(ps + 2, __ATOMIC_RELAXED, __HIP_MEMORY_SCOPE_AGENT) + __hip_atomic_load(ps + 3, __ATOMIC_RELAXED, __HIP_MEMORY_SCOPE_AGENT));
                s4 += sx<16>(s4); s4 = sum32(s4);
                const float rstd = __builtin_amdgcn_rsqf(s4 * (1.f / 1024.f) + 1e-6f);
#pragma unroll
                for (int bj = 0; bj < 2; ++bj) { const size_t off = (size_t)row * DMODEL + c0 + bj * HALF; const f32x4 g0 = *(const f32x4*)(gfin + c0 + bj * HALF), g1 = *(const f32x4*)(gfin + c0 + bj * HALF + 4);
                    __builtin_nontemporal_store(v[ai][m][bj][0] * rstd * g0, (f32x4*)(out + off)); __builtin_nontemporal_store(v[ai][m][bj][1] * rstd * g1, (f32x4*)(out + off + 4)); } }
    }
};

__device__ __forceinline__ void tr_item(const float* src, int srcN, int k0, int c0, const float* gain, bf16_t* dst, int dstPitch, int dstRow0, LAS float* scr, int lane) {
    float tv[32];
#pragma unroll
    for (int i = 0; i < 32; ++i) { const int kk = 2 * i + (lane >> 5); tv[i] = __builtin_nontemporal_load(src + (size_t)(k0 + kk) * srcN + c0 + (lane & 31)); }
    if (gain) {
#pragma unroll
        for (int i = 0; i < 32; ++i) tv[i] *= gain[k0 + 2 * i + (lane >> 5)]; }
#pragma unroll
    for (int i = 0; i < 32; ++i) scr[(2 * i + (lane >> 5)) * 33 + (lane & 31)] = tv[i];
    asm volatile("s_waitcnt lgkmcnt(0)" ::: "memory");
    const int c = lane & 7;
#pragma unroll
    for (int j = 0; j < 4; ++j) { const int n = (lane >> 3) + 8 * j; const LAS float* s = scr + (8 * c) * 33 + n;
        u32x4 o; o.x = pkbf(s[0 * 33], s[1 * 33]); o.y = pkbf(s[2 * 33], s[3 * 33]); o.z = pkbf(s[4 * 33], s[5 * 33]); o.w = pkbf(s[6 * 33], s[7 * 33]);
        *(u32x4*)(dst + (size_t)(dstRow0 + n) * dstPitch + k0 + 8 * c) = o; }
    asm volatile("s_waitcnt lgkmcnt(0)" ::: "memory");
}
__device__ __forceinline__ void tr_w13(const float* w1, const float* w3, const float* gain, bf16_t* dst, int item, LAS float* scr, int lane) {
    const int nblk = 5632 / 32, kb = item / nblk, nb = item % nblk, R0 = 32 * nb, tile = R0 >> 8, r = R0 & 255;
    tr_item(r < 128 ? w1 : w3, DFF, 64 * kb, 128 * tile + (r & 127), gain, dst, DMODEL, R0, scr, lane);
}
__device__ __forceinline__ void cis_d(double a, double& c, double& s) {
    const double k = rint(a * 0.63661977236758134);
    const double r = fma(-k, 6.123233995736766e-17, fma(-k, 1.5707963267948966, a)), r2 = r * r;
    const double sp = r * (1.0 + r2 * (-1.0 / 6 + r2 * (1.0 / 120 + r2 * (-1.0 / 5040 + r2 * (1.0 / 362880 + r2 * (-1.0 / 39916800 + r2 * (1.0 / 6227020800.0)))))));
    const double cp = 1.0 + r2 * (-0.5 + r2 * (1.0 / 24 + r2 * (-1.0 / 720 + r2 * (1.0 / 40320 + r2 * (-1.0 / 3628800 + r2 * (1.0 / 479001600.0 + r2 * (-1.0 / 87178291200.0)))))));
    const int q = ((int)k) & 3;
    c = (q == 0) ? cp : (q == 1) ? -sp : (q == 2) ? -cp : sp;
    s = (q == 0) ? sp : (q == 1) ? cp : (q == 2) ? -sp : -cp;
}
__device__ __forceinline__ float gelu_tanh(float y) { return y * sigm(1.5957691216057308f * (y + 0.044715f * y * y * y)); }

__device__ __forceinline__ void ssm_item(int bg, const bf16_t* U, const bf16_t* Ktab, const bf16_t* Pend, const bf16_t* Cc, const float* AP, bf16_t* Yout, LAS unsigned char* lds, int tid, unsigned* done) {
    asm volatile("" : "+v"(tid));
    const int lane = tid & 63, wid = __builtin_amdgcn_readfirstlane(tid >> 6), fr = lane & 15, fq = lane >> 4;
    const int b = bg >> 5, g = bg & 31;
    const bf16_t* Ub = U + (size_t)bg * SEQL * 16; const bf16_t* Kt = Ktab + g * 4096; const bf16_t* Pe = Pend + g * 32768; const bf16_t* Cg = Cc + g * 32768; const float* APg = AP + g * 64 * 36;
    float a16r[4], a16i[4];
#pragma unroll
    for (int pt = 0; pt < 4; ++pt) { a16r[pt] = APg[(16 * pt + fr) * 36 + 32]; a16i[pt] = APg[(16 * pt + fr) * 36 + 33]; }
    const float a64r = APg[lane * 36 + 34], a64i = APg[lane * 36 + 35];
    float cr = 0.f, ci = 0.f;
    LAS float* Ebuf = (LAS float*)lds; LAS float* Cbuf = (LAS float*)(lds + 16384); LAS unsigned short* XP = (LAS unsigned short*)(lds + 32768) + wid * (16 * 136);
    const int slot = wid * 4 + fq;
    LAS unsigned short* PendL = (LAS unsigned short*)(lds + 67584); LAS unsigned short* KtL = (LAS unsigned short*)(lds + 135168);
    { const GAS u32x4* ps = (const GAS u32x4*)Pe; u32x4 tv[8];
#pragma unroll
      for (int i = 0; i < 8; ++i) tv[i] = ps[tid + 512 * i];
      const u32x4 kv = ((const GAS u32x4*)Kt)[tid];
#pragma unroll
      for (int i = 0; i < 8; ++i) { const int c = tid + 512 * i; *(LAS u32x4*)(PendL + (c >> 5) * 264 + (c & 31) * 8) = tv[i]; }
      *(LAS u32x4*)(KtL + tid * 8) = kv; }
    __syncthreads();
    for (int seg = 0; seg < 4; ++seg) {
        const int c0 = seg * 128 + wid * 16;
        bf16x8 uf[8];
        { const bf16_t* ub = Ub + ((size_t)(c0 + fr) * 16 + (fq >> 1)) * 16 + 8 * (fq & 1); asm volatile("" : "+v"(ub));
#pragma unroll
        for (int ks = 0; ks < 8; ++ks) uf[ks] = *(const GAS bf16x8*)(ub + 32 * ks); }
        f32x4 S[8];
#pragma unroll
        for (int nt = 0; nt < 8; ++nt) { const LAS unsigned short* pn = PendL + (16 * nt + fr) * 264 + 8 * fq; S[nt] = (f32x4){0.f, 0.f, 0.f, 0.f};
#pragma unroll
            for (int ks = 0; ks < 8; ++ks) { const bf16x8 pf = *(const LAS bf16x8*)(pn + 32 * ks); S[nt] = __builtin_amdgcn_mfma_f32_16x16x32_bf16(uf[ks], pf, S[nt], 0, 0, 0); } }
        f32x4 Y[16];
#pragma unroll
        for (int tl = 0; tl < 16; ++tl) Y[tl] = (f32x4){0.f, 0.f, 0.f, 0.f};
#pragma unroll
        for (int d = 0; d < 16; ++d) { const int j = d - (fq >> 1); bf16x8 kfv = *(const LAS bf16x8*)(KtL + ((j < 0 ? 0 : j) * 16 + fr) * 16 + 8 * (fq & 1)); if (j < 0) kfv = (bf16x8){0, 0, 0, 0, 0, 0, 0, 0};
#pragma unroll
            for (int ks = 0; ks < 8; ++ks) if (d + 2 * ks < 16) Y[d + 2 * ks] = __builtin_amdgcn_mfma_f32_16x16x32_bf16(kfv, uf[ks], Y[d + 2 * ks], 0, 0, 0); }
#pragma unroll
        for (int pt = 0; pt < 4; ++pt) { float xr = 0.f, xi = 0.f;
#pragma unroll
            for (int i = 0; i < 4; ++i) { const float nr = a16r[pt] * xr - a16i[pt] * xi + S[pt][i], ni = a16r[pt] * xi + a16i[pt] * xr + S[pt + 4][i]; xr = nr; xi = ni; }
            Ebuf[slot * 128 + 16 * pt + fr] = xr; Ebuf[slot * 128 + 64 + 16 * pt + fr] = xi; }
        __syncthreads();
        if (wid == 0) {
            float er[32], ei[32];
#pragma unroll
            for (int sl = 0; sl < 32; ++sl) { er[sl] = Ebuf[sl * 128 + lane]; ei[sl] = Ebuf[sl * 128 + 64 + lane]; }
#pragma unroll
            for (int sl = 0; sl < 32; ++sl) { Cbuf[sl * 128 + lane] = cr; Cbuf[sl * 128 + 64 + lane] = ci;
                const float nr = a64r * cr - a64i * ci + er[sl], ni = a64r * ci + a64i * cr + ei[sl]; cr = nr; ci = ni; }
        }
        __syncthreads();
#pragma unroll
        for (int pt = 0; pt < 4; ++pt) { float xr = Cbuf[slot * 128 + 16 * pt + fr], xi = Cbuf[slot * 128 + 64 + 16 * pt + fr];
#pragma unroll
            for (int i = 0; i < 4; ++i) { const unsigned w = pkbf(xr, xi); XP[(4 * fq + i) * 136 + 16 * pt + fr] = (unsigned short)(w & 0xffffu); XP[(4 * fq + i) * 136 + 64 + 16 * pt + fr] = (unsigned short)(w >> 16);
                const float nr = a16r[pt] * xr - a16i[pt] * xi + S[pt][i], ni = a16r[pt] * xi + a16i[pt] * xr + S[pt + 4][i]; xr = nr; xi = ni; } }
        asm volatile("s_waitcnt lgkmcnt(0)" ::: "memory");
        bf16x8 xf[4];
#pragma unroll
        for (int ks = 0; ks < 4; ++ks) xf[ks] = *(const LAS bf16x8*)(XP + fr * 136 + 32 * ks + 8 * fq);
#pragma unroll
        for (int tl = 0; tl < 16; ++tl) { const bf16_t* cp = Cg + (tl * 16 + fr) * 128 + 8 * fq; if ((tl & 3) == 0) asm volatile("" : "+v"(cp) :: "memory"); else asm volatile("" : "+v"(cp));
#pragma unroll
            for (int ks = 0; ks < 4; ++ks) { const bf16x8 cf = *(const GAS bf16x8*)(cp + 32 * ks); Y[tl] = __builtin_amdgcn_mfma_f32_16x16x32_bf16(cf, xf[ks], Y[tl], 0, 0, 0); } }
        bf16_t* yo = Yout + ((size_t)b * SEQL + (size_t)(c0 + fr) * 16) * HW + g * 16 + 4 * fq; asm volatile("" : "+v"(yo));
#pragma unroll
        for (int tl = 0; tl < 16; ++tl) { u32x2 w; w.x = pkbf(gelu_tanh(Y[tl][0]), gelu_tanh(Y[tl][1])); w.y = pkbf(gelu_tanh(Y[tl][2]), gelu_tanh(Y[tl][3])); *(GAS u32x2*)(yo + (size_t)tl * HW) = w; }
        asm volatile("s_waitcnt lgkmcnt(0)" ::: "memory");
    }
    asm volatile("s_waitcnt vmcnt(0)" ::: "memory");
    __syncthreads();
    if (tid == 0) { __builtin_amdgcn_fence(__ATOMIC_RELEASE, "agent"); asm volatile("s_waitcnt vmcnt(0)" ::: "memory"); __hip_atomic_fetch_add(done, 1u, __ATOMIC_RELAXED, __HIP_MEMORY_SCOPE_AGENT); }
}

#define XB_TMO      128
#define XB_XCNT(j)  (256  + 64 * (j))
#define XB_XSUB(j)  (1280 + 64 * (j))
#define XB_XGEN(j)  (2304 + 64 * (j))
#define XB_TOP      3328
#define XB_TOPGEN   3392
#define XCD_BAR_WORDS 3456
#define XB_SPIN_CAP (1u << 18)

__device__ __forceinline__ unsigned xb_ld(unsigned* p)              { return __hip_atomic_load(p, __ATOMIC_RELAXED, __HIP_MEMORY_SCOPE_AGENT); }
__device__ __forceinline__ unsigned xb_add(unsigned* p, unsigned v) { return __hip_atomic_fetch_add(p, v, __ATOMIC_RELAXED, __HIP_MEMORY_SCOPE_AGENT); }
__device__ __forceinline__ unsigned xb_xcc_id() { return (unsigned)__builtin_amdgcn_s_getreg((3 << 11) | 20) & 0xFu; }
#define XB_SPIN(cond, bar) do { unsigned _sp = 0; while (cond) { __builtin_amdgcn_s_sleep(1); \
    if ((++_sp & 255u) == 0u) { if (xb_ld(&(bar)[XB_TMO])) break; if (_sp > XB_SPIN_CAP) { atomicAdd(&(bar)[XB_TMO], 1u); break; } } } } while (0)

struct XcdBarrier {
    unsigned* bar; unsigned x;
    volatile LAS unsigned* st;
};

__device__ __forceinline__ XcdBarrier xcd_barrier_post(unsigned* bar, volatile LAS unsigned* st) {
    XcdBarrier b; b.bar = bar; b.x = xb_xcc_id(); b.st = st;
    if (threadIdx.x == 0) (void)xb_add(&bar[XB_XCNT(b.x)], 1u);
    return b;
}
__device__ __forceinline__ void xcd_barrier_complete(unsigned* bar, unsigned x, unsigned& nloc, unsigned& nx) {
    const unsigned G = gridDim.x * gridDim.y * gridDim.z;
    unsigned sum, cnt, mine, sp = 0u;
    for (;;) {
        sum = 0u; cnt = 0u; mine = 0u;
#pragma unroll
        for (unsigned j = 0; j < 16; ++j) { const unsigned c = xb_ld(&bar[XB_XCNT(j)]); sum += c; cnt += (c > 0u) ? 1u : 0u; mine = (j == x) ? c : mine; }
        if (sum == G) break;
        __builtin_amdgcn_s_sleep(1);
        if ((++sp & 255u) == 0u) { if (xb_ld(&bar[XB_TMO])) break; if (sp > XB_SPIN_CAP) { atomicAdd(&bar[XB_TMO], 1u); break; } }
    }
    nloc = mine > 0u ? mine : 1u; nx = cnt > 0u ? cnt : 1u;
}

__device__ __forceinline__ void xcd_barrier(const XcdBarrier& b) {
    asm volatile("s_waitcnt vmcnt(0)" ::: "memory");
    __syncthreads();
    if (threadIdx.x == 0) {
        unsigned* bar = b.bar;
        __builtin_amdgcn_s_waitcnt(0);
        unsigned nloc = b.st[0], nx = b.st[1];
        if (nloc == 0u) { xcd_barrier_complete(bar, b.x, nloc, nx); b.st[0] = nloc; b.st[1] = nx; }
        const unsigned old = xb_add(&bar[XB_XSUB(b.x)], 1u);
        const unsigned gen = old / nloc;
        if (old + 1u == (gen + 1u) * nloc) {
            __builtin_amdgcn_fence(__ATOMIC_RELEASE, "agent");
            asm volatile("s_waitcnt vmcnt(0)" ::: "memory");
            const unsigned og = xb_add(&bar[XB_TOP], 1u);
            const unsigned tg = og / nx;
            if (og + 1u == (tg + 1u) * nx) xb_add(&bar[XB_TOPGEN], 1u);
            else XB_SPIN(xb_ld(&bar[XB_TOPGEN]) == tg, bar);
            __builtin_amdgcn_fence(__ATOMIC_ACQUIRE, "agent");
            xb_add(&bar[XB_XGEN(b.x)], 1u);
            asm volatile("s_waitcnt vmcnt(0)" ::: "memory");
        } else {
            XB_SPIN(xb_ld(&bar[XB_XGEN(b.x)]) == gen, bar);
            __builtin_amdgcn_fence(__ATOMIC_ACQUIRE, "agent");
            asm volatile("s_waitcnt vmcnt(0)" ::: "memory");
        }
    }
    __syncthreads();
}

#define BHMAP(r) ((((r) & 1) << 3) | (7 - ((r) >> 1)))
constexpr int NATT = 704;
struct Args { const float* in[30]; float* out; unsigned char* ws; };
#define CAS __attribute__((address_space(4)))
#define GSYNC() do { XcdBarrier b_; b_.bar = (unsigned*)(((const CAS Args*)__builtin_amdgcn_kernarg_segment_ptr())->ws + 4096); b_.x = xb_xcc_id(); b_.st = (volatile LAS unsigned*)(lds + MISC_OFF + 32); xcd_barrier(b_); } while (0)
#ifdef PROBE_SEL1
#define STAMP() do { if (blockIdx.x == 0 && threadIdx.x == 0) { unsigned long long* ts_ = (unsigned long long*)(((const CAS Args*)__builtin_amdgcn_kernarg_segment_ptr())->ws + 1024); ts_[nstamp] = __builtin_amdgcn_s_memrealtime(); } ++nstamp; } while (0)
#else
#define STAMP() do {} while (0)
#endif

__global__ void __launch_bounds__(512, 2) mk_fwd(Args a) {
    extern __shared__ __attribute__((aligned(16))) unsigned char lds_raw[];
    cg::grid_group grid = cg::this_grid();
    LAS unsigned char* lds = (LAS unsigned char*)lds_raw;
    const int wave_s = __builtin_amdgcn_readfirstlane((int)(threadIdx.x >> 6));
    int nstamp = 0; (void)nstamp;
    if (threadIdx.x < 32) ((LAS unsigned*)(lds + MISC_OFF))[threadIdx.x] = 0u;
    if (blockIdx.x == 0) { unsigned* cz = (unsigned*)(((const CAS Args*)__builtin_amdgcn_kernarg_segment_ptr())->ws);
        for (int i = threadIdx.x; i < 4480; i += 512) if (i < 128 || i >= 1024) __hip_atomic_store(cz + i, 0u, __ATOMIC_RELAXED, __HIP_MEMORY_SCOPE_AGENT);
        if (threadIdx.x < 64) __hip_atomic_store(cz + 4608 + 64 * threadIdx.x, 0u, __ATOMIC_RELAXED, __HIP_MEMORY_SCOPE_AGENT);
        if (threadIdx.x < 256) __hip_atomic_store(cz + 12288 + threadIdx.x, 0u, __ATOMIC_RELAXED, __HIP_MEMORY_SCOPE_AGENT);
        if (threadIdx.x < 96) __hip_atomic_store(cz + 13312 + threadIdx.x, 0u, __ATOMIC_RELAXED, __HIP_MEMORY_SCOPE_AGENT); }
    __syncthreads();
    grid.sync();
    (void)xcd_barrier_post((unsigned*)(((const CAS Args*)__builtin_amdgcn_kernarg_segment_ptr())->ws + 4096), (volatile LAS unsigned*)(lds + MISC_OFF + 32));
    STAMP();
#define IDS() const CAS Args* ap_ = (const CAS Args*)__builtin_amdgcn_kernarg_segment_ptr(); asm volatile("" : "+s"(ap_)); \
    int tid; asm volatile("v_mbcnt_lo_u32_b32 %0, -1, 0\n\tv_mbcnt_hi_u32_b32 %0, -1, %0" : "=v"(tid)); tid += wave_s * 64; const int lane = tid & 63, wave = __builtin_amdgcn_readfirstlane(tid >> 6); \
    const int G = gridDim.x, bx = blockIdx.x, vcu = (G % 8 == 0) ? (bx % 8) * (G / 8) + bx / 8 : bx; \
    const int gw = vcu * 8 + wave, NGW = G * 8, gt = bx * 512 + tid, NGT = G * 512; (void)lane; (void)gw; (void)NGW; (void)gt; (void)NGT; (void)vcu
#define INP(i) (ap_->in[i])
#define WSP(T, off) ((T*)(ap_->ws + (off)))
#define OUTP (ap_->out)
    {
        IDS();
        const float *x = INP(0), *pin = INP(1), *g_ffn1 = INP(2), *w1_a = INP(3), *w3_a = INP(4), *w2_a = INP(5), *g_mix = INP(6), *w_in = INP(7);
        const float *a_re = INP(9), *a_im = INP(10), *log_dt = INP(11), *b_re = INP(12), *b_im = INP(13);
        const float *w_glu = INP(17), *g_attn_out = INP(19), *g_ssm_out = INP(20), *w_out = INP(21), *g_ffn2 = INP(22), *w1_b = INP(23), *w3_b = INP(24), *w2_b = INP(25);
        const float *g_ple = INP(26), *w_ple_gate = INP(27), *w_ple_proj = INP(28);
        float* AP = WSP(float, WS_AP); float* BB = WSP(float, WS_BB); bf16_t* Wf = WSP(bf16_t, WS_WF); float* ssq0 = WSP(float, WS_SSQ0);
        bf16_t *W13a = WSP(bf16_t, WS_W13A), *W2a = WSP(bf16_t, WS_W2A), *Win = WSP(bf16_t, WS_WIN), *Wglu = WSP(bf16_t, WS_WGLU), *WoA = WSP(bf16_t, WS_WOA);
        bf16_t *W13b = WSP(bf16_t, WS_W13B), *W2b = WSP(bf16_t, WS_W2B), *Wg = WSP(bf16_t, WS_WG), *Wp = WSP(bf16_t, WS_WP), *PB = WSP(bf16_t, WS_PB), *XB = WSP(bf16_t, WS_XB);
        LAS float* scr = (LAS float*)(lds + wave * 16384);
        constexpr int I_13 = 16 * 176, I_IN = 16 * 64;
        constexpr int NITEMS = I_13 + I_IN;
        for (int it = gw; it < NITEMS; it += NGW) {
            int r = it;
            if (r < I_13) { tr_w13(w1_a, w3_a, g_ffn1, W13a, r, scr, lane); continue; } r -= I_13;
            { const int R0 = 32 * (r % 64); tr_item(w_in, 2056, 64 * (r / 64), R0 < 1536 ? R0 : R0 + 8, g_mix, Win, DMODEL, R0, scr, lane); }
        }
        for (int m = gw; m < TOK; m += 2 * NGW) {
            const int m2 = m + NGW; const bool has2 = m2 < TOK; const int mb = has2 ? m2 : m;
            const f32x4* xr = (const f32x4*)(x + (size_t)m * DMODEL) + lane; const f32x4* xr2 = (const f32x4*)(x + (size_t)mb * DMODEL) + lane;
            f32x4 va[4], vb[4];
#pragma unroll
            for (int j = 0; j < 4; ++j) { va[j] = __builtin_nontemporal_load(xr + 64 * j); vb[j] = __builtin_nontemporal_load(xr2 + 64 * j); }
            const f32x4 pa = __builtin_nontemporal_load((const f32x4*)(pin + (size_t)m * PLE) + lane), pb = __builtin_nontemporal_load((const f32x4*)(pin + (size_t)mb * PLE) + lane);
            u32x2* o8 = (u32x2*)(XB + (size_t)m * DMODEL) + lane; u32x2* o8b = (u32x2*)(XB + (size_t)mb * DMODEL) + lane; float ss = 0.f, ss2 = 0.f;
#pragma unroll
            for (int j = 0; j < 4; ++j) { const f32x4 v = va[j]; ss += (v[0] * v[0] + v[1] * v[1]) + (v[2] * v[2] + v[3] * v[3]); u32x2 w; w.x = pkbf(v[0], v[1]); w.y = pkbf(v[2], v[3]); o8[64 * j] = w; }
            ss = wave_sum(ss); if (lane < 4) ssq0[(size_t)m * 4 + lane] = lane == 0 ? ss : 0.f;
            { u32x2 w; w.x = pkbf(pa[0], pa[1]); w.y = pkbf(pa[2], pa[3]); *((u32x2*)(PB + (size_t)m * PLE) + lane) = w; }
            if (has2) {
#pragma unroll
                for (int j = 0; j < 4; ++j) { const f32x4 v = vb[j]; ss2 += (v[0] * v[0] + v[1] * v[1]) + (v[2] * v[2] + v[3] * v[3]); u32x2 w; w.x = pkbf(v[0], v[1]); w.y = pkbf(v[2], v[3]); o8b[64 * j] = w; }
                ss2 = wave_sum(ss2); if (lane < 4) ssq0[(size_t)m2 * 4 + lane] = lane == 0 ? ss2 : 0.f;
                u32x2 w; w.x = pkbf(pb[0], pb[1]); w.y = pkbf(pb[2], pb[3]); *((u32x2*)(PB + (size_t)m2 * PLE) + lane) = w; }
        }
        if (gt < 16384) { const int n = gt >> 10, k = gt & 1023; const float v = n < 8 ? g_mix[k] * w_in[(size_t)k * 2056 + 1536 + n] : 0.f; Wf[gt] = (bf16_t)(pkbf(v, 0.f) & 0xffffu); }
        if (gt < 2048) {
            const int g = gt >> 6; const double dt = exp((double)log_dt[g]), ar = a_re[gt], ai = a_im[gt];
            double cs, sn; cis_d(dt * ai, cs, sn); const double dec = exp(dt * ar), Ar = dec * cs, Ai = dec * sn;
            const double nr = Ar - 1.0, ni = Ai, den = ar * ar + ai * ai, f_r = (nr * ar + ni * ai) / den, f_i = (ni * ar - nr * ai) / den;
            float* ap = AP + gt * 36; double pr = 1.0, pi = 0.0;
            for (int n = 0; n <= 16; ++n) { ap[2 * n] = (float)pr; ap[2 * n + 1] = (float)pi; if (n < 16) { const double t_ = pr * Ar - pi * Ai; pi = pr * Ai + pi * Ar; pr = t_; } }
            double qr = pr * pr - pi * pi, qi = 2.0 * pr * pi; const double q2r = qr * qr - qi * qi, q2i = 2.0 * qr * qi; ap[34] = (float)q2r; ap[35] = (float)q2i;
            for (int h = 0; h < 16; ++h) { const double br = b_re[gt * 16 + h], bi = b_im[gt * 16 + h]; BB[gt * 32 + 2 * h] = (float)(f_r * br - f_i * bi); BB[gt * 32 + 2 * h + 1] = (float)(f_r * bi + f_i * br); }
        }
    }
    GSYNC(); STAMP();

    {
        IDS();
        pg8::Gemm gm{WSP(bf16_t, WS_XB), WSP(bf16_t, WS_W13A), TOK, 2 * DFF, DMODEL}; pg8::StaticOrder S; S.init(TOK, 2 * DFF, G, bx);
        EpiSwiglu<4> E{WSP(bf16_t, WS_H1), WSP(float, WS_SSQ0)};
        pg8::gemm_phase<EpiSwiglu<4>, pg8::StaticOrder, true, true>(lds, gm, S, E, tid);
    }
    if ((int)blockIdx.x >= (int)gridDim.x / 2) {
        IDS();
        const float *c_re = INP(14), *c_im = INP(15), *d_skip = INP(16);
        const float* AP = WSP(float, WS_AP); const float* BB = WSP(float, WS_BB); bf16_t* Ktab = WSP(bf16_t, WS_KTAB); bf16_t* Pend = WSP(bf16_t, WS_PEND); bf16_t* Cc = WSP(bf16_t, WS_CC);
        const int gt2 = (bx - G / 2) * 512 + tid, NGT2 = (G - G / 2) * 512;
        { const float *w2_a = INP(5), *w_glu = INP(17), *g_attn_out = INP(19), *g_ssm_out = INP(20), *w_out = INP(21), *w_ple_proj = INP(28);
          bf16_t *W2a = WSP(bf16_t, WS_W2A), *Wglu = WSP(bf16_t, WS_WGLU), *WoA = WSP(bf16_t, WS_WOA), *Wp = WSP(bf16_t, WS_WP);
          LAS float* scr = (LAS float*)(lds + wave * 16384);
          constexpr int I_2 = 44 * 32, I_GLU = 8 * 16, I_O = 8 * 32, I_P = 4 * 32;
          for (int it = (bx - G / 2) * 8 + wave; it < I_2 + I_GLU + 2 * I_O + I_P; it += (G - G / 2) * 8) {
              int r = it;
              if (r < I_2) { tr_item(w2_a, DMODEL, 64 * (r / 32), 32 * (r % 32), nullptr, W2a, DFF, 32 * (r % 32), scr, lane); continue; } r -= I_2;
              if (r < I_GLU) { tr_item(w_glu, HW, 64 * (r / 16), 32 * (r % 16), nullptr, Wglu, HW, 32 * (r % 16), scr, lane); continue; } r -= I_GLU;
              if (r < 2 * I_O) { const int kb = r / 32; tr_item(w_out, DMODEL, 64 * kb, 32 * (r % 32), kb < 8 ? g_attn_out : g_ssm_out - HW, WoA, DMODEL, 32 * (r % 32), scr, lane); continue; } r -= 2 * I_O;
              tr_item(w_ple_proj, DMODEL, 64 * (r / 32), 32 * (r % 32), nullptr, Wp, PLE, 32 * (r % 32), scr, lane);
          } }
        for (int idx = gt2; idx < 131072; idx += NGT2) {
            const int g = idx >> 12, j = (idx >> 8) & 15, h = (idx >> 4) & 15, hp = idx & 15; float s = 0.f;
#pragma unroll 16
            for (int p = 0; p < 64; ++p) { const float Cr = c_re[(g * 16 + h) * 64 + p], Ci = c_im[(g * 16 + h) * 64 + p], Ar = AP[(g * 64 + p) * 36 + 2 * j], Ai = AP[(g * 64 + p) * 36 + 2 * j + 1];
                const float Wr = Cr * Ar - Ci * Ai, Wi = Cr * Ai + Ci * Ar, Br = BB[(g * 64 + p) * 32 + 2 * hp], Bi = BB[(g * 64 + p) * 32 + 2 * hp + 1]; s += Wr * Br - Wi * Bi; }
            if (j == 0 && h == hp) s += d_skip[g * 16 + h];
            Ktab[idx] = (bf16_t)(pkbf(s, 0.f) & 0xffffu);
        }
        for (int idx = gt2; idx < 1048576; idx += NGT2) {
            { const int g = idx >> 15, comp = (idx >> 8) & 127, k = idx & 255, p = comp & 63, im = comp >> 6, sl = k >> 4, hp = k & 15;
              const float Ar = AP[(g * 64 + p) * 36 + 2 * (15 - sl)], Ai = AP[(g * 64 + p) * 36 + 2 * (15 - sl) + 1], Br = BB[(g * 64 + p) * 32 + 2 * hp], Bi = BB[(g * 64 + p) * 32 + 2 * hp + 1];
              const float v = im ? (Ar * Bi + Ai * Br) : (Ar * Br - Ai * Bi); Pend[idx] = (bf16_t)(pkbf(v, 0.f) & 0xffffu); }
            { const int g = idx >> 15, n = (idx >> 7) & 255, tl = n >> 4, h = n & 15, comp = idx & 127, p = comp & 63, im = comp >> 6;
              const float Cr = c_re[(g * 16 + h) * 64 + p], Ci = c_im[(g * 16 + h) * 64 + p], Ar = AP[(g * 64 + p) * 36 + 2 * (tl + 1)], Ai = AP[(g * 64 + p) * 36 + 2 * (tl + 1) + 1];
              const float v = im ? -(Cr * Ai + Ci * Ar) : (Cr * Ar - Ci * Ai); Cc[idx] = (bf16_t)(pkbf(v, 0.f) & 0xffffu); }
        }
    }
    GSYNC(); STAMP();
    {
        IDS();
        pg8::Gemm gm{WSP(bf16_t, WS_H1), WSP(bf16_t, WS_W2A), TOK, DMODEL, DFF}; pg8::StaticOrder S; S.init(TOK, DMODEL, G, bx);
        EpiRes<false, true> E{nullptr, WSP(bf16_t, WS_XB), WSP(float, WS_SSQ1), nullptr, 0.5f};
        pg8::gemm_phase<EpiRes<false, true>, pg8::StaticOrder, true, true>(lds, gm, S, E, tid);
    }
    GSYNC(); STAMP();
    {
        IDS();
        const float* b_f = INP(8); const bf16_t* XB = WSP(bf16_t, WS_XB); const bf16_t* Wf = WSP(bf16_t, WS_WF); const float* ssq1 = WSP(float, WS_SSQ1); float* LOGF = WSP(float, WS_LOGF);
        const int fr = lane & 15, fq = lane >> 4;
        for (int it = gw >> 1; it < TOK / 16; it += NGW >> 1) {
            const int t0 = it * 16, kh = wave & 1; f32x4 acc0 = (f32x4){0.f, 0.f, 0.f, 0.f}, acc1 = acc0;
            const bf16_t* ap = XB + (size_t)(t0 + fr) * DMODEL + 8 * fq + 512 * kh; const bf16_t* bp = Wf + fr * DMODEL + 8 * fq + 512 * kh;
            bf16x8 av[16], bv[16];
#pragma unroll
            for (int ks = 0; ks < 16; ++ks) { av[ks] = *(const bf16x8*)(ap + 32 * ks); bv[ks] = *(const bf16x8*)(bp + 32 * ks); }
#pragma unroll
            for (int ks = 0; ks < 16; ks += 2) { acc0 = __builtin_amdgcn_mfma_f32_16x16x32_bf16(av[ks], bv[ks], acc0, 0, 0, 0); acc1 = __builtin_amdgcn_mfma_f32_16x16x32_bf16(av[ks + 1], bv[ks + 1], acc1, 0, 0, 0); }
            f32x4 acc = acc0 + acc1;
            LAS f32x4* xch = (LAS f32x4*)(lds + (wave >> 1) * 1024) + lane;
            if (kh) *xch = acc;
            __syncthreads();
            if (!kh) { acc = acc + *xch;
                if (fr < 8) { const int r0 = t0 + 4 * fq; const float bf = b_f[fr]; f32x4 o;
#pragma unroll
                    for (int i = 0; i < 4; ++i) { const float z = rstd_row<16>(ssq1, r0 + i, 1.f / 1024.f) * acc[i] + bf; o[i] = fminf(z, 0.f) - log1pf(expf(-fabsf(z))); }
                    *(f32x4*)(LOGF + (size_t)((r0 >> 13) * 8 + fr) * SEQL + (r0 & 8191)) = o; } }
            __syncthreads();
        }
        pg8::Gemm gm{XB, WSP(bf16_t, WS_WIN), TOK, 2048, DMODEL}; pg8::StaticOrder S; S.init(TOK, 2048, G, bx);
        EpiQKVU E{WSP(bf16_t, WS_Q), WSP(bf16_t, WS_U), ssq1, WSP(unsigned, WS_CTL) + 13312};
        pg8::gemm_phase<EpiQKVU, pg8::StaticOrder, true, true>(lds, gm, S, E, tid);
    }
    GSYNC(); STAMP();
    {
        volatile LAS int* qs = (volatile LAS int*)(lds + MISC_OFF);
        int qfirst = 1;
        for (;;) {
            IDS();
            int item;
            if (qfirst) { item = bx; qfirst = 0; }
            else {
                if (tid == 0) qs[0] = G + (int)__hip_atomic_fetch_add(WSP(unsigned, WS_CTL) + 64, 1u, __ATOMIC_RELAXED, __HIP_MEMORY_SCOPE_AGENT);
                __syncthreads();
                item = __builtin_amdgcn_readfirstlane(qs[0]);
                __syncthreads(); }
            if (item >= 64 + NATT + 176 + 256 + 128) break;
            if (item >= 64 + NATT + 176 + 256) {
                const int j_ = item - (64 + NATT + 176 + 256);
                if (tid == 0) { unsigned* dn = WSP(unsigned, WS_CTL) + 13400 + (j_ >> 6);
                    for (unsigned sp = 0; sp < (1u << 22); ++sp) { if (__hip_atomic_load(dn, __ATOMIC_RELAXED, __HIP_MEMORY_SCOPE_AGENT) >= 32u) break; __builtin_amdgcn_s_sleep(8); }
                    __builtin_amdgcn_fence(__ATOMIC_ACQUIRE, "agent"); asm volatile("s_waitcnt vmcnt(0)" ::: "memory"); }
                __syncthreads();
                pg8::Gemm gm{WSP(bf16_t, WS_Y), WSP(bf16_t, WS_WGLU), TOK, HW, HW}; StrideOrder S{j_, 1 << 28, 128, 2};
                EpiGlu E{WSP(bf16_t, WS_Y), INP(18), WSP(bf16_t, WS_SSMO), WSP(float, WS_SSQS)};
                pg8::gemm_phase<EpiGlu, StrideOrder, true, true>(lds, gm, S, E, tid); continue; }
            if (item >= 64 + NATT + 176) {
                pg8::Gemm gm{WSP(bf16_t, WS_PB), WSP(bf16_t, WS_WP), TOK, DMODEL, PLE}; StrideOrder S{item - (64 + NATT + 176), 1 << 28, 256, 4};
                EpiBf16P E{WSP(bf16_t, WS_PP)};
                pg8::gemm_phase<EpiBf16P, StrideOrder, true, true>(lds, gm, S, E, tid); continue; }
            if (item >= 64 + NATT) {
                tr_w13(INP(23), INP(24), INP(22), WSP(bf16_t, WS_W13B), (item - (64 + NATT)) * 16 + wave * 2, (LAS float*)(lds + wave * 16384), lane);
                tr_w13(INP(23), INP(24), INP(22), WSP(bf16_t, WS_W13B), (item - (64 + NATT)) * 16 + wave * 2 + 1, (LAS float*)(lds + wave * 16384), lane);
                __syncthreads(); continue; }
            const bool is_ssm = item < 64;
#ifdef PROBE_SEL1
            const unsigned long long t0_ = __builtin_amdgcn_s_memrealtime();
#endif
            if (is_ssm) ssm_item(item, WSP(bf16_t, WS_U), WSP(bf16_t, WS_KTAB), WSP(bf16_t, WS_PEND), WSP(bf16_t, WS_CC), WSP(float, WS_AP), WSP(bf16_t, WS_Y), lds, tid, WSP(unsigned, WS_CTL) + 13400 + (item >> 5));
            else { const int a_ = item - 64; int kind, bh, qb;
                if (a_ < 64) { kind = 2; bh = BHMAP(a_ & 15); qb = 19 - (a_ >> 4); }
                else if (a_ < 64 + 576) { const int c_ = a_ - 64, lvl = c_ / 48, r_ = c_ % 48; kind = r_ >> 4; bh = BHMAP(r_ & 15); qb = kind < 2 ? 31 - lvl : 15 - lvl; }
                else { const int c_ = a_ - 640; kind = 2; bh = BHMAP(c_ & 15); qb = 3 - (c_ >> 4); }
                const int ntf = 4 * (qb + 1), tm = ntf >> 1, tb = kind == 0 ? tm : 0, te = kind == 1 ? tm : ntf, mode = kind == 2 ? 0 : (kind == 0 ? 2 : 1), sid = kind < 2 ? (qb - 20) * 16 + bh : 0;
                attn_body::attn_unit<96>(bh >> 3, bh & 7, qb, tb, te, mode, (sid < 60 ? WSP(float, 180 * MiB) + (size_t)sid * PARTF : sid < 105 ? WSP(float, WS_W2B) + (size_t)(sid - 60) * PARTF : WSP(float, 236 * MiB) + (size_t)(sid - 105) * PARTF), WSP(unsigned, WS_CTL) + 12288 + sid, WSP(unsigned, WS_CTL) + 13312 + 2 * bh,
                    WSP(attn_body::bf16, WS_Q), WSP(attn_body::bf16, WS_K), WSP(attn_body::bf16, WS_V), WSP(attn_body::bf16, WS_Q), WSP(float, WS_LOGF), WSP(float, WS_SSQA), (char*)lds_raw, tid); }
#ifdef PROBE_SEL1
            if (tid == 0) { const unsigned d_ = (unsigned)(__builtin_amdgcn_s_memrealtime() - t0_); atomicMax(WSP(unsigned, WS_CTL) + (is_ssm ? 128 : 129), d_); if (is_ssm) atomicMin(WSP(unsigned, WS_CTL) + 130, ~d_); }
#endif
        }
    }
    GSYNC(); STAMP();
    {
        { IDS(); pg8::Gemm gm{WSP(bf16_t, WS_Q), WSP(bf16_t, WS_WOA), TOK, DMODEL, DMODEL, WSP(bf16_t, WS_SSMO), HW}; pg8::StaticOrder S; S.init(TOK, DMODEL, G, bx);
          EpiOut E{WSP(bf16_t, WS_XB), WSP(float, WS_SSQ2), WSP(float, WS_SSQA), WSP(float, WS_SSQS)};
          pg8::gemm_phase<EpiOut, pg8::StaticOrder, true, true>(lds, gm, S, E, tid); }
    }
    GSYNC(); STAMP();
    {
        IDS();
        pg8::Gemm gm{WSP(bf16_t, WS_XB), WSP(bf16_t, WS_W13B), TOK, 2 * DFF, DMODEL}; pg8::StaticOrder S; S.init(TOK, 2 * DFF, G, bx);
        EpiSwiglu<16> E{WSP(bf16_t, WS_H1), WSP(float, WS_SSQ2)};
        pg8::gemm_phase<EpiSwiglu<16>, pg8::StaticOrder, true, true>(lds, gm, S, E, tid);
    }
    if ((int)blockIdx.x >= (int)gridDim.x / 2) {
        IDS();
        const float *w2_b = INP(25), *g_ple = INP(26), *w_ple_gate = INP(27); bf16_t *W2b = WSP(bf16_t, WS_W2B), *Wg = WSP(bf16_t, WS_WG);
        LAS float* scr = (LAS float*)(lds + wave * 16384);
        constexpr int I_2 = 44 * 32, I_G = 16 * 32;
        for (int it = (bx - G / 2) * 8 + wave; it < I_2 + I_G; it += (G - G / 2) * 8) {
            int r = it;
            if (r < I_2) { tr_item(w2_b, DMODEL, 64 * (r / 32), 32 * (r % 32), nullptr, W2b, DFF, 32 * (r % 32), scr, lane); continue; } r -= I_2;
            tr_item(w_ple_gate, DMODEL, 64 * (r / 32), 32 * (r % 32), g_ple, Wg, DMODEL, 32 * (r % 32), scr, lane);
        }
    }
    GSYNC(); STAMP();
    {
        IDS();
        pg8::Gemm gm{WSP(bf16_t, WS_H1), WSP(bf16_t, WS_W2B), TOK, DMODEL, DFF}; pg8::StaticOrder S; S.init(TOK, DMODEL, G, bx);
        EpiRes<false, true> E{nullptr, WSP(bf16_t, WS_XB), WSP(float, WS_SSQ3), nullptr, 0.5f};
        pg8::gemm_phase<EpiRes<false, true>, pg8::StaticOrder, true, true>(lds, gm, S, E, tid);
    }
    GSYNC(); STAMP();
    {
        if ((int)gridDim.x == 256) { IDS(); pg8::Gemm gm{WSP(bf16_t, WS_XB), WSP(bf16_t, WS_WG), TOK, DMODEL, DMODEL}; pg8::StaticOrder S; S.init(TOK, DMODEL, G, bx);
          EpiGateFinal E{WSP(bf16_t, WS_XB), OUTP, WSP(bf16_t, WS_PP), WSP(float, WS_SSQ3), WSP(float, WS_SSQ4), WSP(unsigned, WS_CTL) + 4608, INP(29)};
          pg8::gemm_phase<EpiGateFinal, pg8::StaticOrder, true, true>(lds, gm, S, E, tid); }
        else { IDS(); pg8::Gemm gm{WSP(bf16_t, WS_XB), WSP(bf16_t, WS_WG), TOK, DMODEL, DMODEL}; pg8::StaticOrder S; S.init(TOK, DMODEL, G, bx);
          EpiGate E{WSP(bf16_t, WS_XB), OUTP, WSP(bf16_t, WS_PP), WSP(float, WS_SSQ3), WSP(float, WS_SSQ4)};
          pg8::gemm_phase<EpiGate, pg8::StaticOrder, true, true>(lds, gm, S, E, tid); }
    }
    if ((int)gridDim.x != 256) {
    GSYNC(); STAMP();
    { IDS(); const float* ssq4 = WSP(float, WS_SSQ4); float* out = OUTP; const float* g_final = INP(29);
    for (int m = gw; m < TOK; m += NGW) {
        const float rs = rstd_row<16>(ssq4, m, 1.f / 1024.f); f32x4* o = (f32x4*)(out + (size_t)m * DMODEL) + lane; const f32x4* gf = (const f32x4*)g_final + lane;
#pragma unroll
        for (int j = 0; j < 4; ++j) { const f32x4 v = o[64 * j], gg = gf[64 * j]; o[64 * j] = v * rs * gg; }
    } }
    }
#ifdef PROBE_SEL1
    GSYNC(); STAMP();
    if (blockIdx.x == 0) { IDS(); const unsigned long long* ts_ = (const unsigned long long*)(ap_->ws + 1024); const unsigned* cw = WSP(unsigned, WS_CTL);
        float dur[15];
#pragma unroll
        for (int k = 0; k < 11; ++k) dur[k] = (float)(ts_[k + 1] - ts_[k]) * 0.01f;
        dur[11] = (float)cw[128] * 0.01f; dur[12] = (float)cw[129] * 0.01f; dur[13] = (float)(~cw[130]) * 0.01f; dur[14] = (float)(ts_[11] - ts_[0]) * 0.01f;
        float t1 = 0.f, t2 = 0.f;
#pragma unroll
        for (int k = 0; k < 15; ++k) { if (k == PROBE_SEL1) t1 = dur[k]; if (k == PROBE_SEL2) t2 = dur[k]; }
        if (tid == 0) OUTP[0] += t1 * 0.01f;
        for (int r = tid; r < 1024; r += 512) OUTP[(size_t)(r * 16) * DMODEL + 1] += t2 * 0.01f; }
#endif
}

extern "C" void kernel_launch(void* const* d_in, const int* in_sizes, int n_in, void* d_out, int out_size, void* d_ws, size_t ws_size, hipStream_t stream) {
    static int grid = 0;
    if (grid == 0) {
        if (n_in != 30 || out_size != TOK * DMODEL || ws_size < WS_END) { fprintf(stderr, "kernel_launch: unexpected problem (n_in %d out %d ws %zu)\n", n_in, out_size, ws_size); grid = -1; return; }
        int dev = 0, cus = 0, per_cu = 0;
        (void)hipGetDevice(&dev); (void)hipDeviceGetAttribute(&cus, hipDeviceAttributeMultiprocessorCount, dev);
        if (hipFuncSetAttribute((const void*)mk_fwd, hipFuncAttributeMaxDynamicSharedMemorySize, LDS_BYTES) != hipSuccess) { fprintf(stderr, "kernel_launch: hipFuncSetAttribute failed\n"); grid = -1; return; }
        if (hipOccupancyMaxActiveBlocksPerMultiprocessor(&per_cu, (const void*)mk_fwd, 512, LDS_BYTES) != hipSuccess || per_cu < 1) { fprintf(stderr, "kernel_launch: occupancy query gave %d\n", per_cu); per_cu = 1; }
        (void)hipGetLastError();
        grid = cus * per_cu;
    }
    if (grid < 0) return;
    Args a{};
    for (int i = 0; i < 30; ++i) a.in[i] = (const float*)d_in[i];
    a.out = (float*)d_out; a.ws = (unsigned char*)d_ws;
    void* args[] = {&a};
    hipError_t e = hipLaunchCooperativeKernel((const void*)mk_fwd, dim3(grid), dim3(512), args, LDS_BYTES, stream);
    if (e != hipSuccess) fprintf(stderr, "kernel_launch: cooperative launch failed: %s (grid %d)\n", hipGetErrorString(e), grid);
}
```
